# Optimizing an MI355X kernel written in HIP

```python
import math
import jax, jax.numpy as jnp
from jax import lax
import numpy as np

D_MODEL = 1024
BATCH = 4
SEQ = 8192
DEPTH = 4

N_MIXERS = 3
EPS = 1e-6
D_FF = 2816
CONV_WIDTH = 3
MLA_HEADS = 16
Q_LORA = 256
KV_LORA = 128
QK_NOPE = 64
QK_ROPE = 32
QK_HEAD = QK_NOPE + QK_ROPE
V_HEAD = 64
ROPE_THETA = 10000.0
Q_BLOCK = 128
SG_WIDTH = D_MODEL
SG_GROUPS = 8
SG_CHUNK = 128
N_A = (DEPTH + 2) // 3
N_B = (DEPTH + 1) // 3
N_C = DEPTH // 3

kernel_name = "hybrid_interleaved_macaron_trunk"


def rms_norm(x, g):
    xf = x.astype(jnp.float32)
    y = xf * lax.rsqrt(jnp.mean(xf * xf, axis=-1, keepdims=True) + EPS)
    return y.astype(x.dtype) * g


def swiglu(x, w_gate, w_up, w_down):
    return (jax.nn.silu(x @ w_gate) * (x @ w_up)) @ w_down


def rope(t, cos, sin):
    t1, t2 = jnp.split(t, 2, axis=-1)
    return jnp.concatenate([t1 * cos - t2 * sin, t2 * cos + t1 * sin], axis=-1)


def short_conv_mixer(x, w_in, conv_k, w_out):
    d = x.shape[-1]
    proj = x @ w_in
    b_gate, c_gate, h = proj[..., :d], proj[..., d:2 * d], proj[..., 2 * d:]
    z = c_gate * h
    conv = lax.conv_general_dilated(
        z, conv_k[:, None, :].astype(z.dtype), window_strides=(1,),
        padding=[(CONV_WIDTH - 1, 0)], dimension_numbers=("NWC", "WIO", "NWC"),
        feature_group_count=d)
    return (b_gate * conv) @ w_out


def mla_mixer(x, cos, sin, w_a, q_norm, w_uq, kv_norm, w_ukv, q_gain, k_gain, w_o):
    bsz, s, _ = x.shape
    a = x @ w_a
    c_q = a[..., :Q_LORA]
    c_kv = a[..., Q_LORA:Q_LORA + KV_LORA]
    k_pe = a[..., Q_LORA + KV_LORA:]
    q = (rms_norm(c_q, q_norm) @ w_uq).reshape(bsz, s, MLA_HEADS, QK_HEAD)
    kv = (rms_norm(c_kv, kv_norm) @ w_ukv).reshape(bsz, s, MLA_HEADS, QK_NOPE + V_HEAD)
    k_nope, v = kv[..., :QK_NOPE], kv[..., QK_NOPE:]
    k = jnp.concatenate(
        [k_nope, jnp.broadcast_to(k_pe[:, :, None, :], (bsz, s, MLA_HEADS, QK_ROPE))], axis=-1)
    q = rms_norm(q, q_gain)
    k = rms_norm(k, k_gain)
    cos_h, sin_h = cos[:, :, None, :], sin[:, :, None, :]
    q = jnp.concatenate([q[..., :QK_NOPE], rope(q[..., QK_NOPE:], cos_h, sin_h)], axis=-1)
    k = jnp.concatenate([k[..., :QK_NOPE], rope(k[..., QK_NOPE:], cos_h, sin_h)], axis=-1)
    q = q.transpose(0, 2, 1, 3)
    k = k.transpose(0, 2, 1, 3)
    v = v.transpose(0, 2, 1, 3)
    scale = QK_HEAD ** -0.5
    outs = []
    for blk in range(s // Q_BLOCK):
        q0, end = blk * Q_BLOCK, (blk + 1) * Q_BLOCK
        qb = q[:, :, q0:end]
        kb, vb = k[:, :, :end], v[:, :, :end]
        sc = jnp.einsum("bhqd,bhkd->bhqk", qb, kb).astype(jnp.float32) * scale
        mask = jnp.arange(end)[None, :] <= jnp.arange(q0, end)[:, None]
        sc = jnp.where(mask[None, None], sc, -jnp.inf)
        p = jax.nn.softmax(sc, axis=-1).astype(vb.dtype)
        outs.append(jnp.einsum("bhqk,bhkd->bhqd", p, vb))
    o = jnp.concatenate(outs, axis=2)
    o = o.transpose(0, 2, 1, 3).reshape(bsz, s, MLA_HEADS * V_HEAD)
    return o @ w_o


def spatial_gating_mixer(x, w_in, v_norm, w_s, b_s, w_out):
    bsz, s, _ = x.shape
    z = jax.nn.gelu(x @ w_in)
    u, v = z[..., :SG_WIDTH], z[..., SG_WIDTH:]
    v = rms_norm(v, v_norm)
    cg = SG_WIDTH // SG_GROUPS
    v = v.reshape(bsz, s // SG_CHUNK, SG_CHUNK, SG_GROUPS, cg)
    causal = jnp.tril(jnp.ones((SG_CHUNK, SG_CHUNK), dtype=bool))
    w_masked = jnp.where(causal[None], w_s, jnp.zeros((), w_s.dtype))
    mixed = jnp.einsum("gts,bcsgk->bctgk", w_masked, v) + b_s.T[None, None, :, :, None]
    return (u * mixed.reshape(bsz, s, SG_WIDTH)) @ w_out


def setup_inputs(seed: int = 0) -> dict:
    key = jax.random.key(seed)
    ks = jax.random.split(key, 24)

    def nrm(k, shape, fan_in):
        return jax.random.normal(k, shape, jnp.float32) * fan_in ** -0.5

    def gain(k, shape):
        return 1.0 + 0.05 * jax.random.normal(k, shape, jnp.float32)

    x = jax.random.normal(ks[0], (BATCH, SEQ, D_MODEL), jnp.float32)
    start = jax.random.randint(ks[1], (BATCH,), 0, 4096, dtype=jnp.int32)
    positions = (start[:, None] + jnp.arange(SEQ, dtype=jnp.int32)[None, :]).astype(jnp.int32)
    return {
        "x": x,
        "positions": positions,
        "norm_g": gain(ks[2], (DEPTH, 3, D_MODEL)),
        "ffn_gate": nrm(ks[3], (DEPTH, 2, D_MODEL, D_FF), D_MODEL),
        "ffn_up": nrm(ks[4], (DEPTH, 2, D_MODEL, D_FF), D_MODEL),
        "ffn_down": nrm(ks[5], (DEPTH, 2, D_FF, D_MODEL), D_FF),
        "conv_w_in": nrm(ks[6], (N_A, D_MODEL, 3 * D_MODEL), D_MODEL),
        "conv_k": nrm(ks[7], (N_A, CONV_WIDTH, D_MODEL), CONV_WIDTH),
        "conv_w_out": nrm(ks[8], (N_A, D_MODEL, D_MODEL), D_MODEL),
        "mla_w_a": nrm(ks[9], (N_B, D_MODEL, Q_LORA + KV_LORA + QK_ROPE), D_MODEL),
        "mla_q_norm": gain(ks[10], (N_B, Q_LORA)),
        "mla_w_uq": nrm(ks[11], (N_B, Q_LORA, MLA_HEADS * QK_HEAD), Q_LORA),
        "mla_kv_norm": gain(ks[12], (N_B, KV_LORA)),
        "mla_w_ukv": nrm(ks[13], (N_B, KV_LORA, MLA_HEADS * (QK_NOPE + V_HEAD)), KV_LORA),
        "mla_q_gain": gain(ks[14], (N_B, QK_HEAD)),
        "mla_k_gain": gain(ks[15], (N_B, QK_HEAD)),
        "mla_w_o": nrm(ks[16], (N_B, MLA_HEADS * V_HEAD, D_MODEL), MLA_HEADS * V_HEAD),
        "sg_w_in": nrm(ks[17], (N_C, D_MODEL, 2 * SG_WIDTH), D_MODEL),
        "sg_v_norm": gain(ks[18], (N_C, SG_WIDTH)),
        "sg_w_s": nrm(ks[19], (N_C, SG_GROUPS, SG_CHUNK, SG_CHUNK), SG_CHUNK),
        "sg_b": 1.0 + 0.1 * jax.random.normal(ks[20], (N_C, SG_GROUPS, SG_CHUNK), jnp.float32),
        "sg_w_out": nrm(ks[21], (N_C, SG_WIDTH, D_MODEL), SG_WIDTH),
    }


def reference(x, positions, norm_g, ffn_gate, ffn_up, ffn_down,
              conv_w_in, conv_k, conv_w_out,
              mla_w_a, mla_q_norm, mla_w_uq, mla_kv_norm, mla_w_ukv, mla_q_gain, mla_k_gain, mla_w_o,
              sg_w_in, sg_v_norm, sg_w_s, sg_b, sg_w_out):
    inv_freq = 1.0 / (ROPE_THETA ** (jnp.arange(0, QK_ROPE, 2, dtype=jnp.float32) / QK_ROPE))
    ang = positions.astype(jnp.float32)[..., None] * inv_freq
    cos = jnp.cos(ang).astype(x.dtype)
    sin = jnp.sin(ang).astype(x.dtype)

    ia = ib = ic = 0
    for i in range(DEPTH):
        x = x + 0.5 * swiglu(rms_norm(x, norm_g[i, 0]), ffn_gate[i, 0], ffn_up[i, 0], ffn_down[i, 0])
        hn = rms_norm(x, norm_g[i, 1])
        kind = i % N_MIXERS
        if kind == 0:
            mix = short_conv_mixer(hn, conv_w_in[ia], conv_k[ia], conv_w_out[ia])
            ia += 1
        elif kind == 1:
            mix = mla_mixer(hn, cos, sin, mla_w_a[ib], mla_q_norm[ib], mla_w_uq[ib], mla_kv_norm[ib],
                            mla_w_ukv[ib], mla_q_gain[ib], mla_k_gain[ib], mla_w_o[ib])
            ib += 1
        else:
            mix = spatial_gating_mixer(hn, sg_w_in[ic], sg_v_norm[ic], sg_w_s[ic], sg_b[ic], sg_w_out[ic])
            ic += 1
        x = x + mix
        x = x + 0.5 * swiglu(rms_norm(x, norm_g[i, 2]), ffn_gate[i, 1], ffn_up[i, 1], ffn_down[i, 1])
    return x
```

```cpp
#include <hip/hip_runtime.h>
#include <hip/hip_cooperative_groups.h>
#include <cstdio>
#include <cstdint>
#include <cmath>
namespace cg = cooperative_groups;
namespace pg8 {
#define PG8_LAS __attribute__((address_space(3)))
typedef unsigned short bf16_t;
typedef short bf16x8 __attribute__((ext_vector_type(8)));
typedef float f32x4 __attribute__((ext_vector_type(4)));
typedef unsigned u32x4 __attribute__((ext_vector_type(4)));
constexpr int BM = 256, BK = 64, HALF = 128, HTB = HALF * BK * 2  , STAGE_BYTES = 8 * HTB, NXCD = 8, WGM = 8;

__host__ __device__ __forceinline__ int lds_byte(int r, int c) { const int st = (r >> 4) * 2 + (c >> 5), rr = r & 15, cc = c & 31, ob = rr * 64 + cc * 2; return st * 1024 + (ob ^ (((ob >> 9) & 1) << 5)); }
__host__ __device__ __forceinline__ void stage_rc(int b, int& R, int& C) { const int st = b / 1024, sb = b % 1024, swz = sb ^ (((sb >> 9) & 1) << 5); R = (st >> 1) * 16 + swz / 64; C = (st & 1) * 32 + (swz % 64) / 2; }
__host__ __device__ __forceinline__ int perm32(int rho) { const int n = rho >> 4, i = rho & 15; return 8 * (i >> 2) + 4 * n + (i & 3); }

__device__ __forceinline__ int lane_id_asm() { int l; asm volatile("v_mbcnt_lo_u32_b32 %0, -1, 0\n\tv_mbcnt_hi_u32_b32 %0, -1, %0" : "=v"(l)); return l; }
struct Unit { int pm, pn; };
struct Gemm { const bf16_t* A; const bf16_t* Bt; int M, N, K; };

struct StaticOrder {
    int nM, nN, nwg, G, c;
    __host__ __device__ void init(int M, int N, int G_, int c_) { nM = M / BM; nN = N / BM; nwg = nM * nN; G = G_; c = c_; }
    __host__ __device__ bool next(int i, Unit& u) const {
        const long L = (long)i * G + c; if (L >= nwg) return false;
        int wgid = (int)L; { const int q = nwg / NXCD, r = nwg % NXCD, xcd = wgid % NXCD, off = wgid / NXCD; wgid = (xcd < r ? xcd * (q + 1) : r * (q + 1) + (xcd - r) * q) + off; }
        const int nig = WGM * nN, gid = wgid / nig, fm = gid * WGM, gsz = (nM - fm) < WGM ? (nM - fm) : WGM;
        u.pm = fm + ((wgid % nig) % gsz); u.pn = (wgid % nig) / gsz; return true;
    }
    __device__ __forceinline__ void a_ready(const Unit&) const {}
    __device__ __forceinline__ void done(const Unit&) const {}
};

__device__ __forceinline__ unsigned cvt_pk_bf16(float lo, float hi) { unsigned r; asm volatile("v_cvt_pk_bf16_f32 %0, %1, %2" : "=v"(r) : "v"(lo), "v"(hi)); return r; }
typedef float f32x2 __attribute__((ext_vector_type(2)));
template <class Epi, class Sched, bool ALIGN_EPI = false, bool SP2 = false>
__device__ __forceinline__ void gemm_phase(PG8_LAS unsigned char* lds, const Gemm g, const Sched& S, const Epi& E, const int wave_id) {
    int wid_ = wave_id; asm volatile("" : "+s"(wid_)); const int lane = lane_id_asm(), wid = wid_, tid = wid * 64 + lane, wr = wid >> 2, wc = wid & 3, fr = lane & 15, fq = lane >> 4;
    const int K = g.K, nt = K / BK;
    unsigned voffA[2], voffB[2];
#pragma unroll
    for (int i = 0; i < 2; ++i) { int R, C; stage_rc(tid * 16 + i * 8192, R, C); const int Rb = Epi::PERM ? ((R & ~31) + perm32(R & 31)) : R;
        voffA[i] = (unsigned)(R * K + C) * 2u; voffB[i] = (unsigned)(Rb * K + C) * 2u; }
    const size_t kstep = (size_t)(BK * 2);
    const size_t hstep = (size_t)HALF * K * 2;
    const size_t tstep = 2 * hstep;
    const unsigned ldsw = (unsigned)wid * 1024u;
    const int aoff = lds_byte(wr * 64 + fr, fq * 8), boff = lds_byte(wc * 32 + fr, fq * 8);
#define PG8_SA(b, h) (((b) * 2 + (h)) * HTB)
#define PG8_SB(b, h) ((4 + (b) * 2 + (h)) * HTB)
#define PG8_STAGE(bufoff, gbase, voff) do { _Pragma("unroll") for (int _i = 0; _i < 2; ++_i) \
        __builtin_amdgcn_global_load_lds((const unsigned*)((const char*)(gbase) + (voff)[_i]), (PG8_LAS unsigned*)(lds + (bufoff) + ldsw + _i * 8192), 16, 0, 0); } while (0)
#define PG8_LDA(dst, b, h) do { _Pragma("unroll") for (int m = 0; m < 4; ++m) _Pragma("unroll") for (int k = 0; k < 2; ++k) dst[m][k] = *(const PG8_LAS bf16x8*)(lds + PG8_SA(b, h) + aoff + m * 2048 + k * 1024); } while (0)
#define PG8_LDB(dst, b, h) do { _Pragma("unroll") for (int n = 0; n < 2; ++n) _Pragma("unroll") for (int k = 0; k < 2; ++k) dst[n][k] = *(const PG8_LAS bf16x8*)(lds + PG8_SB(b, h) + boff + n * 2048 + k * 1024); } while (0)
#define PG8_MMA(ai, bj, At, Bt) do { __builtin_amdgcn_s_setprio(1); _Pragma("unroll") for (int m = 0; m < 4; ++m) _Pragma("unroll") for (int n = 0; n < 2; ++n) _Pragma("unroll") for (int k = 0; k < 2; ++k) \
        acc[ai][bj][m][n] = __builtin_amdgcn_mfma_f32_16x16x32_bf16(Bt[n][k], At[m][k], acc[ai][bj][m][n], 0, 0, 0); __builtin_amdgcn_s_setprio(0); } while (0)
#define PG8_WAIT_V(n) asm volatile("s_waitcnt vmcnt(" #n ")" ::: "memory")
#define PG8_WAIT_L(n) asm volatile("s_waitcnt lgkmcnt(" #n ")" ::: "memory")
#define PG8_BAR __builtin_amdgcn_s_barrier()
#define PG8_SCHED __builtin_amdgcn_sched_barrier(0)
    Unit cur, nxt; int ui = 0;
    if (!S.next(0, cur)) return;
    f32x4 acc[2][2][4][2];
#pragma unroll
    for (int a = 0; a < 2; ++a)
#pragma unroll
        for (int b = 0; b < 2; ++b)
#pragma unroll
            for (int m = 0; m < 4; ++m)
#pragma unroll
                for (int n = 0; n < 2; ++n) acc[a][b][m][n] = (f32x4){0.f, 0.f, 0.f, 0.f};
    bf16x8 At[4][2], B0[2][2], B1[2][2];
    const char* cA = (const char*)g.A + (size_t)cur.pm * tstep; const char* cB = (const char*)g.Bt + (size_t)cur.pn * tstep;
    S.a_ready(cur);
    if constexpr (SP2) {
        PG8_STAGE(PG8_SB(0, 0), cB, voffB); PG8_STAGE(PG8_SB(0, 1), cB + hstep, voffB); PG8_STAGE(PG8_SA(0, 0), cA, voffA); PG8_STAGE(PG8_SA(0, 1), cA + hstep, voffA);
        if (wr == 1) PG8_BAR;
        PG8_WAIT_V(2); PG8_BAR;
        PG8_STAGE(PG8_SB(1, 0), cB + kstep, voffB); PG8_STAGE(PG8_SA(1, 0), cA + kstep, voffA); PG8_STAGE(PG8_SB(1, 1), cB + hstep + kstep, voffB);
        PG8_WAIT_V(6); PG8_BAR;
    } else {
        PG8_STAGE(PG8_SB(0, 0), cB, voffB); PG8_STAGE(PG8_SA(0, 0), cA, voffA); PG8_STAGE(PG8_SB(0, 1), cB + hstep, voffB); PG8_STAGE(PG8_SA(0, 1), cA + hstep, voffA);
        if (wr == 1) PG8_BAR;
        PG8_WAIT_V(4); PG8_BAR;
        PG8_STAGE(PG8_SB(1, 0), cB + kstep, voffB); PG8_STAGE(PG8_SA(1, 0), cA + kstep, voffA); PG8_STAGE(PG8_SB(1, 1), cB + hstep + kstep, voffB);
        PG8_WAIT_V(6); PG8_BAR;
    }
    for (;;) {
        const bool has_next = S.next(ui + 1, nxt);
        const char* nA = has_next ? (const char*)g.A + (size_t)nxt.pm * tstep : cA; const char* nB = has_next ? (const char*)g.Bt + (size_t)nxt.pn * tstep : cB;
        for (int t = 0; t < nt; t += 2) {
            const bool last = (t == nt - 2);
            const char* a1 = cA + (size_t)(t + 1) * kstep;
            const char* a2 = last ? nA : cA + (size_t)(t + 2) * kstep; const char* b2 = last ? nB : cB + (size_t)(t + 2) * kstep;
            const char* a3 = a2 + kstep; const char* b3 = b2 + kstep;
            if (last && has_next) S.a_ready(nxt);
            if constexpr (SP2) {
            PG8_LDB(B0, 0, 0); PG8_LDB(B1, 0, 1); PG8_SCHED; PG8_LDA(At, 0, 0); PG8_STAGE(PG8_SA(1, 1), a1 + hstep, voffA);
            PG8_WAIT_V(8); PG8_WAIT_L(0); PG8_BAR; PG8_MMA(0, 0, At, B0); PG8_MMA(0, 1, At, B1); PG8_BAR; PG8_SCHED;
            PG8_LDA(At, 0, 1); PG8_STAGE(PG8_SB(0, 0), b2, voffB); PG8_STAGE(PG8_SB(0, 1), b2 + hstep, voffB); PG8_STAGE(PG8_SA(0, 0), a2, voffA);
            PG8_WAIT_V(8); PG8_WAIT_L(0); PG8_BAR; PG8_MMA(1, 0, At, B0); PG8_MMA(1, 1, At, B1); PG8_BAR; PG8_SCHED;
            PG8_LDB(B0, 1, 0); PG8_LDB(B1, 1, 1); PG8_SCHED; PG8_LDA(At, 1, 0); PG8_STAGE(PG8_SA(0, 1), a2 + hstep, voffA);
            PG8_WAIT_V(8); PG8_WAIT_L(0); PG8_BAR; PG8_MMA(0, 0, At, B0); PG8_MMA(0, 1, At, B1); PG8_BAR; PG8_SCHED;
            PG8_LDA(At, 1, 1); PG8_STAGE(PG8_SB(1, 0), b3, voffB); PG8_STAGE(PG8_SB(1, 1), b3 + hstep, voffB); PG8_STAGE(PG8_SA(1, 0), a3, voffA);
            PG8_WAIT_V(8); PG8_WAIT_L(0); PG8_BAR; PG8_MMA(1, 0, At, B0); PG8_MMA(1, 1, At, B1); PG8_BAR; PG8_SCHED;
            } else {
            PG8_LDB(B0, 0, 0); PG8_SCHED; PG8_LDA(At, 0, 0); PG8_STAGE(PG8_SA(1, 1), a1 + hstep, voffA);
            PG8_WAIT_L(8); PG8_BAR; PG8_WAIT_L(0); PG8_MMA(0, 0, At, B0); PG8_BAR; PG8_SCHED;
            PG8_LDB(B1, 0, 1); PG8_STAGE(PG8_SB(0, 0), b2, voffB);
            PG8_BAR; PG8_WAIT_L(0); PG8_MMA(0, 1, At, B1); PG8_BAR;
            PG8_LDA(At, 0, 1); PG8_STAGE(PG8_SA(0, 0), a2, voffA);
            PG8_BAR; PG8_WAIT_L(0); PG8_MMA(1, 0, At, B0); PG8_BAR; PG8_SCHED;
            PG8_STAGE(PG8_SB(0, 1), b2 + hstep, voffB);
            PG8_WAIT_V(6); PG8_BAR; PG8_MMA(1, 1, At, B1); PG8_BAR;
            PG8_LDB(B0, 1, 0); PG8_SCHED; PG8_LDA(At, 1, 0); PG8_STAGE(PG8_SA(0, 1), a2 + hstep, voffA);
            PG8_WAIT_L(8); PG8_BAR; PG8_WAIT_L(0); PG8_MMA(0, 0, At, B0); PG8_BAR; PG8_SCHED;
            PG8_LDB(B1, 1, 1); PG8_STAGE(PG8_SB(1, 0), b3, voffB);
            PG8_BAR; PG8_WAIT_L(0); PG8_MMA(0, 1, At, B1); PG8_BAR;
            PG8_LDA(At, 1, 1); PG8_STAGE(PG8_SA(1, 0), a3, voffA);
            PG8_BAR; PG8_WAIT_L(0); PG8_MMA(1, 0, At, B0); PG8_BAR; PG8_SCHED;
            PG8_STAGE(PG8_SB(1, 1), b3 + hstep, voffB);
            PG8_WAIT_V(6); PG8_BAR; PG8_MMA(1, 1, At, B1); PG8_BAR;
            }
        }
        if constexpr (ALIGN_EPI) { if (wr == 0) PG8_BAR; }
        if constexpr (!Epi::AFTER_DRAIN) { E(acc, cur, wr, wc, fr, fq); S.done(cur); }
        if (!has_next) break;
#pragma unroll
        for (int a = 0; a < 2; ++a)
#pragma unroll
            for (int b = 0; b < 2; ++b)
#pragma unroll
                for (int m = 0; m < 4; ++m)
#pragma unroll
                    for (int n = 0; n < 2; ++n) acc[a][b][m][n] = (f32x4){0.f, 0.f, 0.f, 0.f};
        cur = nxt; cA = nA; cB = nB; ++ui;
        if constexpr (ALIGN_EPI) { if (wr == 1) PG8_BAR; }
    }
    PG8_WAIT_V(0);
    if constexpr (!ALIGN_EPI) { if (wr == 0) PG8_BAR; }
    PG8_BAR;
    if constexpr (Epi::AFTER_DRAIN) { E.fused(acc, cur, wr, wc, fr, fq, lds, wid, lane); S.done(cur); }
#undef PG8_SA
#undef PG8_SB
#undef PG8_STAGE
#undef PG8_LDA
#undef PG8_LDB
#undef PG8_MMA
#undef PG8_WAIT_V
#undef PG8_WAIT_L
#undef PG8_BAR
#undef PG8_SCHED
}
}

#define LAS __attribute__((address_space(3)))
#define GAS __attribute__((address_space(1)))
typedef unsigned short bf16_t;
typedef float f32x4 __attribute__((ext_vector_type(4)));
typedef float f32x16 __attribute__((ext_vector_type(16)));
typedef short bf16x8 __attribute__((ext_vector_type(8)));
typedef short s16x4 __attribute__((ext_vector_type(4)));
typedef unsigned u32x4 __attribute__((ext_vector_type(4)));
typedef unsigned u32x2 __attribute__((ext_vector_type(2)));

constexpr int M_TOK = 32768, DM = 1024, FF = 2816, SEQ = 8192;
constexpr float EPS = 1e-6f;
constexpr float QSCALE = 0.10206207261596575f * 1.4426950408889634f;
constexpr int NTHREADS = 512, NWAVES = 8;
constexpr size_t MiB = 1u << 20;
constexpr size_t WS_SS = 0, WS_SSV = 2 * MiB, WS_SSQ = 4 * MiB, WS_SSKV = 4 * MiB + 512 * 1024, WS_SSPE = 5 * MiB;
constexpr size_t WS_COS = 6 * MiB, WS_SIN = 8 * MiB, WS_KR = 10 * MiB;
constexpr size_t WS_XB = 16 * MiB;
constexpr size_t WS_WB = 80 * MiB;
constexpr size_t FFN_BYTES = 16 * MiB + 512 * 1024;
constexpr size_t W_CONV1 = WS_WB + 6 * FFN_BYTES;
constexpr size_t W_MLA_A = W_CONV1 + 8 * MiB, W_MLA_UQ = W_MLA_A + 1 * MiB, W_MLA_UKV = W_MLA_UQ + 1 * MiB, W_MLA_O = W_MLA_UKV + 1 * MiB;
constexpr size_t W_SG_IN = W_MLA_O + 2 * MiB, W_SG_OUT = W_SG_IN + 4 * MiB, W_SG_S = W_SG_OUT + 2 * MiB;
constexpr size_t WS_WL0 = 198 * MiB + 512 * 1024;
constexpr size_t W_CONV0 = WS_WL0 + 2 * FFN_BYTES;
static_assert(W_SG_S + 256 * 1024 <= WS_WL0, "weights map");
constexpr size_t WS_T = 240 * MiB;
static_assert(W_CONV0 + 8 * MiB <= WS_T, "weights map 2");
constexpr size_t T_H = WS_T;
constexpr size_t T_Z = WS_T, T_BG = WS_T + 64 * MiB, T_G = WS_T + 128 * MiB;
constexpr size_t T_Q = WS_T, T_K = WS_T + 96 * MiB, T_O = WS_T + 192 * MiB, T_AQ = T_O, T_AKV = T_O + 16 * MiB;
constexpr size_t WS_END = 512 * MiB;
static_assert(T_O + 64 * MiB <= WS_END && T_H + 176 * MiB <= WS_END, "temp map");
constexpr int RING_BYTES = 131072, EPI_OFF = RING_BYTES, LDS_BYTES = 147456;

__device__ __forceinline__ size_t ffn_w_off(int f) { return f < 2 ? WS_WL0 + (size_t)f * FFN_BYTES : WS_WB + (size_t)(f - 2) * FFN_BYTES; }
__device__ __forceinline__ size_t conv_w_off(int ia) { return ia == 0 ? W_CONV0 : W_CONV1; }

__device__ __forceinline__ unsigned cvtpk(float lo, float hi) { return pg8::cvt_pk_bf16(lo, hi); }
__device__ __forceinline__ u32x4 pack8(f32x4 a, f32x4 b) { u32x4 w; w.x = cvtpk(a[0], a[1]); w.y = cvtpk(a[2], a[3]); w.z = cvtpk(b[0], b[1]); w.w = cvtpk(b[2], b[3]); return w; }
__device__ __forceinline__ float bf_lo(unsigned w) { return __uint_as_float(w << 16); }
__device__ __forceinline__ float bf_hi(unsigned w) { return __uint_as_float(w & 0xffff0000u); }
__device__ __forceinline__ float dot4(f32x4 a) { return (a[0] * a[0] + a[1] * a[1]) + (a[2] * a[2] + a[3] * a[3]); }
__device__ __forceinline__ float wave_sum(float v) {
#pragma unroll
    for (int o = 1; o < 64; o <<= 1) v += __shfl_xor(v, o);
    return v;
}
__device__ __forceinline__ float swap32(float x, bool hi) { auto rr = __builtin_amdgcn_permlane32_swap(__float_as_uint(x), __float_as_uint(x), false, false); return __uint_as_float(hi ? rr[0] : rr[1]); }
__device__ __forceinline__ float red_fq(float s) { s += __shfl_xor(s, 16); s += __shfl_xor(s, 32); return s; }
__device__ __forceinline__ float row_rs16(const GAS float* ss, int row, int fq) {
    const f32x4 p = *(const GAS f32x4*)(ss + (size_t)row * 16 + 4 * fq);
    const float s = red_fq((p[0] + p[1]) + (p[2] + p[3]));
    return rsqrtf(s * (1.0f / 1024.0f) + EPS);
}
__device__ __forceinline__ float silu_f(float x) { return x * __builtin_amdgcn_rcpf(1.0f + __expf(-x)); }
__device__ __forceinline__ float gelu_tanh_f(float x) { const float u2 = 1.5957691216057308f * (x + 0.044715f * x * x * x); return x * __builtin_amdgcn_rcpf(1.0f + __expf(-u2)); }
#define EPI_FENCE() do { asm volatile("" ::: "memory"); __builtin_amdgcn_sched_barrier(0); } while (0)
#define EPI_BAR() do { asm volatile("s_waitcnt lgkmcnt(0)" ::: "memory"); __builtin_amdgcn_s_barrier(); EPI_FENCE(); } while (0)

typedef const pg8::f32x4 (&AccRef)[2][2][4][2];

struct EpiSwiglu {
    static constexpr bool PERM = true, AFTER_DRAIN = false;
    unsigned char* ws;
    __device__ __forceinline__ void operator()(AccRef acc, const pg8::Unit& u, int wr, int wc, int fr_in, int fq_in) const {
        const int lane_e = pg8::lane_id_asm(); const int fr = lane_e & 15, fq = lane_e >> 4; (void)fr_in; (void)fq_in;
        unsigned long long wi_ = (unsigned long long)ws; asm volatile("" : "+s"(wi_)); GAS unsigned char* w = (GAS unsigned char*)wi_;
        const GAS float* ss = (const GAS float*)(w + WS_SS); GAS bf16_t* H = (GAS bf16_t*)(w + T_H);
        const int rowb = u.pm * 256 + wr * 64 + fr, hcol = u.pn * 128 + wc * 32 + 8 * fq;
#pragma unroll
        for (int ai = 0; ai < 2; ++ai)
#pragma unroll
            for (int m = 0; m < 4; ++m) {
                const int row = rowb + ai * 128 + m * 16; const float rs = row_rs16(ss, row, fq);
                f32x4 h0, h1;
#pragma unroll
                for (int j = 0; j < 4; ++j) { h0[j] = silu_f(acc[ai][0][m][0][j] * rs) * (acc[ai][1][m][0][j] * rs); h1[j] = silu_f(acc[ai][0][m][1][j] * rs) * (acc[ai][1][m][1][j] * rs); }
                *(GAS u32x4*)(H + (size_t)row * FF + hcol) = pack8(h0, h1); EPI_FENCE();
            }
    }
};

struct EpiResid {
    static constexpr bool PERM = true, AFTER_DRAIN = false;
    const float* xin; float* xout; unsigned char* ws; float alpha;
    __device__ __forceinline__ void operator()(AccRef acc, const pg8::Unit& u, int wr, int wc, int fr_in, int fq_in) const {
        const int lane_e = pg8::lane_id_asm(); const int fr = lane_e & 15, fq = lane_e >> 4; (void)fr_in; (void)fq_in;
        unsigned long long wi_ = (unsigned long long)ws; asm volatile("" : "+s"(wi_)); GAS unsigned char* w = (GAS unsigned char*)wi_;
        GAS float* ss = (GAS float*)(w + WS_SS); GAS bf16_t* xb = (GAS bf16_t*)(w + WS_XB);
        const int rowb = u.pm * 256 + wr * 64 + fr, colb = u.pn * 256 + wc * 32 + 8 * fq;
#pragma unroll
        for (int ai = 0; ai < 2; ++ai)
#pragma unroll
            for (int m = 0; m < 4; ++m) {
                const int row = rowb + ai * 128 + m * 16; float sq = 0.f;
#pragma unroll
                for (int bj = 0; bj < 2; ++bj) {
                    const size_t off = (size_t)row * DM + colb + bj * 128;
                    const f32x4 x0 = *(const f32x4*)(xin + off), x1 = *(const f32x4*)(xin + off + 4);
                    const f32x4 y0 = x0 + acc[ai][bj][m][0] * alpha, y1 = x1 + acc[ai][bj][m][1] * alpha;
                    *(f32x4*)(xout + off) = y0; *(f32x4*)(xout + off + 4) = y1;
                    *(GAS u32x4*)(xb + off) = pack8(y0, y1);
                    sq += dot4(y0) + dot4(y1);
                }
                sq = red_fq(sq);
                if (fq == 0) ss[(size_t)row * 16 + u.pn * 4 + wc] = sq; EPI_FENCE();
            }
    }
};

struct EpiConvIn {
    static constexpr bool PERM = true, AFTER_DRAIN = false;
    unsigned char* ws;
    __device__ __forceinline__ void operator()(AccRef acc, const pg8::Unit& u, int wr, int wc, int fr_in, int fq_in) const {
        const int lane_e = pg8::lane_id_asm(); const int fr = lane_e & 15, fq = lane_e >> 4; (void)fr_in; (void)fq_in;
        unsigned long long wi_ = (unsigned long long)ws; asm volatile("" : "+s"(wi_)); GAS unsigned char* w = (GAS unsigned char*)wi_;
        const GAS float* ss = (const GAS float*)(w + WS_SS); GAS bf16_t* Z = (GAS bf16_t*)(w + T_Z); GAS bf16_t* Bg = (GAS bf16_t*)(w + T_BG);
        const int rowb = u.pm * 256 + wr * 64 + fr;
#pragma unroll
        for (int ai = 0; ai < 2; ++ai)
#pragma unroll
            for (int m = 0; m < 4; ++m) {
                const int row = rowb + ai * 128 + m * 16; const float rs = row_rs16(ss, row, fq);
                if (u.pn < 8) {
                    const float r2 = rs * rs;
                    const f32x4 z0 = acc[ai][0][m][0] * acc[ai][1][m][0] * r2, z1 = acc[ai][0][m][1] * acc[ai][1][m][1] * r2;
                    *(GAS u32x4*)(Z + (size_t)row * DM + u.pn * 128 + wc * 32 + 8 * fq) = pack8(z0, z1);
                } else {
#pragma unroll
                    for (int bj = 0; bj < 2; ++bj)
                        *(GAS u32x4*)(Bg + (size_t)row * DM + (u.pn - 8) * 256 + bj * 128 + wc * 32 + 8 * fq) = pack8(acc[ai][bj][m][0] * rs, acc[ai][bj][m][1] * rs);
                }
                EPI_FENCE();
            }
    }
};

struct EpiMlaA {
    static constexpr bool PERM = true, AFTER_DRAIN = false;
    unsigned char* ws;
    __device__ __forceinline__ void operator()(AccRef acc, const pg8::Unit& u, int wr, int wc, int fr_in, int fq_in) const {
        const int lane_e = pg8::lane_id_asm(); const int fr = lane_e & 15, fq = lane_e >> 4; (void)fr_in; (void)fq_in;
        unsigned long long wi_ = (unsigned long long)ws; asm volatile("" : "+s"(wi_)); GAS unsigned char* w = (GAS unsigned char*)wi_;
        const GAS float* ss = (const GAS float*)(w + WS_SS); GAS bf16_t* Aq = (GAS bf16_t*)(w + T_AQ); GAS bf16_t* Akv = (GAS bf16_t*)(w + T_AKV); GAS float* ssq = (GAS float*)(w + WS_SSQ); GAS float* sskv = (GAS float*)(w + WS_SSKV);
        GAS float* sspe = (GAS float*)(w + WS_SSPE); GAS float* kr = (GAS float*)(w + WS_KR); const GAS float* cosT = (const GAS float*)(w + WS_COS); const GAS float* sinT = (const GAS float*)(w + WS_SIN);
        const int rowb = u.pm * 256 + wr * 64 + fr;
#pragma unroll
        for (int ai = 0; ai < 2; ++ai)
#pragma unroll
            for (int m = 0; m < 4; ++m) {
                const int row = rowb + ai * 128 + m * 16; const float rs = row_rs16(ss, row, fq);
                const f32x4 a00 = acc[ai][0][m][0] * rs, a01 = acc[ai][0][m][1] * rs, a10 = acc[ai][1][m][0] * rs, a11 = acc[ai][1][m][1] * rs;
                GAS bf16_t* dst = (u.pn == 0 ? Aq : Akv) + (size_t)row * 256 + wc * 32 + 8 * fq;
                *(GAS u32x4*)(dst) = pack8(a00, a01); *(GAS u32x4*)(dst + 128) = pack8(a10, a11);
                if (u.pn == 0) {
                    const float sq = red_fq(dot4(a00) + dot4(a01) + dot4(a10) + dot4(a11));
                    if (fq == 0) ssq[(size_t)row * 4 + wc] = sq;
                } else {
                    const float sq = red_fq(dot4(a00) + dot4(a01));
                    if (fq == 0) sskv[(size_t)row * 4 + wc] = sq;
                    if (wc == 0) {
                        *(GAS f32x4*)(kr + (size_t)row * 32 + 8 * fq) = a10; *(GAS f32x4*)(kr + (size_t)row * 32 + 8 * fq + 4) = a11;
                    }
                }
                EPI_FENCE();
            }
    }
};

struct EpiQ {
    static constexpr bool PERM = true, AFTER_DRAIN = false;
    unsigned char* ws;
    __device__ __forceinline__ void operator()(AccRef acc, const pg8::Unit& u, int wr, int wc, int fr_in, int fq_in) const {
        const int lane_e = pg8::lane_id_asm(); const int fr = lane_e & 15, fq = lane_e >> 4; (void)fr_in; (void)fq_in;
        unsigned long long wi_ = (unsigned long long)ws; asm volatile("" : "+s"(wi_)); GAS unsigned char* w = (GAS unsigned char*)wi_;
        const GAS float* ssq = (const GAS float*)(w + WS_SSQ); GAS bf16_t* Q = (GAS bf16_t*)(w + T_Q);
        const int rowb = u.pm * 256 + wr * 64 + fr;
        if (wc < 3) {
#pragma unroll
            for (int ai = 0; ai < 2; ++ai)
#pragma unroll
                for (int m = 0; m < 4; ++m) {
                    const int row = rowb + ai * 128 + m * 16, b = row >> 13, s = row & 8191;
                    const f32x4 pq = *(const GAS f32x4*)(ssq + (size_t)row * 4);
                    const float rq = rsqrtf(((pq[0] + pq[1]) + (pq[2] + pq[3])) * (1.0f / 256.0f) + EPS);
#pragma unroll
                    for (int bj = 0; bj < 2; ++bj) {
                        const int head = u.pn * 2 + bj;
                        *(GAS u32x4*)(Q + (unsigned)(((b * 16 + head) * SEQ + s) * 96 + wc * 32 + 8 * fq)) = pack8(acc[ai][bj][m][0] * rq, acc[ai][bj][m][1] * rq);
                    }
                    EPI_FENCE();
                }
        }
    }
};

struct EpiKV {
    static constexpr bool PERM = true, AFTER_DRAIN = false;
    unsigned char* ws;
    __device__ __forceinline__ void operator()(AccRef acc, const pg8::Unit& u, int wr, int wc, int fr_in, int fq_in) const {
        const int lane_e = pg8::lane_id_asm(); const int fr = lane_e & 15, fq = lane_e >> 4; (void)fr_in; (void)fq_in;
        unsigned long long wi_ = (unsigned long long)ws; asm volatile("" : "+s"(wi_)); GAS unsigned char* w = (GAS unsigned char*)wi_;
        const GAS float* sskv = (const GAS float*)(w + WS_SSKV); GAS bf16_t* K = (GAS bf16_t*)(w + T_K); GAS bf16_t* Vt = (GAS bf16_t*)(w + WS_XB);
        const int rowb = u.pm * 256 + wr * 64 + fr;
#pragma unroll
        for (int ai = 0; ai < 2; ++ai)
#pragma unroll
            for (int m = 0; m < 4; ++m) {
                const int row = rowb + ai * 128 + m * 16, b = row >> 13, s = row & 8191;
                const f32x4 pk = *(const GAS f32x4*)(sskv + (size_t)row * 4);
                const float r = rsqrtf(((pk[0] + pk[1]) + (pk[2] + pk[3])) * (1.0f / 128.0f) + EPS);
#pragma unroll
                for (int bj = 0; bj < 2; ++bj) {
                    const int head = u.pn * 2 + bj; const unsigned bh = (unsigned)(b * 16 + head);
                    const u32x4 wv = pack8(acc[ai][bj][m][0] * r, acc[ai][bj][m][1] * r);
                    if (wc < 2) {
                        *(GAS u32x4*)(K + ((bh * SEQ + s) * 96u + wc * 32 + 8 * fq)) = wv;
                    } else {
                        GAS bf16_t* vp = Vt + (bh * 64 + (wc - 2) * 32 + 8 * fq) * SEQ + s;
                        vp[0 * SEQ] = (bf16_t)(wv.x & 0xffff); vp[1 * SEQ] = (bf16_t)(wv.x >> 16); vp[2 * SEQ] = (bf16_t)(wv.y & 0xffff); vp[3 * SEQ] = (bf16_t)(wv.y >> 16);
                        vp[4 * SEQ] = (bf16_t)(wv.z & 0xffff); vp[5 * SEQ] = (bf16_t)(wv.z >> 16); vp[6 * SEQ] = (bf16_t)(wv.w & 0xffff); vp[7 * SEQ] = (bf16_t)(wv.w >> 16);
                    }
                }
                EPI_FENCE();
            }
    }
};

struct EpiSgIn {
    static constexpr bool PERM = true, AFTER_DRAIN = false;
    unsigned char* ws;
    __device__ __forceinline__ void operator()(AccRef acc, const pg8::Unit& u, int wr, int wc, int fr_in, int fq_in) const {
        const int lane_e = pg8::lane_id_asm(); const int fr = lane_e & 15, fq = lane_e >> 4; (void)fr_in; (void)fq_in;
        unsigned long long wi_ = (unsigned long long)ws; asm volatile("" : "+s"(wi_)); GAS unsigned char* w = (GAS unsigned char*)wi_;
        const GAS float* ss = (const GAS float*)(w + WS_SS); GAS bf16_t* U = (GAS bf16_t*)(w + T_Z); GAS bf16_t* V = (GAS bf16_t*)(w + T_BG); GAS float* ssv = (GAS float*)(w + WS_SSV);
        const int rowb = u.pm * 256 + wr * 64 + fr;
        GAS bf16_t* dstb = (u.pn < 4 ? U + u.pn * 256 : V + (u.pn - 4) * 256) + wc * 32 + 8 * fq;
#pragma unroll
        for (int ai = 0; ai < 2; ++ai)
#pragma unroll
            for (int m = 0; m < 4; ++m) {
                const int row = rowb + ai * 128 + m * 16; const float rs = row_rs16(ss, row, fq); float sq = 0.f;
#pragma unroll
                for (int bj = 0; bj < 2; ++bj) {
                    f32x4 z0, z1;
#pragma unroll
                    for (int j = 0; j < 4; ++j) { z0[j] = gelu_tanh_f(acc[ai][bj][m][0][j] * rs); z1[j] = gelu_tanh_f(acc[ai][bj][m][1][j] * rs); }
                    *(GAS u32x4*)(dstb + (size_t)row * DM + bj * 128) = pack8(z0, z1);
                    sq += dot4(z0) + dot4(z1);
                }
                if (u.pn >= 4) { sq = red_fq(sq); if (fq == 0) ssv[(size_t)row * 16 + (u.pn - 4) * 4 + wc] = sq; } EPI_FENCE();
            }
    }
};

__device__ __forceinline__ int map_row(int kind, int n0) {
    switch (kind) {
        case 1: return (n0 >> 7) * 256 + (n0 & 127);
        case 2: return (n0 >> 7) * 256 + 128 + (n0 & 127);
        case 3: if (n0 < 1024) return 2048 + n0;
                if (n0 < 2048) { const int c = n0 - 1024; return (c >> 7) * 256 + (c & 127); }
                { const int c = n0 - 2048; return (c >> 7) * 256 + 128 + (c & 127); }
        case 4: return (n0 / 96) * 128 + (n0 % 96);
        default: return n0;
    }
}
__device__ __forceinline__ void tr_item(const float* __restrict__ W, int K, int N, bf16_t* __restrict__ WT, int pitch, const float* __restrict__ scale, int kind, LAS float* scr, int item, int lane) {
    const int nblk = N >> 5, kb = item / nblk, nb = item - kb * nblk, k0 = 64 * kb, n0 = 32 * nb, dr0 = map_row(kind, n0);
#pragma unroll 8
    for (int i = 0; i < 32; ++i) { const int kk = 2 * i + (lane >> 5); float v = W[(size_t)(k0 + kk) * N + n0 + (lane & 31)]; if (scale) v *= scale[k0 + kk]; scr[kk * 33 + (lane & 31)] = v; }
    asm volatile("s_waitcnt lgkmcnt(0)" ::: "memory");
    const int c = lane & 7;
#pragma unroll
    for (int j = 0; j < 4; ++j) { const int n = (lane >> 3) + 8 * j; const LAS float* s = scr + (8 * c) * 33 + n;
        u32x4 o; o.x = cvtpk(s[0 * 33], s[1 * 33]); o.y = cvtpk(s[2 * 33], s[3 * 33]); o.z = cvtpk(s[4 * 33], s[5 * 33]); o.w = cvtpk(s[6 * 33], s[7 * 33]);
        *(u32x4*)(WT + (size_t)(dr0 + n) * pitch + k0 + 8 * c) = o; }
    asm volatile("s_waitcnt lgkmcnt(0)" ::: "memory");
}

struct Args {
    const float* in[22]; float* out; unsigned char* ws; float inv_freq[16]; int ph_lo, ph_hi;
};

__device__ __forceinline__ void prologue(const Args& a, LAS unsigned char* lds, int vcu, int G, int wave, int lane, int tid) {
    unsigned char* ws = a.ws;
    LAS float* scr = (LAS float*)(lds + wave * 16384);
    const int gw = vcu * NWAVES + wave, NGW = G * NWAVES;
    const float* norm_g = a.in[2];
    constexpr int I_FFN = 8 * 4224, I_CONV = 2 * 2048, I_MLA = 1040, I_SG = 1536, NITEMS = I_FFN + I_CONV + I_MLA + I_SG;
    for (int it = gw; it < NITEMS; it += NGW) {
        int r = it;
        if (r < I_FFN) {
            const int f = r / 4224, q = r % 4224, which = q / 1408, item = q % 1408, i = f >> 1, j = f & 1;
            bf16_t* wgu = (bf16_t*)(ws + ffn_w_off(f)); bf16_t* wd = wgu + (size_t)5632 * 1024;
            const float* g = norm_g + (size_t)(i * 3 + (j ? 2 : 0)) * 1024;
            if (which == 0) tr_item(a.in[3] + (size_t)f * 1024 * 2816, 1024, 2816, wgu, 1024, g, 1, scr, item, lane);
            else if (which == 1) tr_item(a.in[4] + (size_t)f * 1024 * 2816, 1024, 2816, wgu, 1024, g, 2, scr, item, lane);
            else tr_item(a.in[5] + (size_t)f * 2816 * 1024, 2816, 1024, wd, 2816, nullptr, 0, scr, item, lane);
            continue;
        }
        r -= I_FFN;
        if (r < I_CONV) {
            const int ia = r / 2048, q = r % 2048, li = ia == 0 ? 0 : 3;
            bf16_t* win = (bf16_t*)(ws + conv_w_off(ia)); bf16_t* wout = win + (size_t)3072 * 1024;
            if (q < 1536) tr_item(a.in[6] + (size_t)ia * 1024 * 3072, 1024, 3072, win, 1024, norm_g + (size_t)(li * 3 + 1) * 1024, 3, scr, q, lane);
            else tr_item(a.in[8] + (size_t)ia * 1024 * 1024, 1024, 1024, wout, 1024, nullptr, 0, scr, q - 1536, lane);
            continue;
        }
        r -= I_CONV;
        if (r < I_MLA) {
            if (r < 208) { tr_item(a.in[9], 1024, 416, (bf16_t*)(ws + W_MLA_A), 1024, norm_g + (size_t)(1 * 3 + 1) * 1024, 0, scr, r, lane); continue; }
            r -= 208;
            if (r < 192) { tr_item(a.in[11], 256, 1536, (bf16_t*)(ws + W_MLA_UQ), 256, a.in[10], 4, scr, r, lane); continue; }
            r -= 192;
            if (r < 128) { tr_item(a.in[13], 128, 2048, (bf16_t*)(ws + W_MLA_UKV), 256, a.in[12], 0, scr, r, lane); continue; }
            r -= 128;
            tr_item(a.in[16], 1024, 1024, (bf16_t*)(ws + W_MLA_O), 1024, nullptr, 0, scr, r, lane);
            continue;
        }
        r -= I_MLA;
        if (r < 1024) tr_item(a.in[17], 1024, 2048, (bf16_t*)(ws + W_SG_IN), 1024, norm_g + (size_t)(2 * 3 + 1) * 1024, 0, scr, r, lane);
        else tr_item(a.in[21], 1024, 1024, (bf16_t*)(ws + W_SG_OUT), 1024, nullptr, 0, scr, r - 1024, lane);
    }
    const int gt = vcu * NTHREADS + tid, NGT = G * NTHREADS;
    const u32x4 z4 = {0u, 0u, 0u, 0u};
    for (int p = gt; p < 12288; p += NGT) *(u32x4*)(ws + W_MLA_A + (size_t)416 * 2048 + (size_t)p * 16) = z4;
    for (int p = gt; p < 16384; p += NGT) { const int h = p >> 10, off = p & 1023; *(u32x4*)(ws + W_MLA_UQ + (size_t)(128 * h + 96) * 512 + (size_t)off * 16) = z4; }
    for (int p = gt; p < 32768; p += NGT) { const int row = p >> 4, c = p & 15; *(u32x4*)(ws + W_MLA_UKV + (size_t)row * 512 + 256 + c * 16) = z4; }
    for (int p = gt; p < 16384; p += NGT) {
        const int t = (p >> 4) & 127, s0 = (p & 15) * 8; const float* src = a.in[19] + (size_t)p * 8;
        const f32x4 w0 = *(const f32x4*)src, w1 = *(const f32x4*)(src + 4); f32x4 m0, m1;
#pragma unroll
        for (int j = 0; j < 4; ++j) { m0[j] = (s0 + j <= t) ? w0[j] : 0.f; m1[j] = (s0 + 4 + j <= t) ? w1[j] : 0.f; }
        *(u32x4*)(ws + W_SG_S + (size_t)p * 16) = pack8(m0, m1);
    }
    {
        const int* pos = (const int*)a.in[1]; float* cosT = (float*)(ws + WS_COS); float* sinT = (float*)(ws + WS_SIN);
        for (int p = gt; p < M_TOK * 16; p += NGT) {
            const int row = p >> 4, i = p & 15; const float ang = (float)pos[row] * a.inv_freq[i];
            const double ad = (double)ang, k = rint(ad * 0.15915494309189535); const float rr = (float)(ad - k * 6.283185307179586);
            cosT[p] = cosf(rr); sinT[p] = sinf(rr);
        }
    }
    {
        const float* x = a.in[0]; bf16_t* xb = (bf16_t*)(ws + WS_XB); float* ss = (float*)(ws + WS_SS);
        for (int row = gw; row < M_TOK; row += NGW) {
            const f32x4* xr = (const f32x4*)(x + (size_t)row * DM) + lane; f32x4 v[4]; float s = 0.f;
#pragma unroll
            for (int j = 0; j < 4; ++j) { v[j] = xr[64 * j]; s += dot4(v[j]); }
            s = wave_sum(s);
            u32x2* o = (u32x2*)(xb + (size_t)row * DM) + lane;
#pragma unroll
            for (int j = 0; j < 4; ++j) { u32x2 w; w.x = cvtpk(v[j][0], v[j][1]); w.y = cvtpk(v[j][2], v[j][3]); o[64 * j] = w; }
            if (lane < 16) ss[(size_t)row * 16 + lane] = lane == 0 ? s : 0.f;
        }
    }
}

__device__ __forceinline__ void unpack8(u32x4 w, float (&f)[8]) { f[0] = bf_lo(w.x); f[1] = bf_hi(w.x); f[2] = bf_lo(w.y); f[3] = bf_hi(w.y); f[4] = bf_lo(w.z); f[5] = bf_hi(w.z); f[6] = bf_lo(w.w); f[7] = bf_hi(w.w); }
__device__ __forceinline__ void conv_phase(const bf16_t* __restrict__ Z, const bf16_t* __restrict__ Bg, const float* __restrict__ ck, bf16_t* __restrict__ Gout, int gt, int NGT) {
    for (int it = gt; it < 2048 * 128; it += NGT) {
        const int cg8 = (it & 127) * 8, row0 = (it >> 7) * 16;
        float k0[8], k1[8], k2[8], zm2[8], zm1[8];
#pragma unroll
        for (int j = 0; j < 8; ++j) { k0[j] = ck[cg8 + j]; k1[j] = ck[1024 + cg8 + j]; k2[j] = ck[2048 + cg8 + j]; }
        if ((row0 & 8191) == 0) {
#pragma unroll
            for (int j = 0; j < 8; ++j) { zm2[j] = 0.f; zm1[j] = 0.f; }
        } else {
            unpack8(*(const u32x4*)(Z + (size_t)(row0 - 2) * DM + cg8), zm2); unpack8(*(const u32x4*)(Z + (size_t)(row0 - 1) * DM + cg8), zm1);
        }
#pragma unroll 4
        for (int r = 0; r < 16; ++r) {
            const size_t off = (size_t)(row0 + r) * DM + cg8; float z[8], b[8]; f32x4 o0, o1;
            unpack8(*(const u32x4*)(Z + off), z); unpack8(*(const u32x4*)(Bg + off), b);
#pragma unroll
            for (int j = 0; j < 4; ++j) { o0[j] = b[j] * (k0[j] * zm2[j] + k1[j] * zm1[j] + k2[j] * z[j]); o1[j] = b[4 + j] * (k0[4 + j] * zm2[4 + j] + k1[4 + j] * zm1[4 + j] + k2[4 + j] * z[4 + j]); }
            *(u32x4*)(Gout + off) = pack8(o0, o1);
#pragma unroll
            for (int j = 0; j < 8; ++j) { zm2[j] = zm1[j]; zm1[j] = z[j]; }
        }
    }
}

__device__ __forceinline__ void sg_phase(LAS unsigned char* lds, const bf16_t* __restrict__ U, const bf16_t* __restrict__ V, const float* __restrict__ ssv, const float* __restrict__ vnorm,
                                         const bf16_t* __restrict__ wsm, const float* __restrict__ bs, bf16_t* __restrict__ G2, int vcu, int G, const int wave_s) {
    constexpr int ROWB = 272, BOFF = 128 * ROWB;
    const int lane = pg8::lane_id_asm(), wid = wave_s, tid = wid * 64 + lane, fr = lane & 15, fq = lane >> 4;
    for (int u = vcu; u < 2048; u += G) {
        const int c = u >> 3, g = u & 7;
        for (int p = tid; p < 2048; p += NTHREADS) { const int t = p >> 4, cc = p & 15; *(LAS u32x4*)(lds + t * ROWB + cc * 16) = *(const u32x4*)(wsm + (size_t)g * 16384 + t * 128 + cc * 8); }
        for (int p = tid; p < 2048; p += NTHREADS) {
            const int s = p >> 4, cg8 = (p & 15) * 8, row = 128 * c + s;
            float v[8]; unpack8(*(const u32x4*)(V + (size_t)row * DM + 128 * g + cg8), v);
            const f32x4* sp = (const f32x4*)(ssv + (size_t)row * 16); const f32x4 a0 = sp[0], a1 = sp[1], a2 = sp[2], a3 = sp[3];
            const float tot = ((a0[0] + a0[1]) + (a0[2] + a0[3])) + ((a1[0] + a1[1]) + (a1[2] + a1[3])) + ((a2[0] + a2[1]) + (a2[2] + a2[3])) + ((a3[0] + a3[1]) + (a3[2] + a3[3]));
            const float rsv = rsqrtf(tot * (1.0f / 1024.0f) + EPS);
            const f32x4 n0 = *(const f32x4*)(vnorm + 128 * g + cg8), n1 = *(const f32x4*)(vnorm + 128 * g + cg8 + 4);
#pragma unroll
            for (int j = 0; j < 4; ++j) {
                const unsigned w = cvtpk(v[j] * rsv * n0[j], v[4 + j] * rsv * n1[j]);
                *(LAS bf16_t*)(lds + BOFF + (cg8 + j) * ROWB + s * 2) = (bf16_t)(w & 0xffff);
                *(LAS bf16_t*)(lds + BOFF + (cg8 + 4 + j) * ROWB + s * 2) = (bf16_t)(w >> 16);
            }
        }
        __syncthreads();
        f32x4 acc[8];
#pragma unroll
        for (int nb = 0; nb < 8; ++nb) acc[nb] = (f32x4){0.f, 0.f, 0.f, 0.f};
#pragma unroll
        for (int ks = 0; ks < 4; ++ks) {
            const bf16x8 wa = *(const LAS bf16x8*)(lds + (16 * wid + fr) * ROWB + (32 * ks + 8 * fq) * 2);
#pragma unroll
            for (int nb = 0; nb < 8; ++nb) {
                const bf16x8 vb = *(const LAS bf16x8*)(lds + BOFF + (16 * nb + fr) * ROWB + (32 * ks + 8 * fq) * 2);
                acc[nb] = __builtin_amdgcn_mfma_f32_16x16x32_bf16(vb, wa, acc[nb], 0, 0, 0);
            }
        }
        {
            const int t = 16 * wid + fr, row = 128 * c + t; const float bias = bs[g * 128 + t];
#pragma unroll
            for (int nb = 0; nb < 8; ++nb) {
                const size_t off = (size_t)row * DM + 128 * g + 16 * nb + 4 * fq;
                const u32x2 uu = *(const u32x2*)(U + off);
                u32x2 o; o.x = cvtpk(bf_lo(uu.x) * (acc[nb][0] + bias), bf_hi(uu.x) * (acc[nb][1] + bias)); o.y = cvtpk(bf_lo(uu.y) * (acc[nb][2] + bias), bf_hi(uu.y) * (acc[nb][3] + bias));
                *(u32x2*)(G2 + off) = o;
            }
        }
        __syncthreads();
    }
}

__device__ __forceinline__ void qk_finalize(bf16_t* __restrict__ Q, bf16_t* __restrict__ K, const float* __restrict__ kpe, const float* __restrict__ qgain, const float* __restrict__ kgain,
                                            const float* __restrict__ cosT, const float* __restrict__ sinT, int gt, int NGT) {
    for (int it = gt; it < 2 * 16 * M_TOK; it += NGT) {
        const bool isk = it >= 16 * M_TOK; const int rh = isk ? it - 16 * M_TOK : it;
        const int bh = rh >> 13, s = rh & 8191, row = (bh >> 4) * SEQ + s;
        bf16_t* p = (isk ? K : Q) + (size_t)rh * 96; const float* gain = isk ? kgain : qgain;
        float v[96];
        if (!isk) {
#pragma unroll
            for (int c = 0; c < 12; ++c) { const u32x4 w = *(const u32x4*)(p + 8 * c); v[8 * c] = bf_lo(w.x); v[8 * c + 1] = bf_hi(w.x); v[8 * c + 2] = bf_lo(w.y); v[8 * c + 3] = bf_hi(w.y); v[8 * c + 4] = bf_lo(w.z); v[8 * c + 5] = bf_hi(w.z); v[8 * c + 6] = bf_lo(w.w); v[8 * c + 7] = bf_hi(w.w); }
        } else {
#pragma unroll
            for (int c = 0; c < 8; ++c) { const u32x4 w = *(const u32x4*)(p + 8 * c); v[8 * c] = bf_lo(w.x); v[8 * c + 1] = bf_hi(w.x); v[8 * c + 2] = bf_lo(w.y); v[8 * c + 3] = bf_hi(w.y); v[8 * c + 4] = bf_lo(w.z); v[8 * c + 5] = bf_hi(w.z); v[8 * c + 6] = bf_lo(w.w); v[8 * c + 7] = bf_hi(w.w); }
#pragma unroll
            for (int c = 0; c < 8; ++c) { const f32x4 w = *(const f32x4*)(kpe + (size_t)row * 32 + 4 * c); v[64 + 4 * c] = w[0]; v[64 + 4 * c + 1] = w[1]; v[64 + 4 * c + 2] = w[2]; v[64 + 4 * c + 3] = w[3]; }
        }
        float ss = 0.f;
#pragma unroll
        for (int d = 0; d < 96; ++d) ss += v[d] * v[d];
        const float rsh = rsqrtf(ss * (1.0f / 96.0f) + EPS), osc = isk ? 1.0f : QSCALE;
#pragma unroll
        for (int d = 0; d < 96; ++d) v[d] *= rsh * gain[d];
#pragma unroll
        for (int c = 0; c < 4; ++c) {
            const f32x4 cs = *(const f32x4*)(cosT + (size_t)row * 16 + 4 * c), sn = *(const f32x4*)(sinT + (size_t)row * 16 + 4 * c);
#pragma unroll
            for (int j = 0; j < 4; ++j) { const int i = 4 * c + j; const float t1 = v[64 + i], t2 = v[80 + i]; v[64 + i] = t1 * cs[j] - t2 * sn[j]; v[80 + i] = t2 * cs[j] + t1 * sn[j]; }
        }
#pragma unroll
        for (int c = 0; c < 12; ++c) {
            u32x4 w; w.x = cvtpk(v[8 * c] * osc, v[8 * c + 1] * osc); w.y = cvtpk(v[8 * c + 2] * osc, v[8 * c + 3] * osc); w.z = cvtpk(v[8 * c + 4] * osc, v[8 * c + 5] * osc); w.w = cvtpk(v[8 * c + 6] * osc, v[8 * c + 7] * osc);
            *(u32x4*)(p + 8 * c) = w;
        }
    }
}

__device__ __forceinline__ void attn_phase(LAS unsigned char* lds, const bf16_t* __restrict__ Q, const bf16_t* __restrict__ K, const bf16_t* __restrict__ Vt, bf16_t* __restrict__ O, int vcu, int G, const int wave_s) {
    constexpr int KROW = 208, VROW = 136, KBUF = 64 * KROW, VBUF = 64 * VROW, VOFF = 2 * KBUF;
    const int lane = pg8::lane_id_asm(), wid = wave_s, tid = wid * 64 + lane, r32 = lane & 31, hi = lane >> 5;
    const int kp0r = tid / 12, kp0c = tid % 12, kp1r = (512 + tid) / 12, kp1c = (512 + tid) % 12, vdv = tid >> 3, vc = tid & 7;
    for (int u = vcu; u < 2048; u += G) {
        const int v = u & 255, i = u >> 8, bh = v >> 2, s4 = v & 3, pr = i >> 1, qb = (i & 1) ? 8 * pr + 7 - s4 : 8 * pr + s4;
        const int q0 = qb * 256, NT = (q0 + 256) / 64, qw0 = q0 + 32 * wid, qabs = qw0 + r32;
        const bf16_t* Qp = Q + ((size_t)bh * SEQ + qabs) * 96 + 8 * hi;
        bf16x8 qf[6];
#pragma unroll
        for (int ds = 0; ds < 6; ++ds) qf[ds] = *(const bf16x8*)(Qp + 16 * ds);
        const bf16_t* Kb = K + (size_t)bh * SEQ * 96; const bf16_t* Vb = Vt + (size_t)bh * 64 * SEQ + (size_t)vdv * SEQ + vc * 8;
        u32x4 kr0, kr1 = {0u, 0u, 0u, 0u}, vr;
#define ATT_LOAD(t) do { const bf16_t* kt_ = Kb + (size_t)(t) * 6144; kr0 = *(const u32x4*)(kt_ + tid * 8); if (tid < 256) kr1 = *(const u32x4*)(kt_ + (512 + tid) * 8); vr = *(const u32x4*)(Vb + (t) * 64); } while (0)
#define ATT_STORE(bf) do { LAS unsigned char* kb_ = lds + (bf) * KBUF; *(LAS u32x4*)(kb_ + kp0r * KROW + kp0c * 16) = kr0; if (tid < 256) *(LAS u32x4*)(kb_ + kp1r * KROW + kp1c * 16) = kr1; \
        LAS unsigned char* vb_ = lds + VOFF + (bf) * VBUF + vdv * VROW + vc * 16; *(LAS u32x2*)(vb_) = (u32x2){vr.x, vr.y}; *(LAS u32x2*)(vb_ + 8) = (u32x2){vr.z, vr.w}; } while (0)
        float m_run = -INFINITY, l_run = 0.f; f32x16 o0, o1;
#pragma unroll
        for (int r = 0; r < 16; ++r) { o0[r] = 0.f; o1[r] = 0.f; }
        ATT_LOAD(0); ATT_STORE(0); __syncthreads();
        for (int t = 0; t < NT; ++t) {
            const int cur = t & 1;
            if (t + 1 < NT) ATT_LOAD(t + 1);
            if (64 * t <= qw0 + 31) {
                const LAS unsigned char* kb = lds + cur * KBUF + r32 * KROW + hi * 16;
                f32x16 p0, p1;
#pragma unroll
                for (int r = 0; r < 16; ++r) { p0[r] = 0.f; p1[r] = 0.f; }
#pragma unroll
                for (int ds = 0; ds < 6; ++ds) {
                    const bf16x8 k0 = *(const LAS bf16x8*)(kb + ds * 32), k1 = *(const LAS bf16x8*)(kb + 32 * KROW + ds * 32);
                    p0 = __builtin_amdgcn_mfma_f32_32x32x16_bf16(k0, qf[ds], p0, 0, 0, 0);
                    p1 = __builtin_amdgcn_mfma_f32_32x32x16_bf16(k1, qf[ds], p1, 0, 0, 0);
                }
                if (64 * t + 63 > qw0) {
#pragma unroll
                    for (int r = 0; r < 16; ++r) { const int kv = 64 * t + (r & 3) + 8 * (r >> 2) + 4 * hi; if (kv > qabs) p0[r] = -INFINITY; if (kv + 32 > qabs) p1[r] = -INFINITY; }
                }
                float mx = fmaxf(p0[0], p1[0]);
#pragma unroll
                for (int r = 1; r < 16; ++r) mx = fmaxf(mx, fmaxf(p0[r], p1[r]));
                mx = fmaxf(mx, __shfl_xor(mx, 32));
                const float mnew = fmaxf(m_run, mx), alpha = __builtin_amdgcn_exp2f(m_run - mnew); m_run = mnew;
                float ls = 0.f;
#pragma unroll
                for (int r = 0; r < 16; ++r) { p0[r] = __builtin_amdgcn_exp2f(p0[r] - mnew); p1[r] = __builtin_amdgcn_exp2f(p1[r] - mnew); ls += p0[r] + p1[r]; }
                l_run = l_run * alpha + ls;
#pragma unroll
                for (int r = 0; r < 16; ++r) { o0[r] *= alpha; o1[r] *= alpha; }
                u32x4 pb[4];
                pb[0] = (u32x4){cvtpk(p0[0], p0[1]), cvtpk(p0[2], p0[3]), cvtpk(p0[4], p0[5]), cvtpk(p0[6], p0[7])};
                pb[1] = (u32x4){cvtpk(p0[8], p0[9]), cvtpk(p0[10], p0[11]), cvtpk(p0[12], p0[13]), cvtpk(p0[14], p0[15])};
                pb[2] = (u32x4){cvtpk(p1[0], p1[1]), cvtpk(p1[2], p1[3]), cvtpk(p1[4], p1[5]), cvtpk(p1[6], p1[7])};
                pb[3] = (u32x4){cvtpk(p1[8], p1[9]), cvtpk(p1[10], p1[11]), cvtpk(p1[12], p1[13]), cvtpk(p1[14], p1[15])};
                const LAS unsigned char* vb = lds + VOFF + cur * VBUF + r32 * VROW + hi * 8;
#pragma unroll
                for (int ks = 0; ks < 4; ++ks) {
                    const bf16x8 pf = __builtin_bit_cast(bf16x8, pb[ks]);
                    { const s16x4 a = *(const LAS s16x4*)(vb + ks * 32), b = *(const LAS s16x4*)(vb + ks * 32 + 16);
                      const bf16x8 vf = {a[0], a[1], a[2], a[3], b[0], b[1], b[2], b[3]};
                      o0 = __builtin_amdgcn_mfma_f32_32x32x16_bf16(vf, pf, o0, 0, 0, 0); }
                    { const s16x4 a = *(const LAS s16x4*)(vb + 32 * VROW + ks * 32), b = *(const LAS s16x4*)(vb + 32 * VROW + ks * 32 + 16);
                      const bf16x8 vf = {a[0], a[1], a[2], a[3], b[0], b[1], b[2], b[3]};
                      o1 = __builtin_amdgcn_mfma_f32_32x32x16_bf16(vf, pf, o1, 0, 0, 0); }
                }
            }
            if (t + 1 < NT) ATT_STORE(cur ^ 1);
            __syncthreads();
        }
        {
            const float lt = l_run + __shfl_xor(l_run, 32), inv = 1.0f / lt;
            const int b = bh >> 4, h = bh & 15;
            bf16_t* Op = O + ((size_t)(b * SEQ + qabs)) * DM + h * 64 + 4 * hi;
#pragma unroll
            for (int rg = 0; rg < 4; ++rg) {
                u32x2 w0; w0.x = cvtpk(o0[4 * rg] * inv, o0[4 * rg + 1] * inv); w0.y = cvtpk(o0[4 * rg + 2] * inv, o0[4 * rg + 3] * inv);
                u32x2 w1; w1.x = cvtpk(o1[4 * rg] * inv, o1[4 * rg + 1] * inv); w1.y = cvtpk(o1[4 * rg + 2] * inv, o1[4 * rg + 3] * inv);
                *(u32x2*)(Op + 8 * rg) = w0; *(u32x2*)(Op + 32 + 8 * rg) = w1;
            }
        }
#undef ATT_LOAD
#undef ATT_STORE
    }
}

__global__ void __launch_bounds__(NTHREADS, 2) fwd_mega(Args a) {
    extern __shared__ __attribute__((aligned(16))) unsigned char lds_raw[];
    LAS unsigned char* lds = (LAS unsigned char*)lds_raw;
    cg::grid_group grid = cg::this_grid();
    const int wave_s = __builtin_amdgcn_readfirstlane(threadIdx.x >> 6);
#define TID_NOW (wave_s * 64 + pg8::lane_id_asm())
    const int lo = a.ph_lo, hi = a.ph_hi;
    int ph = 0;
#define PH_ON (ph >= lo && ph < hi)
#define PH_NEXT do { ++ph; if (ph > lo && ph < hi) grid.sync(); } while (0)
#define WS_LOCAL int G = gridDim.x; asm volatile("" : "+s"(G)); const int bx = blockIdx.x, vcu = (G % 8 == 0) ? (bx % 8) * (G / 8) + bx / 8 : bx; (void)vcu; unsigned long long wsi_ = (unsigned long long)a.ws; asm volatile("" : "+s"(wsi_)); unsigned char* ws = (unsigned char*)(GAS unsigned char*)wsi_; float* ss = (float*)(ws + WS_SS); bf16_t* xb = (bf16_t*)(ws + WS_XB); (void)ss; (void)xb

#ifndef DIS_P0
    if (PH_ON) { WS_LOCAL; const int tid = TID_NOW; prologue(a, lds, vcu, G, wave_s, tid & 63, tid); }
#endif
    PH_NEXT;

#pragma unroll 1
    for (int li = 0; li < 4; ++li) {
#pragma unroll 1
        for (int j = 0; j < 2; ++j) {
            const int f = li * 2 + j;
            if (PH_ON) {
                WS_LOCAL; const bf16_t* wgu = (const bf16_t*)(ws + ffn_w_off(f));
                pg8::Gemm g{xb, wgu, M_TOK, 5632, 1024}; pg8::StaticOrder S; S.init(M_TOK, 5632, G, bx);
                EpiSwiglu E{ws};
#ifndef DIS_F1
                pg8::gemm_phase<EpiSwiglu, pg8::StaticOrder, true, true>(lds, g, S, E, wave_s);
#endif
            }
            PH_NEXT;
            if (PH_ON) {
                WS_LOCAL; const bf16_t* wd = (const bf16_t*)(ws + ffn_w_off(f)) + (size_t)5632 * 1024;
                pg8::Gemm g{(const bf16_t*)(ws + T_H), wd, M_TOK, 1024, FF}; pg8::StaticOrder S; S.init(M_TOK, 1024, G, bx);
                EpiResid E{f == 0 ? a.in[0] : a.out, a.out, ws, 0.5f};
#ifndef DIS_RES
                pg8::gemm_phase<EpiResid, pg8::StaticOrder, true, true>(lds, g, S, E, wave_s);
#endif
            }
            PH_NEXT;
            if (j == 0) {
                const int kind = li % 3;
                if (kind == 0) {
                    const int ia = li == 0 ? 0 : 1;
                    if (PH_ON) {
                        WS_LOCAL; const bf16_t* win = (const bf16_t*)(ws + conv_w_off(ia));
                        pg8::Gemm g{xb, win, M_TOK, 3072, 1024}; pg8::StaticOrder S; S.init(M_TOK, 3072, G, bx);
                        EpiConvIn E{ws};
#ifndef DIS_C1
                        pg8::gemm_phase<EpiConvIn, pg8::StaticOrder, true, true>(lds, g, S, E, wave_s);
#endif
                    }
                    PH_NEXT;
#ifndef DIS_E
                    if (PH_ON) { WS_LOCAL; const int tid = TID_NOW; conv_phase((const bf16_t*)(ws + T_Z), (const bf16_t*)(ws + T_BG), a.in[7] + (size_t)ia * 3 * 1024, (bf16_t*)(ws + T_G), vcu * NTHREADS + tid, G * NTHREADS); }
#endif
                    PH_NEXT;
                } else if (kind == 1) {
                    if (PH_ON) {
                        WS_LOCAL;
                        pg8::Gemm g{xb, (const bf16_t*)(ws + W_MLA_A), M_TOK, 512, 1024}; pg8::StaticOrder S; S.init(M_TOK, 512, G, bx);
                        EpiMlaA E{ws};
#ifndef DIS_M1
                        pg8::gemm_phase<EpiMlaA, pg8::StaticOrder, true, true>(lds, g, S, E, wave_s);
#endif
                    }
                    PH_NEXT;
                    if (PH_ON) {
                        { WS_LOCAL; pg8::Gemm g{(const bf16_t*)(ws + T_AQ), (const bf16_t*)(ws + W_MLA_UQ), M_TOK, 2048, 256}; pg8::StaticOrder S; S.init(M_TOK, 2048, G, bx);
                          EpiQ E{ws};
#ifndef DIS_M2
                          pg8::gemm_phase<EpiQ, pg8::StaticOrder, true, true>(lds, g, S, E, wave_s);
#endif
                        }
                        { WS_LOCAL; pg8::Gemm g{(const bf16_t*)(ws + T_AKV), (const bf16_t*)(ws + W_MLA_UKV), M_TOK, 2048, 256}; pg8::StaticOrder S; S.init(M_TOK, 2048, G, bx);
                          EpiKV E{ws};
#ifndef DIS_M3
                          pg8::gemm_phase<EpiKV, pg8::StaticOrder, true, true>(lds, g, S, E, wave_s);
#endif
                        }
                    }
                    PH_NEXT;
#ifndef DIS_FIN
                    if (PH_ON) { WS_LOCAL; const int tid = TID_NOW; qk_finalize((bf16_t*)(ws + T_Q), (bf16_t*)(ws + T_K), (const float*)(ws + WS_KR), a.in[14], a.in[15], (const float*)(ws + WS_COS), (const float*)(ws + WS_SIN), vcu * NTHREADS + tid, G * NTHREADS); }
#endif
                    PH_NEXT;
#ifndef DIS_ATT
                    if (PH_ON) { WS_LOCAL; attn_phase(lds, (const bf16_t*)(ws + T_Q), (const bf16_t*)(ws + T_K), (const bf16_t*)(ws + WS_XB), (bf16_t*)(ws + T_O), vcu, G, wave_s); }
#endif
                    PH_NEXT;
                } else {
                    if (PH_ON) {
                        WS_LOCAL;
                        pg8::Gemm g{xb, (const bf16_t*)(ws + W_SG_IN), M_TOK, 2048, 1024}; pg8::StaticOrder S; S.init(M_TOK, 2048, G, bx);
                        EpiSgIn E{ws};
#ifndef DIS_S1
                        pg8::gemm_phase<EpiSgIn, pg8::StaticOrder, true, true>(lds, g, S, E, wave_s);
#endif
                    }
                    PH_NEXT;
#ifndef DIS_S2
                    if (PH_ON) { WS_LOCAL; sg_phase(lds, (const bf16_t*)(ws + T_Z), (const bf16_t*)(ws + T_BG), (const float*)(ws + WS_SSV), a.in[18], (const bf16_t*)(ws + W_SG_S), a.in[20], (bf16_t*)(ws + T_G), vcu, G, wave_s); }
#endif
                    PH_NEXT;
                }
                if (PH_ON) {
                    WS_LOCAL;
                    const bf16_t* Amix = (const bf16_t*)(ws + (kind == 1 ? T_O : T_G));
                    const bf16_t* Wmix = kind == 0 ? (const bf16_t*)(ws + conv_w_off(li == 0 ? 0 : 1)) + (size_t)3072 * 1024 : kind == 1 ? (const bf16_t*)(ws + W_MLA_O) : (const bf16_t*)(ws + W_SG_OUT);
                    pg8::Gemm g{Amix, Wmix, M_TOK, 1024, 1024}; pg8::StaticOrder S; S.init(M_TOK, 1024, G, bx);
                    EpiResid E{a.out, a.out, ws, 1.0f};
#ifndef DIS_RES
                    pg8::gemm_phase<EpiResid, pg8::StaticOrder, true, true>(lds, g, S, E, wave_s);
#endif
                }
                PH_NEXT;
            }
        }
    }
}

#ifndef MK_PER_PHASE
#define MK_PER_PHASE 0
#endif
extern "C" void kernel_launch(void* const* d_in, const int* in_sizes, int n_in, void* d_out, int out_size, void* d_ws, size_t ws_size, hipStream_t stream) {
    static int grid = 0;
    if (grid == 0) {
        if (n_in != 22 || out_size != M_TOK * DM || ws_size < WS_END) { fprintf(stderr, "kernel_launch: unexpected shapes (n_in %d out %d ws %zu)\n", n_in, out_size, ws_size); grid = -1; return; }
        int dev = 0, cus = 0, per_cu = 0;
        hipGetDevice(&dev); hipDeviceGetAttribute(&cus, hipDeviceAttributeMultiprocessorCount, dev);
        if (hipFuncSetAttribute((const void*)fwd_mega, hipFuncAttributeMaxDynamicSharedMemorySize, LDS_BYTES) != hipSuccess) fprintf(stderr, "kernel_launch: hipFuncSetAttribute failed\n");
        if (hipOccupancyMaxActiveBlocksPerMultiprocessor(&per_cu, (const void*)fwd_mega, NTHREADS, LDS_BYTES) != hipSuccess || per_cu < 1) { fprintf(stderr, "kernel_launch: occupancy query says %d\n", per_cu); per_cu = 1; }
        (void)hipGetLastError();
        grid = cus * 1;
        fprintf(stderr, "kernel_launch: grid %d (per_cu %d)\n", grid, per_cu);
    }
    if (grid < 0) return;
    Args a{};
    for (int i = 0; i < 22; ++i) a.in[i] = (const float*)d_in[i];
    a.out = (float*)d_out; a.ws = (unsigned char*)d_ws;
    for (int i = 0; i < 16; ++i) { const float e = (float)(2 * i) / 32.0f; a.inv_freq[i] = 1.0f / powf(10000.0f, e); }
#if MK_PER_PHASE
    for (int p = 0; p < 31; ++p) { a.ph_lo = p; a.ph_hi = p + 1; hipLaunchKernelGGL(fwd_mega, dim3(grid), dim3(NTHREADS), LDS_BYTES, stream, a); }
#else
    a.ph_lo = 0; a.ph_hi = 1000;
    void* args[] = {&a};
    const hipError_t e = hipLaunchCooperativeKernel((const void*)fwd_mega, dim3(grid), dim3(NTHREADS), args, LDS_BYTES, stream);
    if (e != hipSuccess) fprintf(stderr, "kernel_launch: cooperative launch failed: %s (grid %d)\n", hipGetErrorString(e), grid);
#endif
}
```

```cpp
#include <hip/hip_runtime.h>
#include <hip/hip_cooperative_groups.h>
#include <cstdio>
#include <cstdint>
#include <cmath>
namespace cg = cooperative_groups;
namespace pg8 {
#define PG8_LAS __attribute__((address_space(3)))
typedef unsigned short bf16_t;
typedef short bf16x8 __attribute__((ext_vector_type(8)));
typedef float f32x4 __attribute__((ext_vector_type(4)));
typedef unsigned u32x4 __attribute__((ext_vector_type(4)));
constexpr int BM = 256, BK = 64, HALF = 128, HTB = HALF * BK * 2  , STAGE_BYTES = 8 * HTB, NXCD = 8, WGM = 8;

__host__ __device__ __forceinline__ int lds_byte(int r, int c) { const int st = (r >> 4) * 2 + (c >> 5), rr = r & 15, cc = c & 31, ob = rr * 64 + cc * 2; return st * 1024 + (ob ^ (((ob >> 9) & 1) << 5)); }
__host__ __device__ __forceinline__ void stage_rc(int b, int& R, int& C) { const int st = b / 1024, sb = b % 1024, swz = sb ^ (((sb >> 9) & 1) << 5); R = (st >> 1) * 16 + swz / 64; C = (st & 1) * 32 + (swz % 64) / 2; }
__host__ __device__ __forceinline__ int perm32(int rho) { const int n = rho >> 4, i = rho & 15; return 8 * (i >> 2) + 4 * n + (i & 3); }

__device__ __forceinline__ int lane_id_asm() { int l; asm volatile("v_mbcnt_lo_u32_b32 %0, -1, 0\n\tv_mbcnt_hi_u32_b32 %0, -1, %0" : "=v"(l)); return l; }
struct Unit { int pm, pn; };
struct Gemm { const bf16_t* A; const bf16_t* Bt; int M, N, K; };

struct StaticOrder {
    int nM, nN, nwg, G, c;
    __host__ __device__ void init(int M, int N, int G_, int c_) { nM = M / BM; nN = N / BM; nwg = nM * nN; G = G_; c = c_; }
    __host__ __device__ bool next(int i, Unit& u) const {
        const long L = (long)i * G + c; if (L >= nwg) return false;
        int wgid = (int)L; { const int q = nwg / NXCD, r = nwg % NXCD, xcd = wgid % NXCD, off = wgid / NXCD; wgid = (xcd < r ? xcd * (q + 1) : r * (q + 1) + (xcd - r) * q) + off; }
        const int nig = WGM * nN, gid = wgid / nig, fm = gid * WGM, gsz = (nM - fm) < WGM ? (nM - fm) : WGM;
        u.pm = fm + ((wgid % nig) % gsz); u.pn = (wgid % nig) / gsz; return true;
    }
    __device__ __forceinline__ void a_ready(const Unit&) const {}
    __device__ __forceinline__ void done(const Unit&) const {}
};

__device__ __forceinline__ unsigned cvt_pk_bf16(float lo, float hi) { unsigned r; asm volatile("v_cvt_pk_bf16_f32 %0, %1, %2" : "=v"(r) : "v"(lo), "v"(hi)); return r; }
typedef float f32x2 __attribute__((ext_vector_type(2)));
template <class Epi, class Sched, bool ALIGN_EPI = false, bool SP2 = false>
__device__ __forceinline__ void gemm_phase(PG8_LAS unsigned char* lds, const Gemm g, const Sched& S, const Epi& E, const int wave_id) {
    int wid_ = wave_id; asm volatile("" : "+s"(wid_)); const int lane = lane_id_asm(), wid = wid_, tid = wid * 64 + lane, wr = wid >> 2, wc = wid & 3, fr = lane & 15, fq = lane >> 4;
    const int K = g.K, nt = K / BK;
    unsigned voffA[2], voffB[2];
#pragma unroll
    for (int i = 0; i < 2; ++i) { int R, C; stage_rc(tid * 16 + i * 8192, R, C); const int Rb = Epi::PERM ? ((R & ~31) + perm32(R & 31)) : R;
        voffA[i] = (unsigned)(R * K + C) * 2u; voffB[i] = (unsigned)(Rb * K + C) * 2u; }
    const size_t kstep = (size_t)(BK * 2);
    const size_t hstep = (size_t)HALF * K * 2;
    const size_t tstep = 2 * hstep;
    const unsigned ldsw = (unsigned)wid * 1024u;
    const int aoff = lds_byte(wr * 64 + fr, fq * 8), boff = lds_byte(wc * 32 + fr, fq * 8);
#define PG8_SA(b, h) (((b) * 2 + (h)) * HTB)
#define PG8_SB(b, h) ((4 + (b) * 2 + (h)) * HTB)
#define PG8_STAGE(bufoff, gbase, voff) do { _Pragma("unroll") for (int _i = 0; _i < 2; ++_i) \
        __builtin_amdgcn_global_load_lds((const unsigned*)((const char*)(gbase) + (voff)[_i]), (PG8_LAS unsigned*)(lds + (bufoff) + ldsw + _i * 8192), 16, 0, 0); } while (0)
#define PG8_LDA(dst, b, h) do { _Pragma("unroll") for (int m = 0; m < 4; ++m) _Pragma("unroll") for (int k = 0; k < 2; ++k) dst[m][k] = *(const PG8_LAS bf16x8*)(lds + PG8_SA(b, h) + aoff + m * 2048 + k * 1024); } while (0)
#define PG8_LDB(dst, b, h) do { _Pragma("unroll") for (int n = 0; n < 2; ++n) _Pragma("unroll") for (int k = 0; k < 2; ++k) dst[n][k] = *(const PG8_LAS bf16x8*)(lds + PG8_SB(b, h) + boff + n * 2048 + k * 1024); } while (0)
#define PG8_MMA(ai, bj, At, Bt) do { __builtin_amdgcn_s_setprio(1); _Pragma("unroll") for (int m = 0; m < 4; ++m) _Pragma("unroll") for (int n = 0; n < 2; ++n) _Pragma("unroll") for (int k = 0; k < 2; ++k) \
        acc[ai][bj][m][n] = __builtin_amdgcn_mfma_f32_16x16x32_bf16(Bt[n][k], At[m][k], acc[ai][bj][m][n], 0, 0, 0); __builtin_amdgcn_s_setprio(0); } while (0)
#define PG8_WAIT_V(n) asm volatile("s_waitcnt vmcnt(" #n ")" ::: "memory")
#define PG8_WAIT_L(n) asm volatile("s_waitcnt lgkmcnt(" #n ")" ::: "memory")
#define PG8_BAR __builtin_amdgcn_s_barrier()
#define PG8_SCHED __builtin_amdgcn_sched_barrier(0)
    Unit cur, nxt; int ui = 0;
    if (!S.next(0, cur)) return;
    f32x4 acc[2][2][4][2];
#pragma unroll
    for (int a = 0; a < 2; ++a)
#pragma unroll
        for (int b = 0; b < 2; ++b)
#pragma unroll
            for (int m = 0; m < 4; ++m)
#pragma unroll
                for (int n = 0; n < 2; ++n) acc[a][b][m][n] = (f32x4){0.f, 0.f, 0.f, 0.f};
    bf16x8 At[4][2], B0[2][2], B1[2][2];
    const char* cA = (const char*)g.A + (size_t)cur.pm * tstep; const char* cB = (const char*)g.Bt + (size_t)cur.pn * tstep;
    S.a_ready(cur);
    if constexpr (SP2) {
        PG8_STAGE(PG8_SB(0, 0), cB, voffB); PG8_STAGE(PG8_SB(0, 1), cB + hstep, voffB); PG8_STAGE(PG8_SA(0, 0), cA, voffA); PG8_STAGE(PG8_SA(0, 1), cA + hstep, voffA);
        if (wr == 1) PG8_BAR;
        PG8_WAIT_V(2); PG8_BAR;
        PG8_STAGE(PG8_SB(1, 0), cB + kstep, voffB); PG8_STAGE(PG8_SA(1, 0), cA + kstep, voffA); PG8_STAGE(PG8_SB(1, 1), cB + hstep + kstep, voffB);
        PG8_WAIT_V(6); PG8_BAR;
    } else {
        PG8_STAGE(PG8_SB(0, 0), cB, voffB); PG8_STAGE(PG8_SA(0, 0), cA, voffA); PG8_STAGE(PG8_SB(0, 1), cB + hstep, voffB); PG8_STAGE(PG8_SA(0, 1), cA + hstep, voffA);
        if (wr == 1) PG8_BAR;
        PG8_WAIT_V(4); PG8_BAR;
        PG8_STAGE(PG8_SB(1, 0), cB + kstep, voffB); PG8_STAGE(PG8_SA(1, 0), cA + kstep, voffA); PG8_STAGE(PG8_SB(1, 1), cB + hstep + kstep, voffB);
        PG8_WAIT_V(6); PG8_BAR;
    }
    for (;;) {
        const bool has_next = S.next(ui + 1, nxt);
        const char* nA = has_next ? (const char*)g.A + (size_t)nxt.pm * tstep : cA; const char* nB = has_next ? (const char*)g.Bt + (size_t)nxt.pn * tstep : cB;
        for (int t = 0; t < nt; t += 2) {
            if (t == 2) E.prefetch(cur, wid, lane);
            const bool last = (t == nt - 2);
            const char* a1 = cA + (size_t)(t + 1) * kstep;
            const char* a2 = last ? nA : cA + (size_t)(t + 2) * kstep; const char* b2 = last ? nB : cB + (size_t)(t + 2) * kstep;
            const char* a3 = a2 + kstep; const char* b3 = b2 + kstep;
            if (last && has_next) S.a_ready(nxt);
            if constexpr (SP2) {
            PG8_LDB(B0, 0, 0); PG8_LDB(B1, 0, 1); PG8_SCHED; PG8_LDA(At, 0, 0); PG8_STAGE(PG8_SA(1, 1), a1 + hstep, voffA);
            PG8_WAIT_V(8); PG8_WAIT_L(0); PG8_BAR; PG8_MMA(0, 0, At, B0); PG8_MMA(0, 1, At, B1); PG8_BAR; PG8_SCHED;
            PG8_LDA(At, 0, 1); PG8_STAGE(PG8_SB(0, 0), b2, voffB); PG8_STAGE(PG8_SB(0, 1), b2 + hstep, voffB); PG8_STAGE(PG8_SA(0, 0), a2, voffA);
            PG8_WAIT_V(8); PG8_WAIT_L(0); PG8_BAR; PG8_MMA(1, 0, At, B0); PG8_MMA(1, 1, At, B1); PG8_BAR; PG8_SCHED;
            PG8_LDB(B0, 1, 0); PG8_LDB(B1, 1, 1); PG8_SCHED; PG8_LDA(At, 1, 0); PG8_STAGE(PG8_SA(0, 1), a2 + hstep, voffA);
            PG8_WAIT_V(8); PG8_WAIT_L(0); PG8_BAR; PG8_MMA(0, 0, At, B0); PG8_MMA(0, 1, At, B1); PG8_BAR; PG8_SCHED;
            PG8_LDA(At, 1, 1); PG8_STAGE(PG8_SB(1, 0), b3, voffB); PG8_STAGE(PG8_SB(1, 1), b3 + hstep, voffB); PG8_STAGE(PG8_SA(1, 0), a3, voffA);
            PG8_WAIT_V(8); PG8_WAIT_L(0); PG8_BAR; PG8_MMA(1, 0, At, B0); PG8_MMA(1, 1, At, B1); PG8_BAR; PG8_SCHED;
            } else {
            PG8_LDB(B0, 0, 0); PG8_SCHED; PG8_LDA(At, 0, 0); PG8_STAGE(PG8_SA(1, 1), a1 + hstep, voffA);
            PG8_WAIT_L(8); PG8_BAR; PG8_WAIT_L(0); PG8_MMA(0, 0, At, B0); PG8_BAR; PG8_SCHED;
            PG8_LDB(B1, 0, 1); PG8_STAGE(PG8_SB(0, 0), b2, voffB);
            PG8_BAR; PG8_WAIT_L(0); PG8_MMA(0, 1, At, B1); PG8_BAR;
            PG8_LDA(At, 0, 1); PG8_STAGE(PG8_SA(0, 0), a2, voffA);
            PG8_BAR; PG8_WAIT_L(0); PG8_MMA(1, 0, At, B0); PG8_BAR; PG8_SCHED;
            PG8_STAGE(PG8_SB(0, 1), b2 + hstep, voffB);
            PG8_WAIT_V(6); PG8_BAR; PG8_MMA(1, 1, At, B1); PG8_BAR;
            PG8_LDB(B0, 1, 0); PG8_SCHED; PG8_LDA(At, 1, 0); PG8_STAGE(PG8_SA(0, 1), a2 + hstep, voffA);
            PG8_WAIT_L(8); PG8_BAR; PG8_WAIT_L(0); PG8_MMA(0, 0, At, B0); PG8_BAR; PG8_SCHED;
            PG8_LDB(B1, 1, 1); PG8_STAGE(PG8_SB(1, 0), b3, voffB);
            PG8_BAR; PG8_WAIT_L(0); PG8_MMA(0, 1, At, B1); PG8_BAR;
            PG8_LDA(At, 1, 1); PG8_STAGE(PG8_SA(1, 0), a3, voffA);
            PG8_BAR; PG8_WAIT_L(0); PG8_MMA(1, 0, At, B0); PG8_BAR; PG8_SCHED;
            PG8_STAGE(PG8_SB(1, 1), b3 + hstep, voffB);
            PG8_WAIT_V(6); PG8_BAR; PG8_MMA(1, 1, At, B1); PG8_BAR;
            }
        }
        if constexpr (ALIGN_EPI) { if (wr == 0) PG8_BAR; }
        if constexpr (!Epi::AFTER_DRAIN) { E(acc, cur, wr, wc, fr, fq); S.done(cur); }
        if (!has_next) break;
#pragma unroll
        for (int a = 0; a < 2; ++a)
#pragma unroll
            for (int b = 0; b < 2; ++b)
#pragma unroll
                for (int m = 0; m < 4; ++m)
#pragma unroll
                    for (int n = 0; n < 2; ++n) acc[a][b][m][n] = (f32x4){0.f, 0.f, 0.f, 0.f};
        cur = nxt; cA = nA; cB = nB; ++ui;
        if constexpr (ALIGN_EPI) { if (wr == 1) PG8_BAR; }
    }
    PG8_WAIT_V(0);
    if constexpr (!ALIGN_EPI) { if (wr == 0) PG8_BAR; }
    PG8_BAR;
    if constexpr (Epi::AFTER_DRAIN) { E.fused(acc, cur, wr, wc, fr, fq, lds, wid, lane); S.done(cur); }
#undef PG8_SA
#undef PG8_SB
#undef PG8_STAGE
#undef PG8_LDA
#undef PG8_LDB
#undef PG8_MMA
#undef PG8_WAIT_V
#undef PG8_WAIT_L
#undef PG8_BAR
#undef PG8_SCHED
}
}

#define LAS __attribute__((address_space(3)))
#define GAS __attribute__((address_space(1)))
typedef unsigned short bf16_t;
typedef float f32x4 __attribute__((ext_vector_type(4)));
typedef float f32x16 __attribute__((ext_vector_type(16)));
typedef short bf16x8 __attribute__((ext_vector_type(8)));
typedef short s16x4 __attribute__((ext_vector_type(4)));
typedef unsigned u32x4 __attribute__((ext_vector_type(4)));
typedef unsigned u32x2 __attribute__((ext_vector_type(2)));

constexpr int M_TOK = 32768, DM = 1024, FF = 2816, SEQ = 8192;
constexpr float EPS = 1e-6f;
constexpr float QSCALE = 0.10206207261596575f * 1.4426950408889634f;
constexpr int NTHREADS = 512, NWAVES = 8;
constexpr size_t MiB = 1u << 20;
constexpr size_t WS_SS = 0, WS_SSV = 2 * MiB, WS_SSQ = 4 * MiB, WS_SSKV = 4 * MiB + 512 * 1024, WS_SSPE = 5 * MiB;
constexpr size_t WS_COS = 6 * MiB, WS_SIN = 8 * MiB, WS_KR = 10 * MiB;
constexpr size_t WS_CTL = 14 * MiB, CTL_ZERO_BYTES = 16384;
constexpr size_t WS_XB = 16 * MiB;
constexpr size_t WS_WB = 80 * MiB;
constexpr size_t FFN_BYTES = 16 * MiB + 512 * 1024;
constexpr size_t W_CONV1 = WS_WB + 6 * FFN_BYTES;
constexpr size_t W_MLA_A = W_CONV1 + 8 * MiB, W_MLA_UQ = W_MLA_A + 1 * MiB, W_MLA_UKV = W_MLA_UQ + 1 * MiB, W_MLA_O = W_MLA_UKV + 1 * MiB;
constexpr size_t W_SG_IN = W_MLA_O + 2 * MiB, W_SG_OUT = W_SG_IN + 4 * MiB, W_SG_S = W_SG_OUT + 2 * MiB;
constexpr size_t WS_WL0 = 198 * MiB + 512 * 1024;
constexpr size_t W_CONV0 = WS_WL0 + 2 * FFN_BYTES;
static_assert(W_SG_S + 256 * 1024 <= WS_WL0, "weights map");
constexpr size_t WS_T = 240 * MiB;
static_assert(W_CONV0 + 8 * MiB <= WS_T, "weights map 2");
constexpr size_t T_H = WS_T;
constexpr size_t T_Z = WS_T, T_BG = WS_T + 64 * MiB, T_G = WS_T + 128 * MiB;
constexpr size_t T_Q = WS_T, T_K = WS_T + 96 * MiB, T_O = WS_T + 192 * MiB, T_AQ = T_O, T_AKV = T_O + 16 * MiB;
constexpr size_t T_LO = WS_T + 192 * MiB;
constexpr size_t WS_END = 512 * MiB;
static_assert(T_O + 64 * MiB <= WS_END && T_H + 176 * MiB <= WS_END, "temp map");
constexpr int RING_BYTES = 131072, EPI_OFF = RING_BYTES  , MISC_OFF = RING_BYTES + 16384, LDS_BYTES = 147456 + 256;

__device__ __forceinline__ size_t ffn_w_off(int f) { return f < 2 ? WS_WL0 + (size_t)f * FFN_BYTES : WS_WB + (size_t)(f - 2) * FFN_BYTES; }
__device__ __forceinline__ size_t conv_w_off(int ia) { return ia == 0 ? W_CONV0 : W_CONV1; }

__device__ __forceinline__ unsigned cvtpk(float lo, float hi) { return pg8::cvt_pk_bf16(lo, hi); }
__device__ __forceinline__ u32x4 pack8(f32x4 a, f32x4 b) { u32x4 w; w.x = cvtpk(a[0], a[1]); w.y = cvtpk(a[2], a[3]); w.z = cvtpk(b[0], b[1]); w.w = cvtpk(b[2], b[3]); return w; }
__device__ __forceinline__ float bf_lo(unsigned w) { return __uint_as_float(w << 16); }
__device__ __forceinline__ float bf_hi(unsigned w) { return __uint_as_float(w & 0xffff0000u); }
__device__ __forceinline__ float dot4(f32x4 a) { return (a[0] * a[0] + a[1] * a[1]) + (a[2] * a[2] + a[3] * a[3]); }
__device__ __forceinline__ float wave_sum(float v) {
#pragma unroll
    for (int o = 1; o < 64; o <<= 1) v += __shfl_xor(v, o);
    return v;
}
__device__ __forceinline__ float swap32(float x, bool hi) { auto rr = __builtin_amdgcn_permlane32_swap(__float_as_uint(x), __float_as_uint(x), false, false); return __uint_as_float(hi ? rr[0] : rr[1]); }
__device__ __forceinline__ float red_fq(float s) { s += __shfl_xor(s, 16); s += __shfl_xor(s, 32); return s; }
__device__ __forceinline__ float row_rs16(const GAS float* ss, int row, int fq) {
    const f32x4 p = *(const GAS f32x4*)(ss + (size_t)row * 16 + 4 * fq);
    const float s = red_fq((p[0] + p[1]) + (p[2] + p[3]));
    return rsqrtf(s * (1.0f / 1024.0f) + EPS);
}
__device__ __forceinline__ float silu_f(float x) { return x * __builtin_amdgcn_rcpf(1.0f + __expf(-x)); }
__device__ __forceinline__ float gelu_tanh_f(float x) { const float u2 = 1.5957691216057308f * (x + 0.044715f * x * x * x); return x * __builtin_amdgcn_rcpf(1.0f + __expf(-u2)); }
#define EPI_FENCE() do { asm volatile("" ::: "memory"); __builtin_amdgcn_sched_barrier(0); } while (0)
#define EPI_BAR() do { asm volatile("s_waitcnt lgkmcnt(0)" ::: "memory"); __builtin_amdgcn_s_barrier(); EPI_FENCE(); } while (0)

typedef const pg8::f32x4 (&AccRef)[2][2][4][2];

__device__ __forceinline__ void ss_prefetch(unsigned char* ws, LAS unsigned char* ldsE, int pm, int wid, int lane) {
    unsigned long long wi_ = (unsigned long long)ws; asm volatile("" : "+s"(wi_));
    (void)lane; const unsigned lo16 = (unsigned)pg8::lane_id_asm() * 16u;
    const unsigned char* srcu = (const unsigned char*)wi_ + WS_SS + (size_t)pm * 16384 + wid * 2048;
    const unsigned char* src = srcu + lo16;
    __builtin_amdgcn_global_load_lds((const unsigned*)src, (LAS unsigned*)(ldsE + wid * 2048), 16, 0, 0);
    __builtin_amdgcn_global_load_lds((const unsigned*)(src + 1024), (LAS unsigned*)(ldsE + wid * 2048 + 1024), 16, 0, 0);
}

struct EpiSwiglu {
    static constexpr bool PERM = true, AFTER_DRAIN = false;
    unsigned char* ws; LAS unsigned char* ldsE;
    __device__ __forceinline__ void prefetch(const pg8::Unit& u, int wid, int lane) const { ss_prefetch(ws, ldsE, u.pm, wid, lane); }
    __device__ __forceinline__ void operator()(AccRef acc, const pg8::Unit& u, int wr, int wc, int fr_in, int fq_in) const {
        const int lane_e = pg8::lane_id_asm(); const int fr = lane_e & 15, fq = lane_e >> 4; (void)fr_in; (void)fq_in;
        unsigned long long wi_ = (unsigned long long)ws; asm volatile("" : "+s"(wi_)); GAS unsigned char* w = (GAS unsigned char*)wi_;
        const GAS float* ss = (const GAS float*)(w + WS_SS); GAS bf16_t* H = (GAS bf16_t*)(w + T_H);
        const int rowb = u.pm * 256 + wr * 64 + fr, hcol = u.pn * 128 + wc * 32 + 8 * fq;
        float rs8[8];
        { f32x4 pp[8];
#pragma unroll
          for (int q = 0; q < 8; ++q) pp[q] = *(const LAS f32x4*)(ldsE + ((q >> 2) * 128 + wr * 64 + (q & 3) * 16 + fr) * 64 + fq * 16);
#pragma unroll
          for (int q = 0; q < 8; ++q) rs8[q] = rsqrtf(red_fq((pp[q][0] + pp[q][1]) + (pp[q][2] + pp[q][3])) * (1.0f / 1024.0f) + EPS); }
        EPI_FENCE();
#pragma unroll
        for (int ai = 0; ai < 2; ++ai)
#pragma unroll
            for (int m = 0; m < 4; ++m) {
                const int row = rowb + ai * 128 + m * 16; const float rs = rs8[ai * 4 + m];
                f32x4 h0, h1;
#pragma unroll
                for (int j = 0; j < 4; ++j) { h0[j] = silu_f(acc[ai][0][m][0][j] * rs) * (acc[ai][1][m][0][j] * rs); h1[j] = silu_f(acc[ai][0][m][1][j] * rs) * (acc[ai][1][m][1][j] * rs); }
                *(GAS u32x4*)(H + (size_t)row * FF + hcol) = pack8(h0, h1);
            }
    }
};

struct EpiResid {
    static constexpr bool PERM = true, AFTER_DRAIN = false;
    const float* xf32; float* outp; unsigned char* ws; float alpha; int flags;
    __device__ __forceinline__ void prefetch(const pg8::Unit&, int, int) const {}
    __device__ __forceinline__ void operator()(AccRef acc, const pg8::Unit& u, int wr, int wc, int fr_in, int fq_in) const {
        const int lane_e = pg8::lane_id_asm(); const int fr = lane_e & 15, fq = lane_e >> 4; (void)fr_in; (void)fq_in;
        unsigned long long wi_ = (unsigned long long)ws; asm volatile("" : "+s"(wi_)); GAS unsigned char* w = (GAS unsigned char*)wi_;
        GAS float* ss = (GAS float*)(w + WS_SS); GAS bf16_t* xb = (GAS bf16_t*)(w + WS_XB);
        const bf16_t* lo_in = (flags & 4) ? (const bf16_t*)((unsigned char*)w + T_LO) : (const bf16_t*)outp;
        bf16_t* lo_out = (flags & 8) ? (bf16_t*)((unsigned char*)w + T_LO) : (bf16_t*)outp;
        const bool first = flags & 1, final_ = flags & 2;
        const int rowb = u.pm * 256 + wr * 64 + fr, colb = u.pn * 256 + wc * 32 + 8 * fq;
#pragma unroll
        for (int ai = 0; ai < 2; ++ai) {
            f32x4 xv[4][2][2];
            if (first) {
#pragma unroll
                for (int m = 0; m < 4; ++m)
#pragma unroll
                    for (int bj = 0; bj < 2; ++bj) { const size_t off = (size_t)(rowb + ai * 128 + m * 16) * DM + colb + bj * 128; xv[m][bj][0] = *(const f32x4*)(xf32 + off); xv[m][bj][1] = *(const f32x4*)(xf32 + off + 4); }
            } else {
                u32x4 rh[4][2], rl[4][2];
#pragma unroll
                for (int m = 0; m < 4; ++m)
#pragma unroll
                    for (int bj = 0; bj < 2; ++bj) { const size_t off = (size_t)(rowb + ai * 128 + m * 16) * DM + colb + bj * 128; rh[m][bj] = *(const GAS u32x4*)(xb + off); rl[m][bj] = *(const u32x4*)(lo_in + off); }
#pragma unroll
                for (int m = 0; m < 4; ++m)
#pragma unroll
                    for (int bj = 0; bj < 2; ++bj) { const u32x4 h = rh[m][bj], l = rl[m][bj];
                        xv[m][bj][0] = (f32x4){bf_lo(h.x) + bf_lo(l.x), bf_hi(h.x) + bf_hi(l.x), bf_lo(h.y) + bf_lo(l.y), bf_hi(h.y) + bf_hi(l.y)};
                        xv[m][bj][1] = (f32x4){bf_lo(h.z) + bf_lo(l.z), bf_hi(h.z) + bf_hi(l.z), bf_lo(h.w) + bf_lo(l.w), bf_hi(h.w) + bf_hi(l.w)}; }
            }
#pragma unroll
            for (int m = 0; m < 4; ++m) {
                const int row = rowb + ai * 128 + m * 16; float sq = 0.f;
#pragma unroll
                for (int bj = 0; bj < 2; ++bj) {
                    const size_t off = (size_t)row * DM + colb + bj * 128;
                    const f32x4 y0 = xv[m][bj][0] + acc[ai][bj][m][0] * alpha, y1 = xv[m][bj][1] + acc[ai][bj][m][1] * alpha;
                    if (final_) { *(f32x4*)(outp + off) = y0; *(f32x4*)(outp + off + 4) = y1; }
                    else {
                        const u32x4 h = pack8(y0, y1);
                        const f32x4 d0 = {y0[0] - bf_lo(h.x), y0[1] - bf_hi(h.x), y0[2] - bf_lo(h.y), y0[3] - bf_hi(h.y)}, d1 = {y1[0] - bf_lo(h.z), y1[1] - bf_hi(h.z), y1[2] - bf_lo(h.w), y1[3] - bf_hi(h.w)};
                        *(GAS u32x4*)(xb + off) = h; *(u32x4*)(lo_out + off) = pack8(d0, d1);
                        sq += dot4(y0) + dot4(y1);
                    }
                }
                if (!final_) { sq = red_fq(sq); if (fq == 0) ss[(size_t)row * 16 + u.pn * 4 + wc] = sq; }
            }
            EPI_FENCE();
        }
    }
};

struct EpiConvIn {
    static constexpr bool PERM = true, AFTER_DRAIN = false;
    unsigned char* ws; LAS unsigned char* ldsE;
    __device__ __forceinline__ void prefetch(const pg8::Unit& u, int wid, int lane) const { ss_prefetch(ws, ldsE, u.pm, wid, lane); }
    __device__ __forceinline__ void operator()(AccRef acc, const pg8::Unit& u, int wr, int wc, int fr_in, int fq_in) const {
        const int lane_e = pg8::lane_id_asm(); const int fr = lane_e & 15, fq = lane_e >> 4; (void)fr_in; (void)fq_in;
        unsigned long long wi_ = (unsigned long long)ws; asm volatile("" : "+s"(wi_)); GAS unsigned char* w = (GAS unsigned char*)wi_;
        const GAS float* ss = (const GAS float*)(w + WS_SS); GAS bf16_t* Z = (GAS bf16_t*)(w + T_Z); GAS bf16_t* Bg = (GAS bf16_t*)(w + T_BG);
        const int rowb = u.pm * 256 + wr * 64 + fr;
        float rs8[8];
        { f32x4 pp[8];
#pragma unroll
          for (int q = 0; q < 8; ++q) pp[q] = *(const LAS f32x4*)(ldsE + ((q >> 2) * 128 + wr * 64 + (q & 3) * 16 + fr) * 64 + fq * 16);
#pragma unroll
          for (int q = 0; q < 8; ++q) rs8[q] = rsqrtf(red_fq((pp[q][0] + pp[q][1]) + (pp[q][2] + pp[q][3])) * (1.0f / 1024.0f) + EPS); }
        EPI_FENCE();
#pragma unroll
        for (int ai = 0; ai < 2; ++ai)
#pragma unroll
            for (int m = 0; m < 4; ++m) {
                const int row = rowb + ai * 128 + m * 16; const float rs = rs8[ai * 4 + m];
                if (u.pn < 8) {
                    const float r2 = rs * rs;
                    const f32x4 z0 = acc[ai][0][m][0] * acc[ai][1][m][0] * r2, z1 = acc[ai][0][m][1] * acc[ai][1][m][1] * r2;
                    *(GAS u32x4*)(Z + (size_t)row * DM + u.pn * 128 + wc * 32 + 8 * fq) = pack8(z0, z1);
                } else {
#pragma unroll
                    for (int bj = 0; bj < 2; ++bj)
                        *(GAS u32x4*)(Bg + (size_t)row * DM + (u.pn - 8) * 256 + bj * 128 + wc * 32 + 8 * fq) = pack8(acc[ai][bj][m][0] * rs, acc[ai][bj][m][1] * rs);
                }
            }
    }
};

struct EpiMlaA {
    static constexpr bool PERM = true, AFTER_DRAIN = false;
    unsigned char* ws; LAS unsigned char* ldsE;
    __device__ __forceinline__ void prefetch(const pg8::Unit& u, int wid, int lane) const { ss_prefetch(ws, ldsE, u.pm, wid, lane); }
    __device__ __forceinline__ void operator()(AccRef acc, const pg8::Unit& u, int wr, int wc, int fr_in, int fq_in) const {
        const int lane_e = pg8::lane_id_asm(); const int fr = lane_e & 15, fq = lane_e >> 4; (void)fr_in; (void)fq_in;
        unsigned long long wi_ = (unsigned long long)ws; asm volatile("" : "+s"(wi_)); GAS unsigned char* w = (GAS unsigned char*)wi_;
        const GAS float* ss = (const GAS float*)(w + WS_SS); GAS bf16_t* Aq = (GAS bf16_t*)(w + T_AQ); GAS bf16_t* Akv = (GAS bf16_t*)(w + T_AKV); GAS float* ssq = (GAS float*)(w + WS_SSQ); GAS float* sskv = (GAS float*)(w + WS_SSKV);
        GAS float* sspe = (GAS float*)(w + WS_SSPE); GAS float* kr = (GAS float*)(w + WS_KR); const GAS float* cosT = (const GAS float*)(w + WS_COS); const GAS float* sinT = (const GAS float*)(w + WS_SIN);
        const int rowb = u.pm * 256 + wr * 64 + fr;
        float rs8[8];
        { f32x4 pp[8];
#pragma unroll
          for (int q = 0; q < 8; ++q) pp[q] = *(const LAS f32x4*)(ldsE + ((q >> 2) * 128 + wr * 64 + (q & 3) * 16 + fr) * 64 + fq * 16);
#pragma unroll
          for (int q = 0; q < 8; ++q) rs8[q] = rsqrtf(red_fq((pp[q][0] + pp[q][1]) + (pp[q][2] + pp[q][3])) * (1.0f / 1024.0f) + EPS); }
        EPI_FENCE();
#pragma unroll
        for (int ai = 0; ai < 2; ++ai)
#pragma unroll
            for (int m = 0; m < 4; ++m) {
                const int row = rowb + ai * 128 + m * 16; const float rs = rs8[ai * 4 + m];
                const f32x4 a00 = acc[ai][0][m][0] * rs, a01 = acc[ai][0][m][1] * rs, a10 = acc[ai][1][m][0] * rs, a11 = acc[ai][1][m][1] * rs;
                GAS bf16_t* dst = (u.pn == 0 ? Aq : Akv) + (size_t)row * 256 + wc * 32 + 8 * fq;
                *(GAS u32x4*)(dst) = pack8(a00, a01); *(GAS u32x4*)(dst + 128) = pack8(a10, a11);
                if (u.pn == 0) {
                    const float sq = red_fq(dot4(a00) + dot4(a01) + dot4(a10) + dot4(a11));
                    if (fq == 0) ssq[(size_t)row * 4 + wc] = sq;
                } else {
                    const float sq = red_fq(dot4(a00) + dot4(a01));
                    if (fq == 0) sskv[(size_t)row * 4 + wc] = sq;
                    if (wc == 0) {
                        *(GAS f32x4*)(kr + (size_t)row * 32 + 8 * fq) = a10; *(GAS f32x4*)(kr + (size_t)row * 32 + 8 * fq + 4) = a11;
                    }
                }
                EPI_FENCE();
            }
    }
};

struct EpiQ {
    static constexpr bool PERM = true, AFTER_DRAIN = false;
    unsigned char* ws;
    __device__ __forceinline__ void prefetch(const pg8::Unit&, int, int) const {}
    __device__ __forceinline__ void operator()(AccRef acc, const pg8::Unit& u, int wr, int wc, int fr_in, int fq_in) const {
        const int lane_e = pg8::lane_id_asm(); const int fr = lane_e & 15, fq = lane_e >> 4; (void)fr_in; (void)fq_in;
        unsigned long long wi_ = (unsigned long long)ws; asm volatile("" : "+s"(wi_)); GAS unsigned char* w = (GAS unsigned char*)wi_;
        const GAS float* ssq = (const GAS float*)(w + WS_SSQ); GAS bf16_t* Q = (GAS bf16_t*)(w + T_Q);
        const int rowb = u.pm * 256 + wr * 64 + fr;
        if (wc < 3) {
            float rs8[8];
            { f32x4 pp[8];
#pragma unroll
              for (int q = 0; q < 8; ++q) pp[q] = *(const GAS f32x4*)(ssq + (size_t)(rowb + (q >> 2) * 128 + (q & 3) * 16) * 4);
#pragma unroll
              for (int q = 0; q < 8; ++q) rs8[q] = rsqrtf(((pp[q][0] + pp[q][1]) + (pp[q][2] + pp[q][3])) * (1.0f / 256.0f) + EPS); }
            EPI_FENCE();
#pragma unroll
            for (int ai = 0; ai < 2; ++ai)
#pragma unroll
                for (int m = 0; m < 4; ++m) {
                    const int row = rowb + ai * 128 + m * 16, b = row >> 13, s = row & 8191;
                    const float rq = rs8[ai * 4 + m];
#pragma unroll
                    for (int bj = 0; bj < 2; ++bj) {
                        const int head = u.pn * 2 + bj;
                        *(GAS u32x4*)(Q + (unsigned)(((b * 16 + head) * SEQ + s) * 96 + wc * 32 + 8 * fq)) = pack8(acc[ai][bj][m][0] * rq, acc[ai][bj][m][1] * rq);
                    }
                    EPI_FENCE();
                }
        }
    }
};

struct EpiKV {
    static constexpr bool PERM = true, AFTER_DRAIN = false;
    unsigned char* ws; float* outp;
    __device__ __forceinline__ void prefetch(const pg8::Unit&, int, int) const {}
    __device__ __forceinline__ void operator()(AccRef acc, const pg8::Unit& u, int wr, int wc, int fr_in, int fq_in) const {
        const int lane_e = pg8::lane_id_asm(); const int fr = lane_e & 15, fq = lane_e >> 4; (void)fr_in; (void)fq_in;
        unsigned long long wi_ = (unsigned long long)ws; asm volatile("" : "+s"(wi_)); GAS unsigned char* w = (GAS unsigned char*)wi_;
        const GAS float* sskv = (const GAS float*)(w + WS_SSKV); GAS bf16_t* K = (GAS bf16_t*)(w + T_K); GAS bf16_t* Vt = (GAS bf16_t*)((GAS unsigned char*)(unsigned long long)outp + 64 * MiB);
        const int rowb = u.pm * 256 + wr * 64 + fr;
#pragma unroll
        for (int ai = 0; ai < 2; ++ai)
#pragma unroll
            for (int m = 0; m < 4; ++m) {
                const int row = rowb + ai * 128 + m * 16, b = row >> 13, s = row & 8191;
                const f32x4 pk = *(const GAS f32x4*)(sskv + (size_t)row * 4);
                const float r = rsqrtf(((pk[0] + pk[1]) + (pk[2] + pk[3])) * (1.0f / 128.0f) + EPS);
#pragma unroll
                for (int bj = 0; bj < 2; ++bj) {
                    const int head = u.pn * 2 + bj; const unsigned bh = (unsigned)(b * 16 + head);
                    const u32x4 wv = pack8(acc[ai][bj][m][0] * r, acc[ai][bj][m][1] * r);
                    if (wc < 2) {
                        *(GAS u32x4*)(K + ((bh * SEQ + s) * 96u + wc * 32 + 8 * fq)) = wv;
                    } else {
                        GAS bf16_t* vp = Vt + (bh * 64 + (wc - 2) * 32 + 8 * fq) * SEQ + s;
                        vp[0 * SEQ] = (bf16_t)(wv.x & 0xffff); vp[1 * SEQ] = (bf16_t)(wv.x >> 16); vp[2 * SEQ] = (bf16_t)(wv.y & 0xffff); vp[3 * SEQ] = (bf16_t)(wv.y >> 16);
                        vp[4 * SEQ] = (bf16_t)(wv.z & 0xffff); vp[5 * SEQ] = (bf16_t)(wv.z >> 16); vp[6 * SEQ] = (bf16_t)(wv.w & 0xffff); vp[7 * SEQ] = (bf16_t)(wv.w >> 16);
                    }
                }
                EPI_FENCE();
            }
    }
};

struct EpiSgIn {
    static constexpr bool PERM = true, AFTER_DRAIN = false;
    unsigned char* ws; LAS unsigned char* ldsE;
    __device__ __forceinline__ void prefetch(const pg8::Unit& u, int wid, int lane) const { ss_prefetch(ws, ldsE, u.pm, wid, lane); }
    __device__ __forceinline__ void operator()(AccRef acc, const pg8::Unit& u, int wr, int wc, int fr_in, int fq_in) const {
        const int lane_e = pg8::lane_id_asm(); const int fr = lane_e & 15, fq = lane_e >> 4; (void)fr_in; (void)fq_in;
        unsigned long long wi_ = (unsigned long long)ws; asm volatile("" : "+s"(wi_)); GAS unsigned char* w = (GAS unsigned char*)wi_;
        const GAS float* ss = (const GAS float*)(w + WS_SS); GAS bf16_t* U = (GAS bf16_t*)(w + T_Z); GAS bf16_t* V = (GAS bf16_t*)(w + T_BG); GAS float* ssv = (GAS float*)(w + WS_SSV);
        const int rowb = u.pm * 256 + wr * 64 + fr;
        GAS bf16_t* dstb = (u.pn < 4 ? U + u.pn * 256 : V + (u.pn - 4) * 256) + wc * 32 + 8 * fq;
        float rs8[8];
        { f32x4 pp[8];
#pragma unroll
          for (int q = 0; q < 8; ++q) pp[q] = *(const LAS f32x4*)(ldsE + ((q >> 2) * 128 + wr * 64 + (q & 3) * 16 + fr) * 64 + fq * 16);
#pragma unroll
          for (int q = 0; q < 8; ++q) rs8[q] = rsqrtf(red_fq((pp[q][0] + pp[q][1]) + (pp[q][2] + pp[q][3])) * (1.0f / 1024.0f) + EPS); }
        EPI_FENCE();
#pragma unroll
        for (int ai = 0; ai < 2; ++ai)
#pragma unroll
            for (int m = 0; m < 4; ++m) {
                const int row = rowb + ai * 128 + m * 16; const float rs = rs8[ai * 4 + m]; float sq = 0.f;
#pragma unroll
                for (int bj = 0; bj < 2; ++bj) {
                    f32x4 z0, z1;
#pragma unroll
                    for (int j = 0; j < 4; ++j) { z0[j] = gelu_tanh_f(acc[ai][bj][m][0][j] * rs); z1[j] = gelu_tanh_f(acc[ai][bj][m][1][j] * rs); }
                    *(GAS u32x4*)(dstb + (size_t)row * DM + bj * 128) = pack8(z0, z1);
                    sq += dot4(z0) + dot4(z1);
                }
                if (u.pn >= 4) { sq = red_fq(sq); if (fq == 0) ssv[(size_t)row * 16 + (u.pn - 4) * 4 + wc] = sq; } EPI_FENCE();
            }
    }
};

__device__ __forceinline__ int map_row(int kind, int n0) {
    switch (kind) {
        case 1: return (n0 >> 7) * 256 + (n0 & 127);
        case 2: return (n0 >> 7) * 256 + 128 + (n0 & 127);
        case 3: if (n0 < 1024) return 2048 + n0;
                if (n0 < 2048) { const int c = n0 - 1024; return (c >> 7) * 256 + (c & 127); }
                { const int c = n0 - 2048; return (c >> 7) * 256 + 128 + (c & 127); }
        case 4: return (n0 / 96) * 128 + (n0 % 96);
        default: return n0;
    }
}
__device__ __forceinline__ void tr_item(const float* __restrict__ W, int K, int N, bf16_t* __restrict__ WT, int pitch, const float* __restrict__ scale, int kind, LAS float* scr, int item, int lane) {
    const int nblk = N >> 5, kb = item / nblk, nb = item - kb * nblk, k0 = 64 * kb, n0 = 32 * nb, dr0 = map_row(kind, n0);
    {
        f32x4 v[8]; const int kr_ = lane >> 3, c4 = (lane & 7) * 4;
#pragma unroll
        for (int i = 0; i < 8; ++i) v[i] = *(const f32x4*)(W + (size_t)(k0 + 8 * i + kr_) * N + n0 + c4);
#pragma unroll
        for (int i = 0; i < 8; ++i) { const int kk = 8 * i + kr_; const float sc = scale ? scale[k0 + kk] : 1.0f;
            scr[kk * 33 + c4] = v[i][0] * sc; scr[kk * 33 + c4 + 1] = v[i][1] * sc; scr[kk * 33 + c4 + 2] = v[i][2] * sc; scr[kk * 33 + c4 + 3] = v[i][3] * sc; }
    }
    asm volatile("s_waitcnt lgkmcnt(0)" ::: "memory");
    const int c = lane & 7;
#pragma unroll
    for (int j = 0; j < 4; ++j) { const int n = (lane >> 3) + 8 * j; const LAS float* s = scr + (8 * c) * 33 + n;
        u32x4 o; o.x = cvtpk(s[0 * 33], s[1 * 33]); o.y = cvtpk(s[2 * 33], s[3 * 33]); o.z = cvtpk(s[4 * 33], s[5 * 33]); o.w = cvtpk(s[6 * 33], s[7 * 33]);
        *(u32x4*)(WT + (size_t)(dr0 + n) * pitch + k0 + 8 * c) = o; }
    asm volatile("s_waitcnt lgkmcnt(0)" ::: "memory");
}

struct Args {
    const float* in[22]; float* out; unsigned char* ws; float inv_freq[16]; int ph_lo, ph_hi;
};

__device__ __forceinline__ void prologue(const Args& a, LAS unsigned char* lds, int vcu, int G, int wave, int lane, int tid) {
    unsigned char* ws = a.ws;
    LAS float* scr = (LAS float*)(lds + wave * 16384);
    const int gw = vcu * NWAVES + wave, NGW = G * NWAVES;
    const float* norm_g = a.in[2];
    constexpr int I_FFN = 8 * 4224, I_CONV = 2 * 2048, I_MLA = 1040, I_SG = 1536, NITEMS = I_FFN + I_CONV + I_MLA + I_SG;
    for (int it = gw; it < NITEMS; it += NGW) {
        int r = it;
        if (r < I_FFN) {
            const int f = r / 4224, q = r % 4224, which = q / 1408, item = q % 1408, i = f >> 1, j = f & 1;
            bf16_t* wgu = (bf16_t*)(ws + ffn_w_off(f)); bf16_t* wd = wgu + (size_t)5632 * 1024;
            const float* g = norm_g + (size_t)(i * 3 + (j ? 2 : 0)) * 1024;
            if (which == 0) tr_item(a.in[3] + (size_t)f * 1024 * 2816, 1024, 2816, wgu, 1024, g, 1, scr, item, lane);
            else if (which == 1) tr_item(a.in[4] + (size_t)f * 1024 * 2816, 1024, 2816, wgu, 1024, g, 2, scr, item, lane);
            else tr_item(a.in[5] + (size_t)f * 2816 * 1024, 2816, 1024, wd, 2816, nullptr, 0, scr, item, lane);
            continue;
        }
        r -= I_FFN;
        if (r < I_CONV) {
            const int ia = r / 2048, q = r % 2048, li = ia == 0 ? 0 : 3;
            bf16_t* win = (bf16_t*)(ws + conv_w_off(ia)); bf16_t* wout = win + (size_t)3072 * 1024;
            if (q < 1536) tr_item(a.in[6] + (size_t)ia * 1024 * 3072, 1024, 3072, win, 1024, norm_g + (size_t)(li * 3 + 1) * 1024, 3, scr, q, lane);
            else tr_item(a.in[8] + (size_t)ia * 1024 * 1024, 1024, 1024, wout, 1024, nullptr, 0, scr, q - 1536, lane);
            continue;
        }
        r -= I_CONV;
        if (r < I_MLA) {
            if (r < 208) { tr_item(a.in[9], 1024, 416, (bf16_t*)(ws + W_MLA_A), 1024, norm_g + (size_t)(1 * 3 + 1) * 1024, 0, scr, r, lane); continue; }
            r -= 208;
            if (r < 192) { tr_item(a.in[11], 256, 1536, (bf16_t*)(ws + W_MLA_UQ), 256, a.in[10], 4, scr, r, lane); continue; }
            r -= 192;
            if (r < 128) { tr_item(a.in[13], 128, 2048, (bf16_t*)(ws + W_MLA_UKV), 256, a.in[12], 0, scr, r, lane); continue; }
            r -= 128;
            tr_item(a.in[16], 1024, 1024, (bf16_t*)(ws + W_MLA_O), 1024, nullptr, 0, scr, r, lane);
            continue;
        }
        r -= I_MLA;
        if (r < 1024) tr_item(a.in[17], 1024, 2048, (bf16_t*)(ws + W_SG_IN), 1024, norm_g + (size_t)(2 * 3 + 1) * 1024, 0, scr, r, lane);
        else tr_item(a.in[21], 1024, 1024, (bf16_t*)(ws + W_SG_OUT), 1024, nullptr, 0, scr, r - 1024, lane);
    }
    const int gt = vcu * NTHREADS + tid, NGT = G * NTHREADS;
    const u32x4 z4 = {0u, 0u, 0u, 0u};
    for (int p = gt; p < 12288; p += NGT) *(u32x4*)(ws + W_MLA_A + (size_t)416 * 2048 + (size_t)p * 16) = z4;
    for (int p = gt; p < 16384; p += NGT) { const int h = p >> 10, off = p & 1023; *(u32x4*)(ws + W_MLA_UQ + (size_t)(128 * h + 96) * 512 + (size_t)off * 16) = z4; }
    for (int p = gt; p < 32768; p += NGT) { const int row = p >> 4, c = p & 15; *(u32x4*)(ws + W_MLA_UKV + (size_t)row * 512 + 256 + c * 16) = z4; }
    for (int p = gt; p < 16384; p += NGT) {
        const int t = (p >> 4) & 127, s0 = (p & 15) * 8; const float* src = a.in[19] + (size_t)p * 8;
        const f32x4 w0 = *(const f32x4*)src, w1 = *(const f32x4*)(src + 4); f32x4 m0, m1;
#pragma unroll
        for (int j = 0; j < 4; ++j) { m0[j] = (s0 + j <= t) ? w0[j] : 0.f; m1[j] = (s0 + 4 + j <= t) ? w1[j] : 0.f; }
        *(u32x4*)(ws + W_SG_S + (size_t)p * 16) = pack8(m0, m1);
    }
    {
        const int* pos = (const int*)a.in[1]; float* cosT = (float*)(ws + WS_COS); float* sinT = (float*)(ws + WS_SIN);
        for (int p = gt; p < M_TOK * 16; p += NGT) {
            const int row = p >> 4, i = p & 15; const float ang = (float)pos[row] * a.inv_freq[i];
            const double ad = (double)ang, k = rint(ad * 0.15915494309189535); const float rr = (float)(ad - k * 6.283185307179586);
            cosT[p] = cosf(rr); sinT[p] = sinf(rr);
        }
    }
    {
        const float* x = a.in[0]; bf16_t* xb = (bf16_t*)(ws + WS_XB); float* ss = (float*)(ws + WS_SS);
        for (int row = gw; row < M_TOK; row += NGW) {
            const f32x4* xr = (const f32x4*)(x + (size_t)row * DM) + lane; f32x4 v[4]; float s = 0.f;
#pragma unroll
            for (int j = 0; j < 4; ++j) { v[j] = xr[64 * j]; s += dot4(v[j]); }
            s = wave_sum(s);
            u32x2* o = (u32x2*)(xb + (size_t)row * DM) + lane;
#pragma unroll
            for (int j = 0; j < 4; ++j) { u32x2 w; w.x = cvtpk(v[j][0], v[j][1]); w.y = cvtpk(v[j][2], v[j][3]); o[64 * j] = w; }
            if (lane < 16) ss[(size_t)row * 16 + lane] = lane == 0 ? s : 0.f;
        }
    }
}

__device__ __forceinline__ void unpack8(u32x4 w, float (&f)[8]) { f[0] = bf_lo(w.x); f[1] = bf_hi(w.x); f[2] = bf_lo(w.y); f[3] = bf_hi(w.y); f[4] = bf_lo(w.z); f[5] = bf_hi(w.z); f[6] = bf_lo(w.w); f[7] = bf_hi(w.w); }
__device__ __forceinline__ void conv_phase(const bf16_t* __restrict__ Z, const bf16_t* __restrict__ Bg, const float* __restrict__ ck, bf16_t* __restrict__ Gout, int gt, int NGT) {
    for (int it = gt; it < 2048 * 128; it += NGT) {
        const int cg8 = (it & 127) * 8, row0 = (it >> 7) * 16;
        float k0[8], k1[8], k2[8], zm2[8], zm1[8];
        { const f32x4 a0 = *(const f32x4*)(ck + cg8), a1 = *(const f32x4*)(ck + cg8 + 4), b0 = *(const f32x4*)(ck + 1024 + cg8), b1 = *(const f32x4*)(ck + 1024 + cg8 + 4), c0 = *(const f32x4*)(ck + 2048 + cg8), c1 = *(const f32x4*)(ck + 2048 + cg8 + 4);
#pragma unroll
          for (int j = 0; j < 4; ++j) { k0[j] = a0[j]; k0[4 + j] = a1[j]; k1[j] = b0[j]; k1[4 + j] = b1[j]; k2[j] = c0[j]; k2[4 + j] = c1[j]; } }
        if ((row0 & 8191) == 0) {
#pragma unroll
            for (int j = 0; j < 8; ++j) { zm2[j] = 0.f; zm1[j] = 0.f; }
        } else {
            unpack8(*(const u32x4*)(Z + (size_t)(row0 - 2) * DM + cg8), zm2); unpack8(*(const u32x4*)(Z + (size_t)(row0 - 1) * DM + cg8), zm1);
        }
#pragma unroll 4
        for (int r = 0; r < 16; ++r) {
            const size_t off = (size_t)(row0 + r) * DM + cg8; float z[8], b[8]; f32x4 o0, o1;
            unpack8(*(const u32x4*)(Z + off), z); unpack8(*(const u32x4*)(Bg + off), b);
#pragma unroll
            for (int j = 0; j < 4; ++j) { o0[j] = b[j] * (k0[j] * zm2[j] + k1[j] * zm1[j] + k2[j] * z[j]); o1[j] = b[4 + j] * (k0[4 + j] * zm2[4 + j] + k1[4 + j] * zm1[4 + j] + k2[4 + j] * z[4 + j]); }
            *(u32x4*)(Gout + off) = pack8(o0, o1);
#pragma unroll
            for (int j = 0; j < 8; ++j) { zm2[j] = zm1[j]; zm1[j] = z[j]; }
        }
    }
}

__device__ __forceinline__ void sg_phase(LAS unsigned char* lds, const bf16_t* __restrict__ U, const bf16_t* __restrict__ V, const float* __restrict__ ssv, const float* __restrict__ vnorm,
                                         const bf16_t* __restrict__ wsm, const float* __restrict__ bs, bf16_t* __restrict__ G2, int vcu, int G, const int wave_s) {
    constexpr int ROWB = 272, BOFF = 128 * ROWB;
    const int lane = pg8::lane_id_asm(), wid = wave_s, tid = wid * 64 + lane, fr = lane & 15, fq = lane >> 4;
    for (int u = vcu; u < 2048; u += G) {
        const int c = u >> 3, g = u & 7;
        for (int p = tid; p < 2048; p += NTHREADS) { const int t = p >> 4, cc = p & 15; *(LAS u32x4*)(lds + t * ROWB + cc * 16) = *(const u32x4*)(wsm + (size_t)g * 16384 + t * 128 + cc * 8); }
        for (int p = tid; p < 2048; p += NTHREADS) {
            const int s = p >> 4, cg8 = (p & 15) * 8, row = 128 * c + s;
            float v[8]; unpack8(*(const u32x4*)(V + (size_t)row * DM + 128 * g + cg8), v);
            const f32x4* sp = (const f32x4*)(ssv + (size_t)row * 16); const f32x4 a0 = sp[0], a1 = sp[1], a2 = sp[2], a3 = sp[3];
            const float tot = ((a0[0] + a0[1]) + (a0[2] + a0[3])) + ((a1[0] + a1[1]) + (a1[2] + a1[3])) + ((a2[0] + a2[1]) + (a2[2] + a2[3])) + ((a3[0] + a3[1]) + (a3[2] + a3[3]));
            const float rsv = rsqrtf(tot * (1.0f / 1024.0f) + EPS);
            const f32x4 n0 = *(const f32x4*)(vnorm + 128 * g + cg8), n1 = *(const f32x4*)(vnorm + 128 * g + cg8 + 4);
#pragma unroll
            for (int j = 0; j < 4; ++j) {
                const unsigned w = cvtpk(v[j] * rsv * n0[j], v[4 + j] * rsv * n1[j]);
                *(LAS bf16_t*)(lds + BOFF + (cg8 + j) * ROWB + s * 2) = (bf16_t)(w & 0xffff);
                *(LAS bf16_t*)(lds + BOFF + (cg8 + 4 + j) * ROWB + s * 2) = (bf16_t)(w >> 16);
            }
        }
        __syncthreads();
        f32x4 acc[8];
#pragma unroll
        for (int nb = 0; nb < 8; ++nb) acc[nb] = (f32x4){0.f, 0.f, 0.f, 0.f};
#pragma unroll
        for (int ks = 0; ks < 4; ++ks) {
            const bf16x8 wa = *(const LAS bf16x8*)(lds + (16 * wid + fr) * ROWB + (32 * ks + 8 * fq) * 2);
#pragma unroll
            for (int nb = 0; nb < 8; ++nb) {
                const bf16x8 vb = *(const LAS bf16x8*)(lds + BOFF + (16 * nb + fr) * ROWB + (32 * ks + 8 * fq) * 2);
                acc[nb] = __builtin_amdgcn_mfma_f32_16x16x32_bf16(vb, wa, acc[nb], 0, 0, 0);
            }
        }
        {
            const int t = 16 * wid + fr, row = 128 * c + t; const float bias = bs[g * 128 + t];
#pragma unroll
            for (int nb = 0; nb < 8; ++nb) {
                const size_t off = (size_t)row * DM + 128 * g + 16 * nb + 4 * fq;
                const u32x2 uu = *(const u32x2*)(U + off);
                u32x2 o; o.x = cvtpk(bf_lo(uu.x) * (acc[nb][0] + bias), bf_hi(uu.x) * (acc[nb][1] + bias)); o.y = cvtpk(bf_lo(uu.y) * (acc[nb][2] + bias), bf_hi(uu.y) * (acc[nb][3] + bias));
                *(u32x2*)(G2 + off) = o;
            }
        }
        __syncthreads();
    }
}

__device__ __forceinline__ void qk_finalize(bf16_t* __restrict__ Q, bf16_t* __restrict__ K, const float* __restrict__ kpe, const float* __restrict__ qgain, const float* __restrict__ kgain,
                                            const float* __restrict__ cosT, const float* __restrict__ sinT, int gt, int NGT) {
    for (int it = 16 * M_TOK + gt; it < 2 * 16 * M_TOK; it += NGT) {
        const bool isk = it >= 16 * M_TOK; const int rh = isk ? it - 16 * M_TOK : it;
        const int bh = rh >> 13, s = rh & 8191, row = (bh >> 4) * SEQ + s;
        bf16_t* p = (isk ? K : Q) + (size_t)rh * 96; const float* gain = isk ? kgain : qgain;
        float v[96];
        if (!isk) {
#pragma unroll
            for (int c = 0; c < 12; ++c) { const u32x4 w = *(const u32x4*)(p + 8 * c); v[8 * c] = bf_lo(w.x); v[8 * c + 1] = bf_hi(w.x); v[8 * c + 2] = bf_lo(w.y); v[8 * c + 3] = bf_hi(w.y); v[8 * c + 4] = bf_lo(w.z); v[8 * c + 5] = bf_hi(w.z); v[8 * c + 6] = bf_lo(w.w); v[8 * c + 7] = bf_hi(w.w); }
        } else {
#pragma unroll
            for (int c = 0; c < 8; ++c) { const u32x4 w = *(const u32x4*)(p + 8 * c); v[8 * c] = bf_lo(w.x); v[8 * c + 1] = bf_hi(w.x); v[8 * c + 2] = bf_lo(w.y); v[8 * c + 3] = bf_hi(w.y); v[8 * c + 4] = bf_lo(w.z); v[8 * c + 5] = bf_hi(w.z); v[8 * c + 6] = bf_lo(w.w); v[8 * c + 7] = bf_hi(w.w); }
#pragma unroll
            for (int c = 0; c < 8; ++c) { const f32x4 w = *(const f32x4*)(kpe + (size_t)row * 32 + 4 * c); v[64 + 4 * c] = w[0]; v[64 + 4 * c + 1] = w[1]; v[64 + 4 * c + 2] = w[2]; v[64 + 4 * c + 3] = w[3]; }
        }
        float ss = 0.f;
#pragma unroll
        for (int d = 0; d < 96; ++d) ss += v[d] * v[d];
        const float rsh = rsqrtf(ss * (1.0f / 96.0f) + EPS), osc = isk ? 1.0f : QSCALE;
#pragma unroll
        for (int d = 0; d < 96; ++d) v[d] *= rsh * gain[d];
#pragma unroll
        for (int c = 0; c < 4; ++c) {
            const f32x4 cs = *(const f32x4*)(cosT + (size_t)row * 16 + 4 * c), sn = *(const f32x4*)(sinT + (size_t)row * 16 + 4 * c);
#pragma unroll
            for (int j = 0; j < 4; ++j) { const int i = 4 * c + j; const float t1 = v[64 + i], t2 = v[80 + i]; v[64 + i] = t1 * cs[j] - t2 * sn[j]; v[80 + i] = t2 * cs[j] + t1 * sn[j]; }
        }
#pragma unroll
        for (int c = 0; c < 12; ++c) {
            u32x4 w; w.x = cvtpk(v[8 * c] * osc, v[8 * c + 1] * osc); w.y = cvtpk(v[8 * c + 2] * osc, v[8 * c + 3] * osc); w.z = cvtpk(v[8 * c + 4] * osc, v[8 * c + 5] * osc); w.w = cvtpk(v[8 * c + 6] * osc, v[8 * c + 7] * osc);
            *(u32x4*)(p + 8 * c) = w;
        }
    }
}

__device__ __forceinline__ float max3f_(float a, float b, float c) { return __builtin_fmaxf(__builtin_fmaxf(a, b), c); }
struct AttRegs { u32x4 k0, k1, v; };
#define ATT_BAR() asm volatile("s_waitcnt lgkmcnt(0)\n\ts_barrier" ::: "memory")
__device__ __forceinline__ void att_qk(const LAS unsigned char* kb, const bf16x8 (&qf)[6], f32x16& p0, f32x16& p1) {
    constexpr int KROW = 208;
    bf16x8 kf[12];
#pragma unroll
    for (int ds = 0; ds < 6; ++ds) { kf[2 * ds] = *(const LAS bf16x8*)(kb + ds * 32); kf[2 * ds + 1] = *(const LAS bf16x8*)(kb + 32 * KROW + ds * 32); }
#pragma unroll
    for (int r = 0; r < 16; ++r) { p0[r] = 0.f; p1[r] = 0.f; }
    __builtin_amdgcn_sched_barrier(0);
#pragma unroll
    for (int ds = 0; ds < 6; ++ds) {
        p0 = __builtin_amdgcn_mfma_f32_32x32x16_bf16(kf[2 * ds], qf[ds], p0, 0, 0, 0);
        p1 = __builtin_amdgcn_mfma_f32_32x32x16_bf16(kf[2 * ds + 1], qf[ds], p1, 0, 0, 0);
    }
    __builtin_amdgcn_sched_barrier(0);
}
template <bool NOMAX> __device__ __forceinline__ void att_soft_pv(const LAS unsigned char* vb, f32x16& p0, f32x16& p1, f32x16& o0, f32x16& o1, float& m_ref, float& l_run, int t, int qw0, int qabs, int hi) {
    constexpr int VROW = 136; constexpr float THR = 8.0f;
    s16x4 va[8], vb2[8];
#pragma unroll
    for (int ks = 0; ks < 4; ++ks) {
        va[2 * ks] = *(const LAS s16x4*)(vb + ks * 32); vb2[2 * ks] = *(const LAS s16x4*)(vb + ks * 32 + 16);
        va[2 * ks + 1] = *(const LAS s16x4*)(vb + 32 * VROW + ks * 32); vb2[2 * ks + 1] = *(const LAS s16x4*)(vb + 32 * VROW + ks * 32 + 16);
    }
    __builtin_amdgcn_sched_barrier(0);
    if (64 * t + 63 > qw0) {
        asm volatile("" ::: "memory");
#pragma unroll
        for (int r = 0; r < 16; ++r) { const int kv = 64 * t + (r & 3) + 8 * (r >> 2) + 4 * hi; if (kv > qabs) p0[r] = -INFINITY; if (kv + 32 > qabs) p1[r] = -INFINITY; }
    }
    if constexpr (!NOMAX) {
        float ma = max3f_(p0[0], p0[1], p1[0]), mb = max3f_(p0[2], p0[3], p1[1]); ma = max3f_(ma, p1[2], p1[3]);
#pragma unroll
        for (int r = 4; r < 16; r += 4) { ma = max3f_(ma, p0[r], p0[r + 1]); mb = max3f_(mb, p0[r + 2], p0[r + 3]); ma = max3f_(ma, p1[r], p1[r + 1]); mb = max3f_(mb, p1[r + 2], p1[r + 3]); }
        float mx = __builtin_fmaxf(ma, mb);
        { auto rr = __builtin_amdgcn_permlane32_swap(__float_as_uint(mx), __float_as_uint(mx), false, false); mx = __builtin_fmaxf(__uint_as_float(rr[0]), __uint_as_float(rr[1])); }
        if (__any(mx > m_ref + THR)) {
            const float mnew = __builtin_fmaxf(m_ref, mx), alpha = __builtin_amdgcn_exp2f(m_ref - mnew); m_ref = mnew; l_run *= alpha;
            o0 = o0 * alpha; o1 = o1 * alpha;
        }
        { const float negm = -m_ref; p0 = p0 + negm; p1 = p1 + negm; }
    }
#pragma unroll
    for (int r = 0; r < 16; ++r) { p0[r] = __builtin_amdgcn_exp2f(p0[r]); p1[r] = __builtin_amdgcn_exp2f(p1[r]); }
    { const f32x16 sv = p0 + p1; l_run += ((sv[0] + sv[1]) + (sv[2] + sv[3])) + ((sv[4] + sv[5]) + (sv[6] + sv[7])) + ((sv[8] + sv[9]) + (sv[10] + sv[11])) + ((sv[12] + sv[13]) + (sv[14] + sv[15])); }
    u32x4 pb[4];
    pb[0] = (u32x4){cvtpk(p0[0], p0[1]), cvtpk(p0[2], p0[3]), cvtpk(p0[4], p0[5]), cvtpk(p0[6], p0[7])};
    pb[1] = (u32x4){cvtpk(p0[8], p0[9]), cvtpk(p0[10], p0[11]), cvtpk(p0[12], p0[13]), cvtpk(p0[14], p0[15])};
    pb[2] = (u32x4){cvtpk(p1[0], p1[1]), cvtpk(p1[2], p1[3]), cvtpk(p1[4], p1[5]), cvtpk(p1[6], p1[7])};
    pb[3] = (u32x4){cvtpk(p1[8], p1[9]), cvtpk(p1[10], p1[11]), cvtpk(p1[12], p1[13]), cvtpk(p1[14], p1[15])};
    __builtin_amdgcn_sched_barrier(0);
#pragma unroll
    for (int ks = 0; ks < 4; ++ks) {
        const bf16x8 pf = __builtin_bit_cast(bf16x8, pb[ks]);
        { const s16x4 a = va[2 * ks], b = vb2[2 * ks];
          const bf16x8 vf = {a[0], a[1], a[2], a[3], b[0], b[1], b[2], b[3]};
          o0 = __builtin_amdgcn_mfma_f32_32x32x16_bf16(vf, pf, o0, 0, 0, 0); }
        { const s16x4 a = va[2 * ks + 1], b = vb2[2 * ks + 1];
          const bf16x8 vf = {a[0], a[1], a[2], a[3], b[0], b[1], b[2], b[3]};
          o1 = __builtin_amdgcn_mfma_f32_32x32x16_bf16(vf, pf, o1, 0, 0, 0); }
    }
}
struct AttK { u32x4 k0, k1; };
template <bool NOMAX> __device__ __forceinline__ void attn_units(LAS unsigned char* lds, const bf16_t* __restrict__ Q, const bf16_t* __restrict__ K, const bf16_t* __restrict__ Vt, bf16_t* __restrict__ O, const float* __restrict__ qgain, const float* __restrict__ cosT, const float* __restrict__ sinT, int vcu, int G, const int wave_s) {
    constexpr int KROW = 208, VROW = 136, KBUF = 64 * KROW, VBUF = 64 * VROW, VOFF = 2 * KBUF;
    const int lane = pg8::lane_id_asm(), wid = wave_s, tid = wid * 64 + lane, r32 = lane & 31, hi = lane >> 5;
    const int kp0r = tid / 12, kp0c = tid % 12, kp1r = (512 + tid) / 12, kp1c = (512 + tid) % 12, vdv = tid >> 3, vc = tid & 7;
    for (int u = vcu; u < 2048; u += G) {
        const int v = u & 255, i = u >> 8, bh = v >> 2, s4 = v & 3, pr = i >> 1, qb = (i & 1) ? 8 * pr + 7 - s4 : 8 * pr + s4;
        const int q0 = qb * 256, NT = (q0 + 256) / 64, qw0 = q0 + 32 * wid, qabs = qw0 + r32;
        const bf16_t* Qp = Q + ((size_t)bh * SEQ + qabs) * 96 + 8 * hi;
        bf16x8 qf[6];
#pragma unroll
        for (int ds = 0; ds < 6; ++ds) qf[ds] = *(const bf16x8*)(Qp + 16 * ds);
        {
            float ssq_ = 0.f;
#pragma unroll
            for (int ds = 0; ds < 6; ++ds) { const u32x4 w = __builtin_bit_cast(u32x4, qf[ds]);
                const float a0 = bf_lo(w.x), a1 = bf_hi(w.x), a2 = bf_lo(w.y), a3 = bf_hi(w.y), a4 = bf_lo(w.z), a5 = bf_hi(w.z), a6 = bf_lo(w.w), a7 = bf_hi(w.w);
                ssq_ += ((a0 * a0 + a1 * a1) + (a2 * a2 + a3 * a3)) + ((a4 * a4 + a5 * a5) + (a6 * a6 + a7 * a7)); }
            { auto rr = __builtin_amdgcn_permlane32_swap(__float_as_uint(ssq_), __float_as_uint(ssq_), false, false); ssq_ = __uint_as_float(rr[0]) + __uint_as_float(rr[1]); }
            float rq = rsqrtf(ssq_ * (1.0f / 96.0f) + EPS) * QSCALE; asm volatile("" : "+v"(rq));
#pragma unroll
            for (int ds = 0; ds < 6; ++ds) asm volatile("" : "+v"(qf[ds]));
#pragma unroll
            for (int ds = 0; ds < 4; ++ds) {
                const u32x4 w = __builtin_bit_cast(u32x4, qf[ds]);
                const f32x4 g0 = *(const f32x4*)(qgain + 16 * ds + 8 * hi), g1 = *(const f32x4*)(qgain + 16 * ds + 8 * hi + 4);
                u32x4 o; o.x = cvtpk(bf_lo(w.x) * g0[0] * rq, bf_hi(w.x) * g0[1] * rq); o.y = cvtpk(bf_lo(w.y) * g0[2] * rq, bf_hi(w.y) * g0[3] * rq);
                o.z = cvtpk(bf_lo(w.z) * g1[0] * rq, bf_hi(w.z) * g1[1] * rq); o.w = cvtpk(bf_lo(w.w) * g1[2] * rq, bf_hi(w.w) * g1[3] * rq);
                qf[ds] = __builtin_bit_cast(bf16x8, o);
                asm volatile("" ::: "memory");
            }
            {
                const u32x4 w1 = __builtin_bit_cast(u32x4, qf[4]), w2 = __builtin_bit_cast(u32x4, qf[5]);
                const size_t trow = (size_t)((bh >> 4) * SEQ + qabs) * 16 + 8 * hi;
                u32x4 p1, p2;
                {   const f32x4 ga = *(const f32x4*)(qgain + 64 + 8 * hi), gb = *(const f32x4*)(qgain + 80 + 8 * hi), c = *(const f32x4*)(cosT + trow), sn = *(const f32x4*)(sinT + trow);
                    const f32x4 t1 = {bf_lo(w1.x) * ga[0], bf_hi(w1.x) * ga[1], bf_lo(w1.y) * ga[2], bf_hi(w1.y) * ga[3]}, t2 = {bf_lo(w2.x) * gb[0], bf_hi(w2.x) * gb[1], bf_lo(w2.y) * gb[2], bf_hi(w2.y) * gb[3]};
                    const f32x4 o1 = (t1 * c - t2 * sn) * rq, o2 = (t2 * c + t1 * sn) * rq;
                    p1.x = cvtpk(o1[0], o1[1]); p1.y = cvtpk(o1[2], o1[3]); p2.x = cvtpk(o2[0], o2[1]); p2.y = cvtpk(o2[2], o2[3]); }
                asm volatile("" ::: "memory");
                {   const f32x4 ga = *(const f32x4*)(qgain + 64 + 8 * hi + 4), gb = *(const f32x4*)(qgain + 80 + 8 * hi + 4), c = *(const f32x4*)(cosT + trow + 4), sn = *(const f32x4*)(sinT + trow + 4);
                    const f32x4 t1 = {bf_lo(w1.z) * ga[0], bf_hi(w1.z) * ga[1], bf_lo(w1.w) * ga[2], bf_hi(w1.w) * ga[3]}, t2 = {bf_lo(w2.z) * gb[0], bf_hi(w2.z) * gb[1], bf_lo(w2.w) * gb[2], bf_hi(w2.w) * gb[3]};
                    const f32x4 o1 = (t1 * c - t2 * sn) * rq, o2 = (t2 * c + t1 * sn) * rq;
                    p1.z = cvtpk(o1[0], o1[1]); p1.w = cvtpk(o1[2], o1[3]); p2.z = cvtpk(o2[0], o2[1]); p2.w = cvtpk(o2[2], o2[3]); }
                qf[4] = __builtin_bit_cast(bf16x8, p1); qf[5] = __builtin_bit_cast(bf16x8, p2);
            }
        }
        const bf16_t* Kb = K + (size_t)bh * SEQ * 96; const bf16_t* Vb = Vt + (size_t)bh * 64 * SEQ + (size_t)vdv * SEQ + vc * 8;
        AttK Kx; Kx.k1 = (u32x4){0u, 0u, 0u, 0u}; u32x4 Vx;
#define LDK(R, t) do { const bf16_t* kt_ = Kb + (size_t)(t) * 6144; R.k0 = *(const u32x4*)(kt_ + tid * 8); if (tid < 256) R.k1 = *(const u32x4*)(kt_ + (512 + tid) * 8); } while (0)
#define LDV(R, t) do { R = *(const u32x4*)(Vb + (t) * 64); } while (0)
#define STK(R, sl) do { LAS unsigned char* kb_ = lds + (sl) * KBUF; *(LAS u32x4*)(kb_ + kp0r * KROW + kp0c * 16) = R.k0; if (tid < 256) *(LAS u32x4*)(kb_ + kp1r * KROW + kp1c * 16) = R.k1; } while (0)
#define STV(R, sl) do { LAS unsigned char* vb_ = lds + VOFF + (sl) * VBUF + vdv * VROW + vc * 16; *(LAS u32x2*)(vb_) = (u32x2){R.x, R.y}; *(LAS u32x2*)(vb_ + 8) = (u32x2){R.z, R.w}; } while (0)
#define ACT(t) (64 * (t) <= qw0 + 31)
        float m_ref = -INFINITY, l_run = 0.f; f32x16 o0, o1, sA0, sA1, sB0, sB1;
#pragma unroll
        for (int r = 0; r < 16; ++r) { o0[r] = 0.f; o1[r] = 0.f; }
        const LAS unsigned char* kbase = lds + r32 * KROW + hi * 16; const LAS unsigned char* vbase = lds + VOFF + r32 * VROW + hi * 8;
        LDK(Kx, 0); LDV(Vx, 0); STK(Kx, 0); STV(Vx, 0); LDK(Kx, 1); STK(Kx, 1);
        ATT_BAR();
        att_qk(kbase, qf, sA0, sA1);
        ATT_BAR();
        for (int t = 0; t < NT; t += 2) {
            if (t + 2 < NT) LDK(Kx, t + 2);
            LDV(Vx, t + 1);
            if (ACT(t + 1)) att_qk(kbase + KBUF, qf, sB0, sB1);
            if (ACT(t)) att_soft_pv<NOMAX>(vbase, sA0, sA1, o0, o1, m_ref, l_run, t, qw0, qabs, hi);
            if (t + 2 < NT) STK(Kx, 0);
            STV(Vx, 1);
            ATT_BAR();
            if (t + 3 < NT) LDK(Kx, t + 3);
            if (t + 2 < NT) LDV(Vx, t + 2);
            if (t + 2 < NT && ACT(t + 2)) att_qk(kbase, qf, sA0, sA1);
            if (ACT(t + 1)) att_soft_pv<NOMAX>(vbase + VBUF, sB0, sB1, o0, o1, m_ref, l_run, t + 1, qw0, qabs, hi);
            if (t + 3 < NT) STK(Kx, 1);
            if (t + 2 < NT) STV(Vx, 0);
            ATT_BAR();
        }
        {
            float lt = l_run; { auto rr = __builtin_amdgcn_permlane32_swap(__float_as_uint(lt), __float_as_uint(lt), false, false); lt = __uint_as_float(rr[0]) + __uint_as_float(rr[1]); }
            const float inv = 1.0f / lt;
            const int b = bh >> 4, h = bh & 15;
            bf16_t* Op = O + ((size_t)(b * SEQ + qabs)) * DM + h * 64 + 4 * hi;
#pragma unroll
            for (int rg = 0; rg < 4; ++rg) {
                u32x2 w0; w0.x = cvtpk(o0[4 * rg] * inv, o0[4 * rg + 1] * inv); w0.y = cvtpk(o0[4 * rg + 2] * inv, o0[4 * rg + 3] * inv);
                u32x2 w1; w1.x = cvtpk(o1[4 * rg] * inv, o1[4 * rg + 1] * inv); w1.y = cvtpk(o1[4 * rg + 2] * inv, o1[4 * rg + 3] * inv);
                *(u32x2*)(Op + 8 * rg) = w0; *(u32x2*)(Op + 32 + 8 * rg) = w1;
            }
        }
    }
#undef LDK
#undef LDV
#undef STK
#undef STV
#undef ACT
}
__device__ __forceinline__ void attn_phase(LAS unsigned char* lds, const bf16_t* __restrict__ Q, const bf16_t* __restrict__ K, const bf16_t* __restrict__ Vt, bf16_t* __restrict__ O, const float* __restrict__ qgain, const float* __restrict__ kgain, const float* __restrict__ cosT, const float* __restrict__ sinT, int vcu, int G, const int wave_s) {
    bool fast;
    { const int lane = pg8::lane_id_asm(); float gq = fabsf(qgain[lane]), gk = fabsf(kgain[lane]);
      if (lane < 32) { gq = fmaxf(gq, fabsf(qgain[64 + lane])); gk = fmaxf(gk, fabsf(kgain[64 + lane])); }
#pragma unroll
      for (int o = 1; o < 64; o <<= 1) { gq = fmaxf(gq, __shfl_xor(gq, o)); gk = fmaxf(gk, __shfl_xor(gk, o)); }
      fast = __builtin_amdgcn_readfirstlane((int)(14.14f * gq * gk < 60.0f)) != 0; }
    if (fast) attn_units<true>(lds, Q, K, Vt, O, qgain, cosT, sinT, vcu, G, wave_s); else attn_units<false>(lds, Q, K, Vt, O, qgain, cosT, sinT, vcu, G, wave_s);
    __builtin_amdgcn_s_waitcnt(0);
    {
    }
}

#define RLX_AGENT __ATOMIC_RELAXED, __HIP_MEMORY_SCOPE_AGENT
#define LDS_WAIT() asm volatile("s_waitcnt lgkmcnt(0)" ::: "memory")
#define VM_WAIT() asm volatile("s_waitcnt vmcnt(0)" ::: "memory")
__device__ __forceinline__ unsigned long long rt() { return __builtin_amdgcn_s_memrealtime(); }
__device__ __forceinline__ unsigned f2bf(float f) { unsigned u = __builtin_bit_cast(unsigned, f); return (u + 0x7fffu + ((u >> 16) & 1u)) >> 16; }
__device__ __forceinline__ unsigned pk2(float lo, float hi) { return f2bf(lo) | (f2bf(hi) << 16); }

#define XB_TMO      128
#define XB_XCNT(j)  (256  + 64 * (j))
#define XB_XSUB(j)  (1280 + 64 * (j))
#define XB_XGEN(j)  (2304 + 64 * (j))
#define XB_TOP      3328
#define XB_TOPGEN   3392
#define XCD_BAR_WORDS 3456
#define XB_SPIN_CAP (1u << 18)

__device__ __forceinline__ unsigned xb_ld(unsigned* p)              { return __hip_atomic_load(p, __ATOMIC_RELAXED, __HIP_MEMORY_SCOPE_AGENT); }
__device__ __forceinline__ unsigned xb_add(unsigned* p, unsigned v) { return __hip_atomic_fetch_add(p, v, __ATOMIC_RELAXED, __HIP_MEMORY_SCOPE_AGENT); }
__device__ __forceinline__ unsigned xb_xcc_id() { return (unsigned)__builtin_amdgcn_s_getreg((3 << 11) | 20) & 0xFu; }
#define XB_SPIN(cond, bar) do { unsigned _sp = 0; while (cond) { __builtin_amdgcn_s_sleep(1); \
    if ((++_sp & 255u) == 0u) { if (xb_ld(&(bar)[XB_TMO])) break; if (_sp > XB_SPIN_CAP) { atomicAdd(&(bar)[XB_TMO], 1u); break; } } } } while (0)

struct XcdBarrier {
    unsigned* bar; unsigned x;
    volatile LAS unsigned* st;
};

__device__ __forceinline__ XcdBarrier xcd_barrier_post(unsigned* bar, volatile LAS unsigned* st) {
    XcdBarrier b; b.bar = bar; b.x = xb_xcc_id(); b.st = st;
    if (threadIdx.x == 0) (void)xb_add(&bar[XB_XCNT(b.x)], 1u);
    return b;
}
__device__ __forceinline__ void xcd_barrier_complete(unsigned* bar, unsigned x, unsigned& nloc, unsigned& nx) {
    const unsigned G = gridDim.x * gridDim.y * gridDim.z;
    unsigned sum, cnt, mine, sp = 0u;
    for (;;) {
        sum = 0u; cnt = 0u; mine = 0u;
#pragma unroll
        for (unsigned j = 0; j < 16; ++j) { const unsigned c = xb_ld(&bar[XB_XCNT(j)]); sum += c; cnt += (c > 0u) ? 1u : 0u; mine = (j == x) ? c : mine; }
        if (sum == G) break;
        __builtin_amdgcn_s_sleep(1);
        if ((++sp & 255u) == 0u) { if (xb_ld(&bar[XB_TMO])) break; if (sp > XB_SPIN_CAP) { atomicAdd(&bar[XB_TMO], 1u); break; } }
    }
    nloc = mine > 0u ? mine : 1u; nx = cnt > 0u ? cnt : 1u;
}

__device__ __forceinline__ void xcd_barrier(const XcdBarrier& b) {
    asm volatile("s_waitcnt vmcnt(0)" ::: "memory");
    __syncthreads();
    if (threadIdx.x == 0) {
        unsigned* bar = b.bar;
        __builtin_amdgcn_s_waitcnt(0);
        unsigned nloc = b.st[0], nx = b.st[1];
        if (nloc == 0u) { xcd_barrier_complete(bar, b.x, nloc, nx); b.st[0] = nloc; b.st[1] = nx; }
        const unsigned old = xb_add(&bar[XB_XSUB(b.x)], 1u);
        const unsigned gen = old / nloc;
        if (old + 1u == (gen + 1u) * nloc) {
            __builtin_amdgcn_fence(__ATOMIC_RELEASE, "agent");
            asm volatile("s_waitcnt vmcnt(0)" ::: "memory");
            const unsigned og = xb_add(&bar[XB_TOP], 1u);
            const unsigned tg = og / nx;
            if (og + 1u == (tg + 1u) * nx) xb_add(&bar[XB_TOPGEN], 1u);
            else XB_SPIN(xb_ld(&bar[XB_TOPGEN]) == tg, bar);
            __builtin_amdgcn_fence(__ATOMIC_ACQUIRE, "agent");
            xb_add(&bar[XB_XGEN(b.x)], 1u);
            asm volatile("s_waitcnt vmcnt(0)" ::: "memory");
        } else {
            XB_SPIN(xb_ld(&bar[XB_XGEN(b.x)]) == gen, bar);
            __builtin_amdgcn_fence(__ATOMIC_ACQUIRE, "agent");
            asm volatile("s_waitcnt vmcnt(0)" ::: "memory");
        }
    }
    __syncthreads();
}

__global__ void __launch_bounds__(NTHREADS, 2) fwd_mega(Args a) {
    extern __shared__ __attribute__((aligned(16))) unsigned char lds_raw[];
    LAS unsigned char* lds = (LAS unsigned char*)lds_raw;
    cg::grid_group grid = cg::this_grid();
    const int wave_s = __builtin_amdgcn_readfirstlane(threadIdx.x >> 6);
#define TID_NOW (wave_s * 64 + pg8::lane_id_asm())
    if (threadIdx.x < 4) ((volatile LAS unsigned*)(lds + MISC_OFF))[threadIdx.x] = 0u;
    __syncthreads();
    (void)xcd_barrier_post((unsigned*)(a.ws + WS_CTL), (volatile LAS unsigned*)(lds + MISC_OFF));
#define PH_ON (true)
#define SEAM() do { { unsigned long long wsb_ = (unsigned long long)a.ws; asm volatile("" : "+s"(wsb_)); XcdBarrier b_; b_.bar = (unsigned*)((unsigned char*)wsb_ + WS_CTL); b_.x = xb_xcc_id(); b_.st = (volatile LAS unsigned*)(lds + MISC_OFF); xcd_barrier(b_); } } while (0)
#ifdef PROBE_SYNC2
#define PH_NEXT do { SEAM(); SEAM(); } while (0)
#else
#define PH_NEXT do { SEAM(); } while (0)
#endif
#define WS_LOCAL int G = gridDim.x; asm volatile("" : "+s"(G)); const int bx = blockIdx.x, vcu = (G % 8 == 0) ? (bx % 8) * (G / 8) + bx / 8 : bx; (void)vcu; unsigned long long wsi_ = (unsigned long long)a.ws; asm volatile("" : "+s"(wsi_)); unsigned char* ws = (unsigned char*)(GAS unsigned char*)wsi_; float* ss = (float*)(ws + WS_SS); bf16_t* xb = (bf16_t*)(ws + WS_XB); (void)ss; (void)xb

#ifndef DIS_P0
    if (PH_ON) { WS_LOCAL; const int tid = TID_NOW;
#ifdef PROBE_P02
#pragma unroll 1
        for (int rep_ = 0; rep_ < 2; ++rep_)
#endif
        prologue(a, lds, vcu, G, wave_s, tid & 63, tid); }
#endif
    if (a.ph_lo != 0) grid.sync();
    PH_NEXT;

#pragma unroll 1
    for (int li = 0; li < 4; ++li) {
#pragma unroll 1
        for (int j = 0; j < 2; ++j) {
            const int f = li * 2 + j;
            if (PH_ON) {
                WS_LOCAL; const bf16_t* wgu = (const bf16_t*)(ws + ffn_w_off(f));
                pg8::Gemm g{xb, wgu, M_TOK, 5632, 1024}; pg8::StaticOrder S; S.init(M_TOK, 5632, G, bx);
                EpiSwiglu E{ws, lds + EPI_OFF};
#ifndef DIS_F1
#ifdef PROBE_F12
#pragma unroll 1
                for (int rep_ = 0; rep_ < 2; ++rep_)
#endif
                pg8::gemm_phase<EpiSwiglu, pg8::StaticOrder, true, true>(lds, g, S, E, wave_s);
#endif
            }
            PH_NEXT;
            if (PH_ON) {
                WS_LOCAL; const bf16_t* wd = (const bf16_t*)(ws + ffn_w_off(f)) + (size_t)5632 * 1024;
                pg8::Gemm g{(const bf16_t*)(ws + T_H), wd, M_TOK, 1024, FF}; pg8::StaticOrder S; S.init(M_TOK, 1024, G, bx);
                EpiResid E{a.in[0], a.out, ws, 0.5f, f == 0 ? 1 : (f == 7 ? (2 | 4) : 0)};
#ifndef DIS_RES
                pg8::gemm_phase<EpiResid, pg8::StaticOrder, true, true>(lds, g, S, E, wave_s);
#endif
            }
            if (f != 7) PH_NEXT;
            if (j == 0) {
                const int kind = li % 3;
                if (kind == 0) {
                    const int ia = li == 0 ? 0 : 1;
                    if (PH_ON) {
                        WS_LOCAL; const bf16_t* win = (const bf16_t*)(ws + conv_w_off(ia));
                        pg8::Gemm g{xb, win, M_TOK, 3072, 1024}; pg8::StaticOrder S; S.init(M_TOK, 3072, G, bx);
                        EpiConvIn E{ws, lds + EPI_OFF};
#ifndef DIS_C1
                        pg8::gemm_phase<EpiConvIn, pg8::StaticOrder, true, true>(lds, g, S, E, wave_s);
#endif
                    }
                    PH_NEXT;
#ifndef DIS_E
                    if (PH_ON) { WS_LOCAL; const int tid = TID_NOW; conv_phase((const bf16_t*)(ws + T_Z), (const bf16_t*)(ws + T_BG), a.in[7] + (size_t)ia * 3 * 1024, (bf16_t*)(ws + T_G), vcu * NTHREADS + tid, G * NTHREADS); }
#endif
                    PH_NEXT;
                } else if (kind == 1) {
                    if (PH_ON) {
                        WS_LOCAL;
                        pg8::Gemm g{xb, (const bf16_t*)(ws + W_MLA_A), M_TOK, 512, 1024}; pg8::StaticOrder S; S.init(M_TOK, 512, G, bx);
                        EpiMlaA E{ws, lds + EPI_OFF};
#ifndef DIS_M1
                        pg8::gemm_phase<EpiMlaA, pg8::StaticOrder, true, true>(lds, g, S, E, wave_s);
#endif
                    }
                    PH_NEXT;
                    if (PH_ON) {
                        { WS_LOCAL; pg8::Gemm g{(const bf16_t*)(ws + T_AQ), (const bf16_t*)(ws + W_MLA_UQ), M_TOK, 2048, 256}; pg8::StaticOrder S; S.init(M_TOK, 2048, G, bx);
                          EpiQ E{ws};
#ifndef DIS_M2
                          pg8::gemm_phase<EpiQ, pg8::StaticOrder, true, true>(lds, g, S, E, wave_s);
#endif
                        }
                        { WS_LOCAL; pg8::Gemm g{(const bf16_t*)(ws + T_AKV), (const bf16_t*)(ws + W_MLA_UKV), M_TOK, 2048, 256}; pg8::StaticOrder S; S.init(M_TOK, 2048, G, bx);
                          EpiKV E{ws, a.out};
#ifndef DIS_M3
                          pg8::gemm_phase<EpiKV, pg8::StaticOrder, true, true>(lds, g, S, E, wave_s);
#endif
                        }
                    }
                    PH_NEXT;
#ifndef DIS_FIN
                    if (PH_ON) { WS_LOCAL; const int tid = TID_NOW; qk_finalize((bf16_t*)(ws + T_Q), (bf16_t*)(ws + T_K), (const float*)(ws + WS_KR), a.in[14], a.in[15], (const float*)(ws + WS_COS), (const float*)(ws + WS_SIN), vcu * NTHREADS + tid, G * NTHREADS); }
#endif
                    PH_NEXT;
#ifndef DIS_ATT
                    if (PH_ON) { WS_LOCAL;
#ifdef PROBE_ATT2
#pragma unroll 1
                        for (int rep_ = 0; rep_ < 2; ++rep_)
#endif
                        attn_phase(lds, (const bf16_t*)(ws + T_Q), (const bf16_t*)(ws + T_K), (const bf16_t*)((const unsigned char*)a.out + 64 * MiB), (bf16_t*)(ws + T_O), a.in[14], a.in[15], (const float*)(ws + WS_COS), (const float*)(ws + WS_SIN), vcu, G, wave_s); }
#endif
                    PH_NEXT;
                } else {
                    if (PH_ON) {
                        WS_LOCAL;
                        pg8::Gemm g{xb, (const bf16_t*)(ws + W_SG_IN), M_TOK, 2048, 1024}; pg8::StaticOrder S; S.init(M_TOK, 2048, G, bx);
                        EpiSgIn E{ws, lds + EPI_OFF};
#ifndef DIS_S1
                        pg8::gemm_phase<EpiSgIn, pg8::StaticOrder, true, true>(lds, g, S, E, wave_s);
#endif
                    }
                    PH_NEXT;
#ifndef DIS_S2
                    if (PH_ON) { WS_LOCAL; sg_phase(lds, (const bf16_t*)(ws + T_Z), (const bf16_t*)(ws + T_BG), (const float*)(ws + WS_SSV), a.in[18], (const bf16_t*)(ws + W_SG_S), a.in[20], (bf16_t*)(ws + T_G), vcu, G, wave_s); }
#endif
                    PH_NEXT;
                }
                if (PH_ON) {
                    WS_LOCAL;
                    const bf16_t* Amix = (const bf16_t*)(ws + (kind == 1 ? T_O : T_G));
                    const bf16_t* Wmix = kind == 0 ? (const bf16_t*)(ws + conv_w_off(li == 0 ? 0 : 1)) + (size_t)3072 * 1024 : kind == 1 ? (const bf16_t*)(ws + W_MLA_O) : (const bf16_t*)(ws + W_SG_OUT);
                    pg8::Gemm g{Amix, Wmix, M_TOK, 1024, 1024}; pg8::StaticOrder S; S.init(M_TOK, 1024, G, bx);
                    EpiResid E{a.in[0], a.out, ws, 1.0f, li == 3 ? 8 : 0};
#ifndef DIS_RES
                    pg8::gemm_phase<EpiResid, pg8::StaticOrder, true, true>(lds, g, S, E, wave_s);
#endif
                }
                PH_NEXT;
            }
        }
    }
}

#ifndef MK_PER_PHASE
#define MK_PER_PHASE 0
#endif
extern "C" void kernel_launch(void* const* d_in, const int* in_sizes, int n_in, void* d_out, int out_size, void* d_ws, size_t ws_size, hipStream_t stream) {
    static int grid = 0;
    if (grid == 0) {
        if (n_in != 22 || out_size != M_TOK * DM || ws_size < WS_END) { fprintf(stderr, "kernel_launch: unexpected shapes (n_in %d out %d ws %zu)\n", n_in, out_size, ws_size); grid = -1; return; }
        int dev = 0, cus = 0, per_cu = 0;
        hipGetDevice(&dev); hipDeviceGetAttribute(&cus, hipDeviceAttributeMultiprocessorCount, dev);
        if (hipFuncSetAttribute((const void*)fwd_mega, hipFuncAttributeMaxDynamicSharedMemorySize, LDS_BYTES) != hipSuccess) fprintf(stderr, "kernel_launch: hipFuncSetAttribute failed\n");
        if (hipOccupancyMaxActiveBlocksPerMultiprocessor(&per_cu, (const void*)fwd_mega, NTHREADS, LDS_BYTES) != hipSuccess || per_cu < 1) { fprintf(stderr, "kernel_launch: occupancy query says %d\n", per_cu); per_cu = 1; }
        (void)hipGetLastError();
        grid = cus * 1;
        fprintf(stderr, "kernel_launch: grid %d (per_cu %d)\n", grid, per_cu);
    }
    if (grid < 0) return;
    if (hipMemsetAsync((char*)d_ws + WS_CTL, 0, CTL_ZERO_BYTES, stream) != hipSuccess) { fprintf(stderr, "kernel_launch: memset failed\n"); return; }
    Args a{};
    for (int i = 0; i < 22; ++i) a.in[i] = (const float*)d_in[i];
    a.out = (float*)d_out; a.ws = (unsigned char*)d_ws;
    for (int i = 0; i < 16; ++i) { const float e = (float)(2 * i) / 32.0f; a.inv_freq[i] = 1.0f / powf(10000.0f, e); }
#if MK_PER_PHASE
    for (int p = 0; p < 31; ++p) { a.ph_lo = p; a.ph_hi = p + 1; hipLaunchKernelGGL(fwd_mega, dim3(grid), dim3(NTHREADS), LDS_BYTES, stream, a); }
#else
    a.ph_lo = 0; a.ph_hi = 1000;
    void* args[] = {&a};
    const hipError_t e = hipLaunchCooperativeKernel((const void*)fwd_mega, dim3(grid), dim3(NTHREADS), args, LDS_BYTES, stream);
    if (e != hipSuccess) fprintf(stderr, "kernel_launch: cooperative launch failed: %s (grid %d)\n", hipGetErrorString(e), grid);
#endif
}
```

```cpp
#include <hip/hip_runtime.h>
#include <hip/hip_cooperative_groups.h>
#include <cstdio>
#include <cstdint>
#include <cmath>
namespace cg = cooperative_groups;
namespace pg8 {
#define PG8_LAS __attribute__((address_space(3)))
typedef unsigned short bf16_t;
typedef short bf16x8 __attribute__((ext_vector_type(8)));
typedef float f32x4 __attribute__((ext_vector_type(4)));
typedef unsigned u32x4 __attribute__((ext_vector_type(4)));
constexpr int BM = 256, BK = 64, HALF = 128, HTB = HALF * BK * 2  , STAGE_BYTES = 8 * HTB, NXCD = 8, WGM = 8;

__host__ __device__ __forceinline__ int lds_byte(int r, int c) { const int st = (r >> 4) * 2 + (c >> 5), rr = r & 15, cc = c & 31, ob = rr * 64 + cc * 2; return st * 1024 + (ob ^ (((ob >> 9) & 1) << 5)); }
__host__ __device__ __forceinline__ void stage_rc(int b, int& R, int& C) { const int st = b / 1024, sb = b % 1024, swz = sb ^ (((sb >> 9) & 1) << 5); R = (st >> 1) * 16 + swz / 64; C = (st & 1) * 32 + (swz % 64) / 2; }
__host__ __device__ __forceinline__ int perm32(int rho) { const int n = rho >> 4, i = rho & 15; return 8 * (i >> 2) + 4 * n + (i & 3); }

__device__ __forceinline__ int lane_id_asm() { int l; asm volatile("v_mbcnt_lo_u32_b32 %0, -1, 0\n\tv_mbcnt_hi_u32_b32 %0, -1, %0" : "=v"(l)); return l; }
struct Unit { int pm, pn; };
struct Gemm { const bf16_t* A; const bf16_t* Bt; int M, N, K; };

struct StaticOrder {
    int nM, nN, nwg, G, c;
    __host__ __device__ void init(int M, int N, int G_, int c_) { nM = M / BM; nN = N / BM; nwg = nM * nN; G = G_; c = c_; }
    __host__ __device__ bool next(int i, Unit& u) const {
        const long L = (long)i * G + c; if (L >= nwg) return false;
        int wgid = (int)L; { const int q = nwg / NXCD, r = nwg % NXCD, xcd = wgid % NXCD, off = wgid / NXCD; wgid = (xcd < r ? xcd * (q + 1) : r * (q + 1) + (xcd - r) * q) + off; }
        const int nig = WGM * nN, gid = wgid / nig, fm = gid * WGM, gsz = (nM - fm) < WGM ? (nM - fm) : WGM;
        u.pm = fm + ((wgid % nig) % gsz); u.pn = (wgid % nig) / gsz; return true;
    }
    __device__ __forceinline__ void a_ready(const Unit&) const {}
    __device__ __forceinline__ void done(const Unit&) const {}
};

__device__ __forceinline__ unsigned cvt_pk_bf16(float lo, float hi) { unsigned r; asm volatile("v_cvt_pk_bf16_f32 %0, %1, %2" : "=v"(r) : "v"(lo), "v"(hi)); return r; }
typedef float f32x2 __attribute__((ext_vector_type(2)));
template <class Epi, class Sched, bool ALIGN_EPI = false, bool SP2 = false>
__device__ __forceinline__ void gemm_phase(PG8_LAS unsigned char* lds, const Gemm g, const Sched& S, const Epi& E, const int wave_id) {
    int wid_ = wave_id; asm volatile("" : "+s"(wid_)); const int lane = lane_id_asm(), wid = wid_, tid = wid * 64 + lane, wr = wid >> 2, wc = wid & 3, fr = lane & 15, fq = lane >> 4;
    const int K = g.K, nt = K / BK;
    unsigned voffA[2], voffB[2];
#pragma unroll
    for (int i = 0; i < 2; ++i) { int R, C; stage_rc(tid * 16 + i * 8192, R, C); const int Rb = Epi::PERM ? ((R & ~31) + perm32(R & 31)) : R;
        voffA[i] = (unsigned)(R * K + C) * 2u; voffB[i] = (unsigned)(Rb * K + C) * 2u; }
    const size_t kstep = (size_t)(BK * 2);
    const size_t hstep = (size_t)HALF * K * 2;
    const size_t tstep = 2 * hstep;
    const unsigned ldsw = (unsigned)wid * 1024u;
    const int aoff = lds_byte(wr * 64 + fr, fq * 8), boff = lds_byte(wc * 32 + fr, fq * 8);
#define PG8_SA(b, h) (((b) * 2 + (h)) * HTB)
#define PG8_SB(b, h) ((4 + (b) * 2 + (h)) * HTB)
#define PG8_STAGE(bufoff, gbase, voff) do { _Pragma("unroll") for (int _i = 0; _i < 2; ++_i) \
        __builtin_amdgcn_global_load_lds((const unsigned*)((const char*)(gbase) + (voff)[_i]), (PG8_LAS unsigned*)(lds + (bufoff) + ldsw + _i * 8192), 16, 0, 0); } while (0)
#define PG8_LDA(dst, b, h) do { _Pragma("unroll") for (int m = 0; m < 4; ++m) _Pragma("unroll") for (int k = 0; k < 2; ++k) dst[m][k] = *(const PG8_LAS bf16x8*)(lds + PG8_SA(b, h) + aoff + m * 2048 + k * 1024); } while (0)
#define PG8_LDB(dst, b, h) do { _Pragma("unroll") for (int n = 0; n < 2; ++n) _Pragma("unroll") for (int k = 0; k < 2; ++k) dst[n][k] = *(const PG8_LAS bf16x8*)(lds + PG8_SB(b, h) + boff + n * 2048 + k * 1024); } while (0)
#define PG8_MMA(ai, bj, At, Bt) do { __builtin_amdgcn_s_setprio(1); _Pragma("unroll") for (int m = 0; m < 4; ++m) _Pragma("unroll") for (int n = 0; n < 2; ++n) _Pragma("unroll") for (int k = 0; k < 2; ++k) \
        acc[ai][bj][m][n] = __builtin_amdgcn_mfma_f32_16x16x32_bf16(Bt[n][k], At[m][k], acc[ai][bj][m][n], 0, 0, 0); __builtin_amdgcn_s_setprio(0); } while (0)
#define PG8_WAIT_V(n) asm volatile("s_waitcnt vmcnt(" #n ")" ::: "memory")
#define PG8_WAIT_L(n) asm volatile("s_waitcnt lgkmcnt(" #n ")" ::: "memory")
#define PG8_BAR __builtin_amdgcn_s_barrier()
#define PG8_SCHED __builtin_amdgcn_sched_barrier(0)
    Unit cur, nxt; int ui = 0;
    if (!S.next(0, cur)) return;
    f32x4 acc[2][2][4][2];
#pragma unroll
    for (int a = 0; a < 2; ++a)
#pragma unroll
        for (int b = 0; b < 2; ++b)
#pragma unroll
            for (int m = 0; m < 4; ++m)
#pragma unroll
                for (int n = 0; n < 2; ++n) acc[a][b][m][n] = (f32x4){0.f, 0.f, 0.f, 0.f};
    bf16x8 At[4][2], B0[2][2], B1[2][2];
    const char* cA = (const char*)g.A + (size_t)cur.pm * tstep; const char* cB = (const char*)g.Bt + (size_t)cur.pn * tstep;
    S.a_ready(cur);
    if constexpr (SP2) {
        PG8_STAGE(PG8_SB(0, 0), cB, voffB); PG8_STAGE(PG8_SB(0, 1), cB + hstep, voffB); PG8_STAGE(PG8_SA(0, 0), cA, voffA); PG8_STAGE(PG8_SA(0, 1), cA + hstep, voffA);
        if (wr == 1) PG8_BAR;
        PG8_WAIT_V(2); PG8_BAR;
        PG8_STAGE(PG8_SB(1, 0), cB + kstep, voffB); PG8_STAGE(PG8_SA(1, 0), cA + kstep, voffA); PG8_STAGE(PG8_SB(1, 1), cB + hstep + kstep, voffB);
        PG8_WAIT_V(6); PG8_BAR;
    } else {
        PG8_STAGE(PG8_SB(0, 0), cB, voffB); PG8_STAGE(PG8_SA(0, 0), cA, voffA); PG8_STAGE(PG8_SB(0, 1), cB + hstep, voffB); PG8_STAGE(PG8_SA(0, 1), cA + hstep, voffA);
        if (wr == 1) PG8_BAR;
        PG8_WAIT_V(4); PG8_BAR;
        PG8_STAGE(PG8_SB(1, 0), cB + kstep, voffB); PG8_STAGE(PG8_SA(1, 0), cA + kstep, voffA); PG8_STAGE(PG8_SB(1, 1), cB + hstep + kstep, voffB);
        PG8_WAIT_V(6); PG8_BAR;
    }
    for (;;) {
        const bool has_next = S.next(ui + 1, nxt);
        const char* nA = has_next ? (const char*)g.A + (size_t)nxt.pm * tstep : cA; const char* nB = has_next ? (const char*)g.Bt + (size_t)nxt.pn * tstep : cB;
        for (int t = 0; t < nt; t += 2) {
            if (t == 2) E.prefetch(cur, wid, lane);
            const bool last = (t == nt - 2);
            const char* a1 = cA + (size_t)(t + 1) * kstep;
            const char* a2 = last ? nA : cA + (size_t)(t + 2) * kstep; const char* b2 = last ? nB : cB + (size_t)(t + 2) * kstep;
            const char* a3 = a2 + kstep; const char* b3 = b2 + kstep;
            if (last && has_next) S.a_ready(nxt);
            if constexpr (SP2) {
            PG8_LDB(B0, 0, 0); PG8_LDB(B1, 0, 1); PG8_SCHED; PG8_LDA(At, 0, 0); PG8_STAGE(PG8_SA(1, 1), a1 + hstep, voffA);
            PG8_WAIT_V(8); PG8_WAIT_L(0); PG8_BAR; PG8_MMA(0, 0, At, B0); PG8_MMA(0, 1, At, B1); PG8_BAR; PG8_SCHED;
            PG8_LDA(At, 0, 1); PG8_STAGE(PG8_SB(0, 0), b2, voffB); PG8_STAGE(PG8_SB(0, 1), b2 + hstep, voffB); PG8_STAGE(PG8_SA(0, 0), a2, voffA);
            PG8_WAIT_V(8); PG8_WAIT_L(0); PG8_BAR; PG8_MMA(1, 0, At, B0); PG8_MMA(1, 1, At, B1); PG8_BAR; PG8_SCHED;
            PG8_LDB(B0, 1, 0); PG8_LDB(B1, 1, 1); PG8_SCHED; PG8_LDA(At, 1, 0); PG8_STAGE(PG8_SA(0, 1), a2 + hstep, voffA);
            PG8_WAIT_V(8); PG8_WAIT_L(0); PG8_BAR; PG8_MMA(0, 0, At, B0); PG8_MMA(0, 1, At, B1); PG8_BAR; PG8_SCHED;
            PG8_LDA(At, 1, 1); PG8_STAGE(PG8_SB(1, 0), b3, voffB); PG8_STAGE(PG8_SB(1, 1), b3 + hstep, voffB); PG8_STAGE(PG8_SA(1, 0), a3, voffA);
            PG8_WAIT_V(8); PG8_WAIT_L(0); PG8_BAR; PG8_MMA(1, 0, At, B0); PG8_MMA(1, 1, At, B1); PG8_BAR; PG8_SCHED;
            } else {
            PG8_LDB(B0, 0, 0); PG8_SCHED; PG8_LDA(At, 0, 0); PG8_STAGE(PG8_SA(1, 1), a1 + hstep, voffA);
            PG8_WAIT_L(8); PG8_BAR; PG8_WAIT_L(0); PG8_MMA(0, 0, At, B0); PG8_BAR; PG8_SCHED;
            PG8_LDB(B1, 0, 1); PG8_STAGE(PG8_SB(0, 0), b2, voffB);
            PG8_BAR; PG8_WAIT_L(0); PG8_MMA(0, 1, At, B1); PG8_BAR;
            PG8_LDA(At, 0, 1); PG8_STAGE(PG8_SA(0, 0), a2, voffA);
            PG8_BAR; PG8_WAIT_L(0); PG8_MMA(1, 0, At, B0); PG8_BAR; PG8_SCHED;
            PG8_STAGE(PG8_SB(0, 1), b2 + hstep, voffB);
            PG8_WAIT_V(6); PG8_BAR; PG8_MMA(1, 1, At, B1); PG8_BAR;
            PG8_LDB(B0, 1, 0); PG8_SCHED; PG8_LDA(At, 1, 0); PG8_STAGE(PG8_SA(0, 1), a2 + hstep, voffA);
            PG8_WAIT_L(8); PG8_BAR; PG8_WAIT_L(0); PG8_MMA(0, 0, At, B0); PG8_BAR; PG8_SCHED;
            PG8_LDB(B1, 1, 1); PG8_STAGE(PG8_SB(1, 0), b3, voffB);
            PG8_BAR; PG8_WAIT_L(0); PG8_MMA(0, 1, At, B1); PG8_BAR;
            PG8_LDA(At, 1, 1); PG8_STAGE(PG8_SA(1, 0), a3, voffA);
            PG8_BAR; PG8_WAIT_L(0); PG8_MMA(1, 0, At, B0); PG8_BAR; PG8_SCHED;
            PG8_STAGE(PG8_SB(1, 1), b3 + hstep, voffB);
            PG8_WAIT_V(6); PG8_BAR; PG8_MMA(1, 1, At, B1); PG8_BAR;
            }
        }
        if constexpr (ALIGN_EPI) { if (wr == 0) PG8_BAR; }
        if constexpr (!Epi::AFTER_DRAIN) { E(acc, cur, wr, wc, fr, fq); S.done(cur); }
        if (!has_next) break;
#pragma unroll
        for (int a = 0; a < 2; ++a)
#pragma unroll
            for (int b = 0; b < 2; ++b)
#pragma unroll
                for (int m = 0; m < 4; ++m)
#pragma unroll
                    for (int n = 0; n < 2; ++n) acc[a][b][m][n] = (f32x4){0.f, 0.f, 0.f, 0.f};
        cur = nxt; cA = nA; cB = nB; ++ui;
        if constexpr (ALIGN_EPI) { if (wr == 1) PG8_BAR; }
    }
    PG8_WAIT_V(0);
    if constexpr (!ALIGN_EPI) { if (wr == 0) PG8_BAR; }
    PG8_BAR;
    if constexpr (Epi::AFTER_DRAIN) { E.fused(acc, cur, wr, wc, fr, fq, lds, wid, lane); S.done(cur); }
#undef PG8_SA
#undef PG8_SB
#undef PG8_STAGE
#undef PG8_LDA
#undef PG8_LDB
#undef PG8_MMA
#undef PG8_WAIT_V
#undef PG8_WAIT_L
#undef PG8_BAR
#undef PG8_SCHED
}
}

#define LAS __attribute__((address_space(3)))
#define GAS __attribute__((address_space(1)))
typedef unsigned short bf16_t;
typedef float f32x4 __attribute__((ext_vector_type(4)));
typedef float f32x16 __attribute__((ext_vector_type(16)));
typedef short bf16x8 __attribute__((ext_vector_type(8)));
typedef short s16x4 __attribute__((ext_vector_type(4)));
typedef unsigned u32x4 __attribute__((ext_vector_type(4)));
typedef unsigned u32x2 __attribute__((ext_vector_type(2)));

constexpr int M_TOK = 32768, DM = 1024, FF = 2816, SEQ = 8192;
constexpr float EPS = 1e-6f;
constexpr float QSCALE = 0.10206207261596575f * 1.4426950408889634f;
constexpr int NTHREADS = 512, NWAVES = 8;
constexpr size_t MiB = 1u << 20;
constexpr size_t WS_SS = 0, WS_SSV = 2 * MiB, WS_SSQ = 4 * MiB, WS_SSKV = 4 * MiB + 512 * 1024, WS_SSPE = 5 * MiB;
constexpr size_t WS_COS = 6 * MiB, WS_SIN = 8 * MiB, WS_KR = 10 * MiB;
constexpr size_t WS_CTL = 14 * MiB, CTL_ZERO_BYTES = 16384;
constexpr size_t WS_XB = 16 * MiB;
constexpr size_t WS_WB = 80 * MiB;
constexpr size_t FFN_BYTES = 16 * MiB + 512 * 1024;
constexpr size_t W_CONV1 = WS_WB + 6 * FFN_BYTES;
constexpr size_t W_MLA_A = W_CONV1 + 8 * MiB, W_MLA_UQ = W_MLA_A + 1 * MiB, W_MLA_UKV = W_MLA_UQ + 1 * MiB, W_MLA_O = W_MLA_UKV + 1 * MiB;
constexpr size_t W_SG_IN = W_MLA_O + 2 * MiB, W_SG_OUT = W_SG_IN + 4 * MiB, W_SG_S = W_SG_OUT + 2 * MiB;
constexpr size_t WS_WL0 = 198 * MiB + 512 * 1024;
constexpr size_t W_CONV0 = WS_WL0 + 2 * FFN_BYTES;
static_assert(W_SG_S + 256 * 1024 <= WS_WL0, "weights map");
constexpr size_t WS_T = 240 * MiB;
static_assert(W_CONV0 + 8 * MiB <= WS_T, "weights map 2");
constexpr size_t T_H = WS_T;
constexpr size_t T_Z = WS_T, T_BG = WS_T + 64 * MiB, T_G = WS_T + 128 * MiB;
constexpr size_t T_Q = WS_T, T_K = WS_T + 96 * MiB, T_O = WS_T + 192 * MiB, T_AQ = T_O, T_AKV = T_O + 16 * MiB;
constexpr size_t T_LO = WS_T + 192 * MiB;
constexpr size_t WS_END = 512 * MiB;
static_assert(T_O + 64 * MiB <= WS_END && T_H + 176 * MiB <= WS_END, "temp map");
constexpr int RING_BYTES = 131072, EPI_OFF = RING_BYTES  , MISC_OFF = RING_BYTES + 16384, LDS_BYTES = 147456 + 256;

__device__ __forceinline__ size_t ffn_w_off(int f) { return f < 2 ? WS_WL0 + (size_t)f * FFN_BYTES : WS_WB + (size_t)(f - 2) * FFN_BYTES; }
__device__ __forceinline__ size_t conv_w_off(int ia) { return ia == 0 ? W_CONV0 : W_CONV1; }

__device__ __forceinline__ unsigned cvtpk(float lo, float hi) { return pg8::cvt_pk_bf16(lo, hi); }
__device__ __forceinline__ u32x4 pack8(f32x4 a, f32x4 b) { u32x4 w; w.x = cvtpk(a[0], a[1]); w.y = cvtpk(a[2], a[3]); w.z = cvtpk(b[0], b[1]); w.w = cvtpk(b[2], b[3]); return w; }
__device__ __forceinline__ float bf_lo(unsigned w) { return __uint_as_float(w << 16); }
__device__ __forceinline__ float bf_hi(unsigned w) { return __uint_as_float(w & 0xffff0000u); }
__device__ __forceinline__ float dot4(f32x4 a) { return (a[0] * a[0] + a[1] * a[1]) + (a[2] * a[2] + a[3] * a[3]); }
__device__ __forceinline__ float wave_sum(float v) {
#pragma unroll
    for (int o = 1; o < 64; o <<= 1) v += __shfl_xor(v, o);
    return v;
}
__device__ __forceinline__ float swap32(float x, bool hi) { auto rr = __builtin_amdgcn_permlane32_swap(__float_as_uint(x), __float_as_uint(x), false, false); return __uint_as_float(hi ? rr[0] : rr[1]); }
__device__ __forceinline__ float red_fq(float s) { s += __shfl_xor(s, 16); s += __shfl_xor(s, 32); return s; }
__device__ __forceinline__ float row_rs16(const GAS float* ss, int row, int fq) {
    const f32x4 p = *(const GAS f32x4*)(ss + (size_t)row * 16 + 4 * fq);
    const float s = red_fq((p[0] + p[1]) + (p[2] + p[3]));
    return rsqrtf(s * (1.0f / 1024.0f) + EPS);
}
__device__ __forceinline__ float silu_f(float x) { return x * __builtin_amdgcn_rcpf(1.0f + __expf(-x)); }
__device__ __forceinline__ float gelu_tanh_f(float x) { const float u2 = 1.5957691216057308f * (x + 0.044715f * x * x * x); return x * __builtin_amdgcn_rcpf(1.0f + __expf(-u2)); }
#define EPI_FENCE() do { asm volatile("" ::: "memory"); __builtin_amdgcn_sched_barrier(0); } while (0)
#define EPI_BAR() do { asm volatile("s_waitcnt lgkmcnt(0)" ::: "memory"); __builtin_amdgcn_s_barrier(); EPI_FENCE(); } while (0)

typedef const pg8::f32x4 (&AccRef)[2][2][4][2];

__device__ __forceinline__ void ss_prefetch(unsigned char* ws, LAS unsigned char* ldsE, int pm, int wid, int lane) {
    unsigned long long wi_ = (unsigned long long)ws; asm volatile("" : "+s"(wi_));
    (void)lane; const unsigned lo16 = (unsigned)pg8::lane_id_asm() * 16u;
    const unsigned char* srcu = (const unsigned char*)wi_ + WS_SS + (size_t)pm * 16384 + wid * 2048;
    const unsigned char* src = srcu + lo16;
    __builtin_amdgcn_global_load_lds((const unsigned*)src, (LAS unsigned*)(ldsE + wid * 2048), 16, 0, 0);
    __builtin_amdgcn_global_load_lds((const unsigned*)(src + 1024), (LAS unsigned*)(ldsE + wid * 2048 + 1024), 16, 0, 0);
}

struct EpiSwiglu {
    static constexpr bool PERM = true, AFTER_DRAIN = false;
    unsigned char* ws; LAS unsigned char* ldsE;
    __device__ __forceinline__ void prefetch(const pg8::Unit& u, int wid, int lane) const { ss_prefetch(ws, ldsE, u.pm, wid, lane); }
    __device__ __forceinline__ void operator()(AccRef acc, const pg8::Unit& u, int wr, int wc, int fr_in, int fq_in) const {
        const int lane_e = pg8::lane_id_asm(); const int fr = lane_e & 15, fq = lane_e >> 4; (void)fr_in; (void)fq_in;
        unsigned long long wi_ = (unsigned long long)ws; asm volatile("" : "+s"(wi_)); GAS unsigned char* w = (GAS unsigned char*)wi_;
        const GAS float* ss = (const GAS float*)(w + WS_SS); GAS bf16_t* H = (GAS bf16_t*)(w + T_H);
        const int rowb = u.pm * 256 + wr * 64 + fr, hcol = u.pn * 128 + wc * 32 + 8 * fq;
        float rs8[8];
        { f32x4 pp[8];
#pragma unroll
          for (int q = 0; q < 8; ++q) pp[q] = *(const LAS f32x4*)(ldsE + ((q >> 2) * 128 + wr * 64 + (q & 3) * 16 + fr) * 64 + fq * 16);
#pragma unroll
          for (int q = 0; q < 8; ++q) rs8[q] = rsqrtf(red_fq((pp[q][0] + pp[q][1]) + (pp[q][2] + pp[q][3])) * (1.0f / 1024.0f) + EPS); }
        EPI_FENCE();
#pragma unroll
        for (int ai = 0; ai < 2; ++ai)
#pragma unroll
            for (int m = 0; m < 4; ++m) {
                const int row = rowb + ai * 128 + m * 16; const float rs = rs8[ai * 4 + m];
                const float k1 = rs * -1.4426950408889634f, r2 = rs * rs; (void)r2;
                f32x4 h0, h1;
#pragma unroll
                for (int j = 0; j < 4; ++j) {
                    { const float a = acc[ai][0][m][0][j], b = acc[ai][1][m][0][j]; { const float x = a * rs; h0[j] = (x * __builtin_amdgcn_rcpf(1.0f + __builtin_amdgcn_exp2f(a * k1))) * (b * rs); } }
                    { const float a = acc[ai][0][m][1][j], b = acc[ai][1][m][1][j]; { const float x = a * rs; h1[j] = (x * __builtin_amdgcn_rcpf(1.0f + __builtin_amdgcn_exp2f(a * k1))) * (b * rs); } }
                }
                *(GAS u32x4*)(H + (size_t)row * FF + hcol) = pack8(h0, h1);
            }
    }
};

struct EpiResid {
    static constexpr bool PERM = true, AFTER_DRAIN = false;
    const float* xf32; float* outp; unsigned char* ws; float alpha; int flags;
    __device__ __forceinline__ void prefetch(const pg8::Unit&, int, int) const {}
    __device__ __forceinline__ void operator()(AccRef acc, const pg8::Unit& u, int wr, int wc, int fr_in, int fq_in) const {
        const int lane_e = pg8::lane_id_asm(); const int fr = lane_e & 15, fq = lane_e >> 4; (void)fr_in; (void)fq_in;
        unsigned long long wi_ = (unsigned long long)ws; asm volatile("" : "+s"(wi_)); GAS unsigned char* w = (GAS unsigned char*)wi_;
        GAS float* ss = (GAS float*)(w + WS_SS); GAS bf16_t* xb = (GAS bf16_t*)(w + WS_XB);
        const bf16_t* lo_in = (flags & 4) ? (const bf16_t*)((unsigned char*)w + T_LO) : (const bf16_t*)outp;
        bf16_t* lo_out = (flags & 8) ? (bf16_t*)((unsigned char*)w + T_LO) : (bf16_t*)outp;
        const bool first = flags & 1, final_ = flags & 2;
        const int rowb = u.pm * 256 + wr * 64 + fr, colb = u.pn * 256 + wc * 32 + 8 * fq;
#pragma unroll
        for (int ai = 0; ai < 2; ++ai) {
            f32x4 xv[4][2][2];
            if (first) {
#pragma unroll
                for (int m = 0; m < 4; ++m)
#pragma unroll
                    for (int bj = 0; bj < 2; ++bj) { const size_t off = (size_t)(rowb + ai * 128 + m * 16) * DM + colb + bj * 128; xv[m][bj][0] = *(const f32x4*)(xf32 + off); xv[m][bj][1] = *(const f32x4*)(xf32 + off + 4); }
            } else {
                u32x4 rh[4][2], rl[4][2];
#pragma unroll
                for (int m = 0; m < 4; ++m)
#pragma unroll
                    for (int bj = 0; bj < 2; ++bj) { const size_t off = (size_t)(rowb + ai * 128 + m * 16) * DM + colb + bj * 128; rh[m][bj] = *(const GAS u32x4*)(xb + off); rl[m][bj] = *(const u32x4*)(lo_in + off); }
#pragma unroll
                for (int m = 0; m < 4; ++m)
#pragma unroll
                    for (int bj = 0; bj < 2; ++bj) { const u32x4 h = rh[m][bj], l = rl[m][bj];
                        xv[m][bj][0] = (f32x4){bf_lo(h.x) + bf_lo(l.x), bf_hi(h.x) + bf_hi(l.x), bf_lo(h.y) + bf_lo(l.y), bf_hi(h.y) + bf_hi(l.y)};
                        xv[m][bj][1] = (f32x4){bf_lo(h.z) + bf_lo(l.z), bf_hi(h.z) + bf_hi(l.z), bf_lo(h.w) + bf_lo(l.w), bf_hi(h.w) + bf_hi(l.w)}; }
            }
#pragma unroll
            for (int m = 0; m < 4; ++m) {
                const int row = rowb + ai * 128 + m * 16; float sq = 0.f;
#pragma unroll
                for (int bj = 0; bj < 2; ++bj) {
                    const size_t off = (size_t)row * DM + colb + bj * 128;
                    const f32x4 y0 = xv[m][bj][0] + acc[ai][bj][m][0] * alpha, y1 = xv[m][bj][1] + acc[ai][bj][m][1] * alpha;
                    if (final_) { *(f32x4*)(outp + off) = y0; *(f32x4*)(outp + off + 4) = y1; }
                    else {
                        const u32x4 h = pack8(y0, y1);
                        const f32x4 d0 = {y0[0] - bf_lo(h.x), y0[1] - bf_hi(h.x), y0[2] - bf_lo(h.y), y0[3] - bf_hi(h.y)}, d1 = {y1[0] - bf_lo(h.z), y1[1] - bf_hi(h.z), y1[2] - bf_lo(h.w), y1[3] - bf_hi(h.w)};
                        *(GAS u32x4*)(xb + off) = h; *(u32x4*)(lo_out + off) = pack8(d0, d1);
                        sq += dot4(y0) + dot4(y1);
                    }
                }
                if (!final_) { sq = red_fq(sq); if (fq == 0) ss[(size_t)row * 16 + u.pn * 4 + wc] = sq; }
            }
            EPI_FENCE();
        }
    }
};

struct EpiConvIn {
    static constexpr bool PERM = true, AFTER_DRAIN = false;
    unsigned char* ws; LAS unsigned char* ldsE;
    __device__ __forceinline__ void prefetch(const pg8::Unit& u, int wid, int lane) const { ss_prefetch(ws, ldsE, u.pm, wid, lane); }
    __device__ __forceinline__ void operator()(AccRef acc, const pg8::Unit& u, int wr, int wc, int fr_in, int fq_in) const {
        const int lane_e = pg8::lane_id_asm(); const int fr = lane_e & 15, fq = lane_e >> 4; (void)fr_in; (void)fq_in;
        unsigned long long wi_ = (unsigned long long)ws; asm volatile("" : "+s"(wi_)); GAS unsigned char* w = (GAS unsigned char*)wi_;
        const GAS float* ss = (const GAS float*)(w + WS_SS); GAS bf16_t* Z = (GAS bf16_t*)(w + T_Z); GAS bf16_t* Bg = (GAS bf16_t*)(w + T_BG);
        const int rowb = u.pm * 256 + wr * 64 + fr;
        float rs8[8];
        { f32x4 pp[8];
#pragma unroll
          for (int q = 0; q < 8; ++q) pp[q] = *(const LAS f32x4*)(ldsE + ((q >> 2) * 128 + wr * 64 + (q & 3) * 16 + fr) * 64 + fq * 16);
#pragma unroll
          for (int q = 0; q < 8; ++q) rs8[q] = rsqrtf(red_fq((pp[q][0] + pp[q][1]) + (pp[q][2] + pp[q][3])) * (1.0f / 1024.0f) + EPS); }
        EPI_FENCE();
#pragma unroll
        for (int ai = 0; ai < 2; ++ai)
#pragma unroll
            for (int m = 0; m < 4; ++m) {
                const int row = rowb + ai * 128 + m * 16; const float rs = rs8[ai * 4 + m];
                if (u.pn < 8) {
                    const float r2 = rs * rs;
                    const f32x4 z0 = acc[ai][0][m][0] * acc[ai][1][m][0] * r2, z1 = acc[ai][0][m][1] * acc[ai][1][m][1] * r2;
                    *(GAS u32x4*)(Z + (size_t)row * DM + u.pn * 128 + wc * 32 + 8 * fq) = pack8(z0, z1);
                } else {
#pragma unroll
                    for (int bj = 0; bj < 2; ++bj)
                        *(GAS u32x4*)(Bg + (size_t)row * DM + (u.pn - 8) * 256 + bj * 128 + wc * 32 + 8 * fq) = pack8(acc[ai][bj][m][0] * rs, acc[ai][bj][m][1] * rs);
                }
            }
    }
};

struct EpiMlaA {
    static constexpr bool PERM = true, AFTER_DRAIN = false;
    unsigned char* ws; LAS unsigned char* ldsE;
    __device__ __forceinline__ void prefetch(const pg8::Unit& u, int wid, int lane) const { ss_prefetch(ws, ldsE, u.pm, wid, lane); }
    __device__ __forceinline__ void operator()(AccRef acc, const pg8::Unit& u, int wr, int wc, int fr_in, int fq_in) const {
        const int lane_e = pg8::lane_id_asm(); const int fr = lane_e & 15, fq = lane_e >> 4; (void)fr_in; (void)fq_in;
        unsigned long long wi_ = (unsigned long long)ws; asm volatile("" : "+s"(wi_)); GAS unsigned char* w = (GAS unsigned char*)wi_;
        const GAS float* ss = (const GAS float*)(w + WS_SS); GAS bf16_t* Aq = (GAS bf16_t*)(w + T_AQ); GAS bf16_t* Akv = (GAS bf16_t*)(w + T_AKV); GAS float* ssq = (GAS float*)(w + WS_SSQ); GAS float* sskv = (GAS float*)(w + WS_SSKV);
        GAS float* sspe = (GAS float*)(w + WS_SSPE); GAS float* kr = (GAS float*)(w + WS_KR); const GAS float* cosT = (const GAS float*)(w + WS_COS); const GAS float* sinT = (const GAS float*)(w + WS_SIN);
        const int rowb = u.pm * 256 + wr * 64 + fr;
        float rs8[8];
        { f32x4 pp[8];
#pragma unroll
          for (int q = 0; q < 8; ++q) pp[q] = *(const LAS f32x4*)(ldsE + ((q >> 2) * 128 + wr * 64 + (q & 3) * 16 + fr) * 64 + fq * 16);
#pragma unroll
          for (int q = 0; q < 8; ++q) rs8[q] = rsqrtf(red_fq((pp[q][0] + pp[q][1]) + (pp[q][2] + pp[q][3])) * (1.0f / 1024.0f) + EPS); }
        EPI_FENCE();
#pragma unroll
        for (int ai = 0; ai < 2; ++ai)
#pragma unroll
            for (int m = 0; m < 4; ++m) {
                const int row = rowb + ai * 128 + m * 16; const float rs = rs8[ai * 4 + m];
                const f32x4 a00 = acc[ai][0][m][0] * rs, a01 = acc[ai][0][m][1] * rs, a10 = acc[ai][1][m][0] * rs, a11 = acc[ai][1][m][1] * rs;
                GAS bf16_t* dst = (u.pn == 0 ? Aq : Akv) + (size_t)row * 256 + wc * 32 + 8 * fq;
                *(GAS u32x4*)(dst) = pack8(a00, a01); *(GAS u32x4*)(dst + 128) = pack8(a10, a11);
                if (u.pn == 0) {
                    const float sq = red_fq(dot4(a00) + dot4(a01) + dot4(a10) + dot4(a11));
                    if (fq == 0) ssq[(size_t)row * 4 + wc] = sq;
                } else {
                    const float sq = red_fq(dot4(a00) + dot4(a01));
                    if (fq == 0) sskv[(size_t)row * 4 + wc] = sq;
                    if (wc == 0) {
                        *(GAS f32x4*)(kr + (size_t)row * 32 + 8 * fq) = a10; *(GAS f32x4*)(kr + (size_t)row * 32 + 8 * fq + 4) = a11;
                    }
                }
                EPI_FENCE();
            }
    }
};

struct EpiQ {
    static constexpr bool PERM = true, AFTER_DRAIN = false;
    unsigned char* ws;
    __device__ __forceinline__ void prefetch(const pg8::Unit&, int, int) const {}
    __device__ __forceinline__ void operator()(AccRef acc, const pg8::Unit& u, int wr, int wc, int fr_in, int fq_in) const {
        const int lane_e = pg8::lane_id_asm(); const int fr = lane_e & 15, fq = lane_e >> 4; (void)fr_in; (void)fq_in;
        unsigned long long wi_ = (unsigned long long)ws; asm volatile("" : "+s"(wi_)); GAS unsigned char* w = (GAS unsigned char*)wi_;
        const GAS float* ssq = (const GAS float*)(w + WS_SSQ); GAS bf16_t* Q = (GAS bf16_t*)(w + T_Q);
        const int rowb = u.pm * 256 + wr * 64 + fr;
        if (wc < 3) {
            float rs8[8];
            { f32x4 pp[8];
#pragma unroll
              for (int q = 0; q < 8; ++q) pp[q] = *(const GAS f32x4*)(ssq + (size_t)(rowb + (q >> 2) * 128 + (q & 3) * 16) * 4);
#pragma unroll
              for (int q = 0; q < 8; ++q) rs8[q] = rsqrtf(((pp[q][0] + pp[q][1]) + (pp[q][2] + pp[q][3])) * (1.0f / 256.0f) + EPS); }
            EPI_FENCE();
#pragma unroll
            for (int ai = 0; ai < 2; ++ai)
#pragma unroll
                for (int m = 0; m < 4; ++m) {
                    const int row = rowb + ai * 128 + m * 16, b = row >> 13, s = row & 8191;
                    const float rq = rs8[ai * 4 + m];
#pragma unroll
                    for (int bj = 0; bj < 2; ++bj) {
                        const int head = u.pn * 2 + bj;
                        *(GAS u32x4*)(Q + (unsigned)(((b * 16 + head) * SEQ + s) * 96 + wc * 32 + 8 * fq)) = pack8(acc[ai][bj][m][0] * rq, acc[ai][bj][m][1] * rq);
                    }
                    EPI_FENCE();
                }
        }
    }
};

struct EpiKV {
    static constexpr bool PERM = true, AFTER_DRAIN = false;
    unsigned char* ws; float* outp;
    __device__ __forceinline__ void prefetch(const pg8::Unit&, int, int) const {}
    __device__ __forceinline__ void operator()(AccRef acc, const pg8::Unit& u, int wr, int wc, int fr_in, int fq_in) const {
        const int lane_e = pg8::lane_id_asm(); const int fr = lane_e & 15, fq = lane_e >> 4; (void)fr_in; (void)fq_in;
        unsigned long long wi_ = (unsigned long long)ws; asm volatile("" : "+s"(wi_)); GAS unsigned char* w = (GAS unsigned char*)wi_;
        const GAS float* sskv = (const GAS float*)(w + WS_SSKV); GAS bf16_t* K = (GAS bf16_t*)(w + T_K); GAS bf16_t* Vt = (GAS bf16_t*)((GAS unsigned char*)(unsigned long long)outp + 64 * MiB);
        const int rowb = u.pm * 256 + wr * 64 + fr;
#pragma unroll
        for (int ai = 0; ai < 2; ++ai)
#pragma unroll
            for (int m = 0; m < 4; ++m) {
                const int row = rowb + ai * 128 + m * 16, b = row >> 13, s = row & 8191;
                const f32x4 pk = *(const GAS f32x4*)(sskv + (size_t)row * 4);
                const float r = rsqrtf(((pk[0] + pk[1]) + (pk[2] + pk[3])) * (1.0f / 128.0f) + EPS);
#pragma unroll
                for (int bj = 0; bj < 2; ++bj) {
                    const int head = u.pn * 2 + bj; const unsigned bh = (unsigned)(b * 16 + head);
                    const u32x4 wv = pack8(acc[ai][bj][m][0] * r, acc[ai][bj][m][1] * r);
                    if (wc < 2) {
                        *(GAS u32x4*)(K + ((bh * SEQ + s) * 96u + wc * 32 + 8 * fq)) = wv;
                    } else {
                        GAS bf16_t* vp = Vt + (bh * 64 + (wc - 2) * 32 + 8 * fq) * SEQ + s;
                        vp[0 * SEQ] = (bf16_t)(wv.x & 0xffff); vp[1 * SEQ] = (bf16_t)(wv.x >> 16); vp[2 * SEQ] = (bf16_t)(wv.y & 0xffff); vp[3 * SEQ] = (bf16_t)(wv.y >> 16);
                        vp[4 * SEQ] = (bf16_t)(wv.z & 0xffff); vp[5 * SEQ] = (bf16_t)(wv.z >> 16); vp[6 * SEQ] = (bf16_t)(wv.w & 0xffff); vp[7 * SEQ] = (bf16_t)(wv.w >> 16);
                    }
                }
                EPI_FENCE();
            }
    }
};

struct EpiSgIn {
    static constexpr bool PERM = true, AFTER_DRAIN = false;
    unsigned char* ws; LAS unsigned char* ldsE;
    __device__ __forceinline__ void prefetch(const pg8::Unit& u, int wid, int lane) const { ss_prefetch(ws, ldsE, u.pm, wid, lane); }
    __device__ __forceinline__ void operator()(AccRef acc, const pg8::Unit& u, int wr, int wc, int fr_in, int fq_in) const {
        const int lane_e = pg8::lane_id_asm(); const int fr = lane_e & 15, fq = lane_e >> 4; (void)fr_in; (void)fq_in;
        unsigned long long wi_ = (unsigned long long)ws; asm volatile("" : "+s"(wi_)); GAS unsigned char* w = (GAS unsigned char*)wi_;
        const GAS float* ss = (const GAS float*)(w + WS_SS); GAS bf16_t* U = (GAS bf16_t*)(w + T_Z); GAS bf16_t* V = (GAS bf16_t*)(w + T_BG); GAS float* ssv = (GAS float*)(w + WS_SSV);
        const int rowb = u.pm * 256 + wr * 64 + fr;
        GAS bf16_t* dstb = (u.pn < 4 ? U + u.pn * 256 : V + (u.pn - 4) * 256) + wc * 32 + 8 * fq;
        float rs8[8];
        { f32x4 pp[8];
#pragma unroll
          for (int q = 0; q < 8; ++q) pp[q] = *(const LAS f32x4*)(ldsE + ((q >> 2) * 128 + wr * 64 + (q & 3) * 16 + fr) * 64 + fq * 16);
#pragma unroll
          for (int q = 0; q < 8; ++q) rs8[q] = rsqrtf(red_fq((pp[q][0] + pp[q][1]) + (pp[q][2] + pp[q][3])) * (1.0f / 1024.0f) + EPS); }
        EPI_FENCE();
#pragma unroll
        for (int ai = 0; ai < 2; ++ai)
#pragma unroll
            for (int m = 0; m < 4; ++m) {
                const int row = rowb + ai * 128 + m * 16; const float rs = rs8[ai * 4 + m]; float sq = 0.f;
#pragma unroll
                for (int bj = 0; bj < 2; ++bj) {
                    f32x4 z0, z1;
#pragma unroll
                    for (int j = 0; j < 4; ++j) { z0[j] = gelu_tanh_f(acc[ai][bj][m][0][j] * rs); z1[j] = gelu_tanh_f(acc[ai][bj][m][1][j] * rs); }
                    *(GAS u32x4*)(dstb + (size_t)row * DM + bj * 128) = pack8(z0, z1);
                    sq += dot4(z0) + dot4(z1);
                }
                if (u.pn >= 4) { sq = red_fq(sq); if (fq == 0) ssv[(size_t)row * 16 + (u.pn - 4) * 4 + wc] = sq; } EPI_FENCE();
            }
    }
};

__device__ __forceinline__ int map_row(int kind, int n0) {
    switch (kind) {
        case 1: return (n0 >> 7) * 256 + (n0 & 127);
        case 2: return (n0 >> 7) * 256 + 128 + (n0 & 127);
        case 3: if (n0 < 1024) return 2048 + n0;
                if (n0 < 2048) { const int c = n0 - 1024; return (c >> 7) * 256 + (c & 127); }
                { const int c = n0 - 2048; return (c >> 7) * 256 + 128 + (c & 127); }
        case 4: return (n0 / 96) * 128 + (n0 % 96);
        default: return n0;
    }
}
__device__ __forceinline__ void tr_item(const float* __restrict__ W, int K, int N, bf16_t* __restrict__ WT, int pitch, const float* __restrict__ scale, int kind, LAS float* scr, int item, int lane) {
    const int nblk = N >> 5, kb = item / nblk, nb = item - kb * nblk, k0 = 64 * kb, n0 = 32 * nb, dr0 = map_row(kind, n0);
    {
        f32x4 v[8]; const int kr_ = lane >> 3, c4 = (lane & 7) * 4;
#pragma unroll
        for (int i = 0; i < 8; ++i) v[i] = *(const f32x4*)(W + (size_t)(k0 + 8 * i + kr_) * N + n0 + c4);
#pragma unroll
        for (int i = 0; i < 8; ++i) { const int kk = 8 * i + kr_; const float sc = scale ? scale[k0 + kk] : 1.0f;
            scr[kk * 33 + c4] = v[i][0] * sc; scr[kk * 33 + c4 + 1] = v[i][1] * sc; scr[kk * 33 + c4 + 2] = v[i][2] * sc; scr[kk * 33 + c4 + 3] = v[i][3] * sc; }
    }
    asm volatile("s_waitcnt lgkmcnt(0)" ::: "memory");
    const int c = lane & 7;
#pragma unroll
    for (int j = 0; j < 4; ++j) { const int n = (lane >> 3) + 8 * j; const LAS float* s = scr + (8 * c) * 33 + n;
        u32x4 o; o.x = cvtpk(s[0 * 33], s[1 * 33]); o.y = cvtpk(s[2 * 33], s[3 * 33]); o.z = cvtpk(s[4 * 33], s[5 * 33]); o.w = cvtpk(s[6 * 33], s[7 * 33]);
        *(u32x4*)(WT + (size_t)(dr0 + n) * pitch + k0 + 8 * c) = o; }
    asm volatile("s_waitcnt lgkmcnt(0)" ::: "memory");
}

struct Args {
    const float* in[22]; float* out; unsigned char* ws; float inv_freq[16]; int ph_lo, ph_hi;
};

__device__ __forceinline__ void prologue(const Args& a, LAS unsigned char* lds, int vcu, int G, int wave, int lane, int tid) {
    unsigned char* ws = a.ws;
    LAS float* scr = (LAS float*)(lds + wave * 16384);
    const int gw = vcu * NWAVES + wave, NGW = G * NWAVES;
    const float* norm_g = a.in[2];
    constexpr int I_FFN = 8 * 4224, I_CONV = 2 * 2048, I_MLA = 1040, I_SG = 1536, NITEMS = I_FFN + I_CONV + I_MLA + I_SG;
    for (int it = gw; it < NITEMS; it += NGW) {
        int r = it;
        if (r < I_FFN) {
            const int f = r / 4224, q = r % 4224, which = q / 1408, item = q % 1408, i = f >> 1, j = f & 1;
            bf16_t* wgu = (bf16_t*)(ws + ffn_w_off(f)); bf16_t* wd = wgu + (size_t)5632 * 1024;
            const float* g = norm_g + (size_t)(i * 3 + (j ? 2 : 0)) * 1024;
            if (which == 0) tr_item(a.in[3] + (size_t)f * 1024 * 2816, 1024, 2816, wgu, 1024, g, 1, scr, item, lane);
            else if (which == 1) tr_item(a.in[4] + (size_t)f * 1024 * 2816, 1024, 2816, wgu, 1024, g, 2, scr, item, lane);
            else tr_item(a.in[5] + (size_t)f * 2816 * 1024, 2816, 1024, wd, 2816, nullptr, 0, scr, item, lane);
            continue;
        }
        r -= I_FFN;
        if (r < I_CONV) {
            const int ia = r / 2048, q = r % 2048, li = ia == 0 ? 0 : 3;
            bf16_t* win = (bf16_t*)(ws + conv_w_off(ia)); bf16_t* wout = win + (size_t)3072 * 1024;
            if (q < 1536) tr_item(a.in[6] + (size_t)ia * 1024 * 3072, 1024, 3072, win, 1024, norm_g + (size_t)(li * 3 + 1) * 1024, 3, scr, q, lane);
            else tr_item(a.in[8] + (size_t)ia * 1024 * 1024, 1024, 1024, wout, 1024, nullptr, 0, scr, q - 1536, lane);
            continue;
        }
        r -= I_CONV;
        if (r < I_MLA) {
            if (r < 208) { tr_item(a.in[9], 1024, 416, (bf16_t*)(ws + W_MLA_A), 1024, norm_g + (size_t)(1 * 3 + 1) * 1024, 0, scr, r, lane); continue; }
            r -= 208;
            if (r < 192) { tr_item(a.in[11], 256, 1536, (bf16_t*)(ws + W_MLA_UQ), 256, a.in[10], 4, scr, r, lane); continue; }
            r -= 192;
            if (r < 128) { tr_item(a.in[13], 128, 2048, (bf16_t*)(ws + W_MLA_UKV), 256, a.in[12], 0, scr, r, lane); continue; }
            r -= 128;
            tr_item(a.in[16], 1024, 1024, (bf16_t*)(ws + W_MLA_O), 1024, nullptr, 0, scr, r, lane);
            continue;
        }
        r -= I_MLA;
        if (r < 1024) tr_item(a.in[17], 1024, 2048, (bf16_t*)(ws + W_SG_IN), 1024, norm_g + (size_t)(2 * 3 + 1) * 1024, 0, scr, r, lane);
        else tr_item(a.in[21], 1024, 1024, (bf16_t*)(ws + W_SG_OUT), 1024, nullptr, 0, scr, r - 1024, lane);
    }
    const int gt = vcu * NTHREADS + tid, NGT = G * NTHREADS;
    const u32x4 z4 = {0u, 0u, 0u, 0u};
    for (int p = gt; p < 12288; p += NGT) *(u32x4*)(ws + W_MLA_A + (size_t)416 * 2048 + (size_t)p * 16) = z4;
    for (int p = gt; p < 16384; p += NGT) { const int h = p >> 10, off = p & 1023; *(u32x4*)(ws + W_MLA_UQ + (size_t)(128 * h + 96) * 512 + (size_t)off * 16) = z4; }
    for (int p = gt; p < 32768; p += NGT) { const int row = p >> 4, c = p & 15; *(u32x4*)(ws + W_MLA_UKV + (size_t)row * 512 + 256 + c * 16) = z4; }
    for (int p = gt; p < 16384; p += NGT) {
        const int t = (p >> 4) & 127, s0 = (p & 15) * 8; const float* src = a.in[19] + (size_t)p * 8;
        const f32x4 w0 = *(const f32x4*)src, w1 = *(const f32x4*)(src + 4); f32x4 m0, m1;
#pragma unroll
        for (int j = 0; j < 4; ++j) { m0[j] = (s0 + j <= t) ? w0[j] : 0.f; m1[j] = (s0 + 4 + j <= t) ? w1[j] : 0.f; }
        *(u32x4*)(ws + W_SG_S + (size_t)p * 16) = pack8(m0, m1);
    }
    {
        const int* pos = (const int*)a.in[1]; float* cosT = (float*)(ws + WS_COS); float* sinT = (float*)(ws + WS_SIN);
        for (int p = gt; p < M_TOK * 16; p += NGT) {
            const int row = p >> 4, i = p & 15; const float ang = (float)pos[row] * a.inv_freq[i];
            const double ad = (double)ang, k = rint(ad * 0.15915494309189535); const float rr = (float)(ad - k * 6.283185307179586);
            cosT[p] = cosf(rr); sinT[p] = sinf(rr);
        }
    }
    {
        const float* x = a.in[0]; bf16_t* xb = (bf16_t*)(ws + WS_XB); float* ss = (float*)(ws + WS_SS);
        for (int row = gw; row < M_TOK; row += NGW) {
            const f32x4* xr = (const f32x4*)(x + (size_t)row * DM) + lane; f32x4 v[4]; float s = 0.f;
#pragma unroll
            for (int j = 0; j < 4; ++j) { v[j] = xr[64 * j]; s += dot4(v[j]); }
            s = wave_sum(s);
            u32x2* o = (u32x2*)(xb + (size_t)row * DM) + lane;
#pragma unroll
            for (int j = 0; j < 4; ++j) { u32x2 w; w.x = cvtpk(v[j][0], v[j][1]); w.y = cvtpk(v[j][2], v[j][3]); o[64 * j] = w; }
            if (lane < 16) ss[(size_t)row * 16 + lane] = lane == 0 ? s : 0.f;
        }
    }
}

__device__ __forceinline__ void unpack8(u32x4 w, float (&f)[8]) { f[0] = bf_lo(w.x); f[1] = bf_hi(w.x); f[2] = bf_lo(w.y); f[3] = bf_hi(w.y); f[4] = bf_lo(w.z); f[5] = bf_hi(w.z); f[6] = bf_lo(w.w); f[7] = bf_hi(w.w); }
__device__ __forceinline__ void conv_phase(const bf16_t* __restrict__ Z, const bf16_t* __restrict__ Bg, const float* __restrict__ ck, bf16_t* __restrict__ Gout, int gt, int NGT) {
    for (int it = gt; it < 2048 * 128; it += NGT) {
        const int cg8 = (it & 127) * 8, row0 = (it >> 7) * 16;
        float k0[8], k1[8], k2[8], zm2[8], zm1[8];
        { const f32x4 a0 = *(const f32x4*)(ck + cg8), a1 = *(const f32x4*)(ck + cg8 + 4), b0 = *(const f32x4*)(ck + 1024 + cg8), b1 = *(const f32x4*)(ck + 1024 + cg8 + 4), c0 = *(const f32x4*)(ck + 2048 + cg8), c1 = *(const f32x4*)(ck + 2048 + cg8 + 4);
#pragma unroll
          for (int j = 0; j < 4; ++j) { k0[j] = a0[j]; k0[4 + j] = a1[j]; k1[j] = b0[j]; k1[4 + j] = b1[j]; k2[j] = c0[j]; k2[4 + j] = c1[j]; } }
        if ((row0 & 8191) == 0) {
#pragma unroll
            for (int j = 0; j < 8; ++j) { zm2[j] = 0.f; zm1[j] = 0.f; }
        } else {
            unpack8(*(const u32x4*)(Z + (size_t)(row0 - 2) * DM + cg8), zm2); unpack8(*(const u32x4*)(Z + (size_t)(row0 - 1) * DM + cg8), zm1);
        }
#pragma unroll 4
        for (int r = 0; r < 16; ++r) {
            const size_t off = (size_t)(row0 + r) * DM + cg8; float z[8], b[8]; f32x4 o0, o1;
            unpack8(*(const u32x4*)(Z + off), z); unpack8(*(const u32x4*)(Bg + off), b);
#pragma unroll
            for (int j = 0; j < 4; ++j) { o0[j] = b[j] * (k0[j] * zm2[j] + k1[j] * zm1[j] + k2[j] * z[j]); o1[j] = b[4 + j] * (k0[4 + j] * zm2[4 + j] + k1[4 + j] * zm1[4 + j] + k2[4 + j] * z[4 + j]); }
            *(u32x4*)(Gout + off) = pack8(o0, o1);
#pragma unroll
            for (int j = 0; j < 8; ++j) { zm2[j] = zm1[j]; zm1[j] = z[j]; }
        }
    }
}

__device__ __forceinline__ void sg_phase(LAS unsigned char* lds, const bf16_t* __restrict__ U, const bf16_t* __restrict__ V, const float* __restrict__ ssv, const float* __restrict__ vnorm,
                                         const bf16_t* __restrict__ wsm, const float* __restrict__ bs, bf16_t* __restrict__ G2, int vcu, int G, const int wave_s) {
    constexpr int ROWB = 272, BOFF = 128 * ROWB;
    const int lane = pg8::lane_id_asm(), wid = wave_s, tid = wid * 64 + lane, fr = lane & 15, fq = lane >> 4;
    for (int u = vcu; u < 2048; u += G) {
        const int c = u >> 3, g = u & 7;
        for (int p = tid; p < 2048; p += NTHREADS) { const int t = p >> 4, cc = p & 15; *(LAS u32x4*)(lds + t * ROWB + cc * 16) = *(const u32x4*)(wsm + (size_t)g * 16384 + t * 128 + cc * 8); }
        for (int p = tid; p < 2048; p += NTHREADS) {
            const int s = p >> 4, cg8 = (p & 15) * 8, row = 128 * c + s;
            float v[8]; unpack8(*(const u32x4*)(V + (size_t)row * DM + 128 * g + cg8), v);
            const f32x4* sp = (const f32x4*)(ssv + (size_t)row * 16); const f32x4 a0 = sp[0], a1 = sp[1], a2 = sp[2], a3 = sp[3];
            const float tot = ((a0[0] + a0[1]) + (a0[2] + a0[3])) + ((a1[0] + a1[1]) + (a1[2] + a1[3])) + ((a2[0] + a2[1]) + (a2[2] + a2[3])) + ((a3[0] + a3[1]) + (a3[2] + a3[3]));
            const float rsv = rsqrtf(tot * (1.0f / 1024.0f) + EPS);
            const f32x4 n0 = *(const f32x4*)(vnorm + 128 * g + cg8), n1 = *(const f32x4*)(vnorm + 128 * g + cg8 + 4);
#pragma unroll
            for (int j = 0; j < 4; ++j) {
                const unsigned w = cvtpk(v[j] * rsv * n0[j], v[4 + j] * rsv * n1[j]);
                *(LAS bf16_t*)(lds + BOFF + (cg8 + j) * ROWB + s * 2) = (bf16_t)(w & 0xffff);
                *(LAS bf16_t*)(lds + BOFF + (cg8 + 4 + j) * ROWB + s * 2) = (bf16_t)(w >> 16);
            }
        }
        __syncthreads();
        f32x4 acc[8];
#pragma unroll
        for (int nb = 0; nb < 8; ++nb) acc[nb] = (f32x4){0.f, 0.f, 0.f, 0.f};
#pragma unroll
        for (int ks = 0; ks < 4; ++ks) {
            const bf16x8 wa = *(const LAS bf16x8*)(lds + (16 * wid + fr) * ROWB + (32 * ks + 8 * fq) * 2);
#pragma unroll
            for (int nb = 0; nb < 8; ++nb) {
                const bf16x8 vb = *(const LAS bf16x8*)(lds + BOFF + (16 * nb + fr) * ROWB + (32 * ks + 8 * fq) * 2);
                acc[nb] = __builtin_amdgcn_mfma_f32_16x16x32_bf16(vb, wa, acc[nb], 0, 0, 0);
            }
        }
        {
            const int t = 16 * wid + fr, row = 128 * c + t; const float bias = bs[g * 128 + t];
#pragma unroll
            for (int nb = 0; nb < 8; ++nb) {
                const size_t off = (size_t)row * DM + 128 * g + 16 * nb + 4 * fq;
                const u32x2 uu = *(const u32x2*)(U + off);
                u32x2 o; o.x = cvtpk(bf_lo(uu.x) * (acc[nb][0] + bias), bf_hi(uu.x) * (acc[nb][1] + bias)); o.y = cvtpk(bf_lo(uu.y) * (acc[nb][2] + bias), bf_hi(uu.y) * (acc[nb][3] + bias));
                *(u32x2*)(G2 + off) = o;
            }
        }
        __syncthreads();
    }
}

__device__ __forceinline__ void qk_finalize(bf16_t* __restrict__ Q, bf16_t* __restrict__ K, const float* __restrict__ kpe, const float* __restrict__ qgain, const float* __restrict__ kgain,
                                            const float* __restrict__ cosT, const float* __restrict__ sinT, int gt, int NGT) {
    for (int it = 16 * M_TOK + gt; it < 2 * 16 * M_TOK; it += NGT) {
        const bool isk = it >= 16 * M_TOK; const int rh = isk ? it - 16 * M_TOK : it;
        const int bh = rh >> 13, s = rh & 8191, row = (bh >> 4) * SEQ + s;
        bf16_t* p = (isk ? K : Q) + (size_t)rh * 96; const float* gain = isk ? kgain : qgain;
        float v[96];
        if (!isk) {
#pragma unroll
            for (int c = 0; c < 12; ++c) { const u32x4 w = *(const u32x4*)(p + 8 * c); v[8 * c] = bf_lo(w.x); v[8 * c + 1] = bf_hi(w.x); v[8 * c + 2] = bf_lo(w.y); v[8 * c + 3] = bf_hi(w.y); v[8 * c + 4] = bf_lo(w.z); v[8 * c + 5] = bf_hi(w.z); v[8 * c + 6] = bf_lo(w.w); v[8 * c + 7] = bf_hi(w.w); }
        } else {
#pragma unroll
            for (int c = 0; c < 8; ++c) { const u32x4 w = *(const u32x4*)(p + 8 * c); v[8 * c] = bf_lo(w.x); v[8 * c + 1] = bf_hi(w.x); v[8 * c + 2] = bf_lo(w.y); v[8 * c + 3] = bf_hi(w.y); v[8 * c + 4] = bf_lo(w.z); v[8 * c + 5] = bf_hi(w.z); v[8 * c + 6] = bf_lo(w.w); v[8 * c + 7] = bf_hi(w.w); }
#pragma unroll
            for (int c = 0; c < 8; ++c) { const f32x4 w = *(const f32x4*)(kpe + (size_t)row * 32 + 4 * c); v[64 + 4 * c] = w[0]; v[64 + 4 * c + 1] = w[1]; v[64 + 4 * c + 2] = w[2]; v[64 + 4 * c + 3] = w[3]; }
        }
        float ss = 0.f;
#pragma unroll
        for (int d = 0; d < 96; ++d) ss += v[d] * v[d];
        const float rsh = rsqrtf(ss * (1.0f / 96.0f) + EPS), osc = isk ? 1.0f : QSCALE;
#pragma unroll
        for (int d = 0; d < 96; ++d) v[d] *= rsh * gain[d];
#pragma unroll
        for (int c = 0; c < 4; ++c) {
            const f32x4 cs = *(const f32x4*)(cosT + (size_t)row * 16 + 4 * c), sn = *(const f32x4*)(sinT + (size_t)row * 16 + 4 * c);
#pragma unroll
            for (int j = 0; j < 4; ++j) { const int i = 4 * c + j; const float t1 = v[64 + i], t2 = v[80 + i]; v[64 + i] = t1 * cs[j] - t2 * sn[j]; v[80 + i] = t2 * cs[j] + t1 * sn[j]; }
        }
#pragma unroll
        for (int c = 0; c < 12; ++c) {
            u32x4 w; w.x = cvtpk(v[8 * c] * osc, v[8 * c + 1] * osc); w.y = cvtpk(v[8 * c + 2] * osc, v[8 * c + 3] * osc); w.z = cvtpk(v[8 * c + 4] * osc, v[8 * c + 5] * osc); w.w = cvtpk(v[8 * c + 6] * osc, v[8 * c + 7] * osc);
            *(u32x4*)(p + 8 * c) = w;
        }
    }
}

__device__ __forceinline__ float max3f_(float a, float b, float c) { return __builtin_fmaxf(__builtin_fmaxf(a, b), c); }
struct AttRegs { u32x4 k0, k1, v; };
#define ATT_BAR() asm volatile("s_waitcnt lgkmcnt(0)\n\ts_barrier" ::: "memory")
__device__ __forceinline__ void att_qk(const LAS unsigned char* kb, const bf16x8 (&qf)[6], f32x16& p0, f32x16& p1) {
    constexpr int KROW = 208;
    bf16x8 kf[12];
#pragma unroll
    for (int ds = 0; ds < 6; ++ds) { kf[2 * ds] = *(const LAS bf16x8*)(kb + ds * 32); kf[2 * ds + 1] = *(const LAS bf16x8*)(kb + 32 * KROW + ds * 32); }
#pragma unroll
    for (int r = 0; r < 16; ++r) { p0[r] = 0.f; p1[r] = 0.f; }
    __builtin_amdgcn_sched_barrier(0);
#pragma unroll
    for (int ds = 0; ds < 6; ++ds) {
        p0 = __builtin_amdgcn_mfma_f32_32x32x16_bf16(kf[2 * ds], qf[ds], p0, 0, 0, 0);
        p1 = __builtin_amdgcn_mfma_f32_32x32x16_bf16(kf[2 * ds + 1], qf[ds], p1, 0, 0, 0);
    }
    __builtin_amdgcn_sched_barrier(0);
}
template <bool NOMAX> __device__ __forceinline__ void att_soft_pv(const LAS unsigned char* vb, f32x16& p0, f32x16& p1, f32x16& o0, f32x16& o1, float& m_ref, float& l_run, int t, int qw0, int qabs, int hi) {
    constexpr int VROW = 136; constexpr float THR = 8.0f;
    s16x4 va[8], vb2[8];
#pragma unroll
    for (int ks = 0; ks < 4; ++ks) {
        va[2 * ks] = *(const LAS s16x4*)(vb + ks * 32); vb2[2 * ks] = *(const LAS s16x4*)(vb + ks * 32 + 16);
        va[2 * ks + 1] = *(const LAS s16x4*)(vb + 32 * VROW + ks * 32); vb2[2 * ks + 1] = *(const LAS s16x4*)(vb + 32 * VROW + ks * 32 + 16);
    }
    __builtin_amdgcn_sched_barrier(0);
    if (64 * t + 63 > qw0) {
        asm volatile("" ::: "memory");
#pragma unroll
        for (int r = 0; r < 16; ++r) { const int kv = 64 * t + (r & 3) + 8 * (r >> 2) + 4 * hi; if (kv > qabs) p0[r] = -INFINITY; if (kv + 32 > qabs) p1[r] = -INFINITY; }
    }
    if constexpr (!NOMAX) {
        float ma = max3f_(p0[0], p0[1], p1[0]), mb = max3f_(p0[2], p0[3], p1[1]); ma = max3f_(ma, p1[2], p1[3]);
#pragma unroll
        for (int r = 4; r < 16; r += 4) { ma = max3f_(ma, p0[r], p0[r + 1]); mb = max3f_(mb, p0[r + 2], p0[r + 3]); ma = max3f_(ma, p1[r], p1[r + 1]); mb = max3f_(mb, p1[r + 2], p1[r + 3]); }
        float mx = __builtin_fmaxf(ma, mb);
        { auto rr = __builtin_amdgcn_permlane32_swap(__float_as_uint(mx), __float_as_uint(mx), false, false); mx = __builtin_fmaxf(__uint_as_float(rr[0]), __uint_as_float(rr[1])); }
        if (__any(mx > m_ref + THR)) {
            const float mnew = __builtin_fmaxf(m_ref, mx), alpha = __builtin_amdgcn_exp2f(m_ref - mnew); m_ref = mnew; l_run *= alpha;
            o0 = o0 * alpha; o1 = o1 * alpha;
        }
        { const float negm = -m_ref; p0 = p0 + negm; p1 = p1 + negm; }
    }
#pragma unroll
    for (int r = 0; r < 16; ++r) { p0[r] = __builtin_amdgcn_exp2f(p0[r]); p1[r] = __builtin_amdgcn_exp2f(p1[r]); }
    { const f32x16 sv = p0 + p1; l_run += ((sv[0] + sv[1]) + (sv[2] + sv[3])) + ((sv[4] + sv[5]) + (sv[6] + sv[7])) + ((sv[8] + sv[9]) + (sv[10] + sv[11])) + ((sv[12] + sv[13]) + (sv[14] + sv[15])); }
    u32x4 pb[4];
    pb[0] = (u32x4){cvtpk(p0[0], p0[1]), cvtpk(p0[2], p0[3]), cvtpk(p0[4], p0[5]), cvtpk(p0[6], p0[7])};
    pb[1] = (u32x4){cvtpk(p0[8], p0[9]), cvtpk(p0[10], p0[11]), cvtpk(p0[12], p0[13]), cvtpk(p0[14], p0[15])};
    pb[2] = (u32x4){cvtpk(p1[0], p1[1]), cvtpk(p1[2], p1[3]), cvtpk(p1[4], p1[5]), cvtpk(p1[6], p1[7])};
    pb[3] = (u32x4){cvtpk(p1[8], p1[9]), cvtpk(p1[10], p1[11]), cvtpk(p1[12], p1[13]), cvtpk(p1[14], p1[15])};
    __builtin_amdgcn_sched_barrier(0);
#pragma unroll
    for (int ks = 0; ks < 4; ++ks) {
        const bf16x8 pf = __builtin_bit_cast(bf16x8, pb[ks]);
        { const s16x4 a = va[2 * ks], b = vb2[2 * ks];
          const bf16x8 vf = {a[0], a[1], a[2], a[3], b[0], b[1], b[2], b[3]};
          o0 = __builtin_amdgcn_mfma_f32_32x32x16_bf16(vf, pf, o0, 0, 0, 0); }
        { const s16x4 a = va[2 * ks + 1], b = vb2[2 * ks + 1];
          const bf16x8 vf = {a[0], a[1], a[2], a[3], b[0], b[1], b[2], b[3]};
          o1 = __builtin_amdgcn_mfma_f32_32x32x16_bf16(vf, pf, o1, 0, 0, 0); }
    }
}
struct AttK { u32x4 k0, k1; };
template <bool NOMAX> __device__ __forceinline__ void attn_units(LAS unsigned char* lds, const bf16_t* __restrict__ Q, const bf16_t* __restrict__ K, const bf16_t* __restrict__ Vt, bf16_t* __restrict__ O, const float* __restrict__ qgain, const float* __restrict__ cosT, const float* __restrict__ sinT, int vcu, int G, const int wave_s) {
    constexpr int KROW = 208, VROW = 136, KBUF = 64 * KROW, VBUF = 64 * VROW, VOFF = 2 * KBUF;
    const int lane = pg8::lane_id_asm(), wid = wave_s, tid = wid * 64 + lane, r32 = lane & 31, hi = lane >> 5;
    const int kp0r = tid / 12, kp0c = tid % 12, kp1r = (512 + tid) / 12, kp1c = (512 + tid) % 12, vdv = tid >> 3, vc = tid & 7;
    for (int u = vcu; u < 2048; u += G) {
        const int v = u & 255, i = u >> 8, bh = v >> 2, s4 = v & 3, pr = i >> 1, qb = (i & 1) ? 8 * pr + 7 - s4 : 8 * pr + s4;
        const int q0 = qb * 256, NT = (q0 + 256) / 64, qw0 = q0 + 32 * wid, qabs = qw0 + r32;
        const bf16_t* Qp = Q + ((size_t)bh * SEQ + qabs) * 96 + 8 * hi;
        bf16x8 qf[6];
#pragma unroll
        for (int ds = 0; ds < 6; ++ds) qf[ds] = *(const bf16x8*)(Qp + 16 * ds);
        {
            float ssq_ = 0.f;
#pragma unroll
            for (int ds = 0; ds < 6; ++ds) { const u32x4 w = __builtin_bit_cast(u32x4, qf[ds]);
                const float a0 = bf_lo(w.x), a1 = bf_hi(w.x), a2 = bf_lo(w.y), a3 = bf_hi(w.y), a4 = bf_lo(w.z), a5 = bf_hi(w.z), a6 = bf_lo(w.w), a7 = bf_hi(w.w);
                ssq_ += ((a0 * a0 + a1 * a1) + (a2 * a2 + a3 * a3)) + ((a4 * a4 + a5 * a5) + (a6 * a6 + a7 * a7)); }
            { auto rr = __builtin_amdgcn_permlane32_swap(__float_as_uint(ssq_), __float_as_uint(ssq_), false, false); ssq_ = __uint_as_float(rr[0]) + __uint_as_float(rr[1]); }
            float rq = rsqrtf(ssq_ * (1.0f / 96.0f) + EPS) * QSCALE; asm volatile("" : "+v"(rq));
#pragma unroll
            for (int ds = 0; ds < 6; ++ds) asm volatile("" : "+v"(qf[ds]));
#pragma unroll
            for (int ds = 0; ds < 4; ++ds) {
                const u32x4 w = __builtin_bit_cast(u32x4, qf[ds]);
                const f32x4 g0 = *(const f32x4*)(qgain + 16 * ds + 8 * hi), g1 = *(const f32x4*)(qgain + 16 * ds + 8 * hi + 4);
                u32x4 o; o.x = cvtpk(bf_lo(w.x) * g0[0] * rq, bf_hi(w.x) * g0[1] * rq); o.y = cvtpk(bf_lo(w.y) * g0[2] * rq, bf_hi(w.y) * g0[3] * rq);
                o.z = cvtpk(bf_lo(w.z) * g1[0] * rq, bf_hi(w.z) * g1[1] * rq); o.w = cvtpk(bf_lo(w.w) * g1[2] * rq, bf_hi(w.w) * g1[3] * rq);
                qf[ds] = __builtin_bit_cast(bf16x8, o);
                asm volatile("" ::: "memory");
            }
            {
                const u32x4 w1 = __builtin_bit_cast(u32x4, qf[4]), w2 = __builtin_bit_cast(u32x4, qf[5]);
                const size_t trow = (size_t)((bh >> 4) * SEQ + qabs) * 16 + 8 * hi;
                u32x4 p1, p2;
                {   const f32x4 ga = *(const f32x4*)(qgain + 64 + 8 * hi), gb = *(const f32x4*)(qgain + 80 + 8 * hi), c = *(const f32x4*)(cosT + trow), sn = *(const f32x4*)(sinT + trow);
                    const f32x4 t1 = {bf_lo(w1.x) * ga[0], bf_hi(w1.x) * ga[1], bf_lo(w1.y) * ga[2], bf_hi(w1.y) * ga[3]}, t2 = {bf_lo(w2.x) * gb[0], bf_hi(w2.x) * gb[1], bf_lo(w2.y) * gb[2], bf_hi(w2.y) * gb[3]};
                    const f32x4 o1 = (t1 * c - t2 * sn) * rq, o2 = (t2 * c + t1 * sn) * rq;
                    p1.x = cvtpk(o1[0], o1[1]); p1.y = cvtpk(o1[2], o1[3]); p2.x = cvtpk(o2[0], o2[1]); p2.y = cvtpk(o2[2], o2[3]); }
                asm volatile("" ::: "memory");
                {   const f32x4 ga = *(const f32x4*)(qgain + 64 + 8 * hi + 4), gb = *(const f32x4*)(qgain + 80 + 8 * hi + 4), c = *(const f32x4*)(cosT + trow + 4), sn = *(const f32x4*)(sinT + trow + 4);
                    const f32x4 t1 = {bf_lo(w1.z) * ga[0], bf_hi(w1.z) * ga[1], bf_lo(w1.w) * ga[2], bf_hi(w1.w) * ga[3]}, t2 = {bf_lo(w2.z) * gb[0], bf_hi(w2.z) * gb[1], bf_lo(w2.w) * gb[2], bf_hi(w2.w) * gb[3]};
                    const f32x4 o1 = (t1 * c - t2 * sn) * rq, o2 = (t2 * c + t1 * sn) * rq;
                    p1.z = cvtpk(o1[0], o1[1]); p1.w = cvtpk(o1[2], o1[3]); p2.z = cvtpk(o2[0], o2[1]); p2.w = cvtpk(o2[2], o2[3]); }
                qf[4] = __builtin_bit_cast(bf16x8, p1); qf[5] = __builtin_bit_cast(bf16x8, p2);
            }
        }
        const bf16_t* Kb = K + (size_t)bh * SEQ * 96; const bf16_t* Vb = Vt + (size_t)bh * 64 * SEQ + (size_t)vdv * SEQ + vc * 8;
        AttK Kx; Kx.k1 = (u32x4){0u, 0u, 0u, 0u}; u32x4 Vx;
#define LDK(R, t) do { const bf16_t* kt_ = Kb + (size_t)(t) * 6144; R.k0 = *(const u32x4*)(kt_ + tid * 8); if (tid < 256) R.k1 = *(const u32x4*)(kt_ + (512 + tid) * 8); } while (0)
#define LDV(R, t) do { R = *(const u32x4*)(Vb + (t) * 64); } while (0)
#define STK(R, sl) do { LAS unsigned char* kb_ = lds + (sl) * KBUF; *(LAS u32x4*)(kb_ + kp0r * KROW + kp0c * 16) = R.k0; if (tid < 256) *(LAS u32x4*)(kb_ + kp1r * KROW + kp1c * 16) = R.k1; } while (0)
#define STV(R, sl) do { LAS unsigned char* vb_ = lds + VOFF + (sl) * VBUF + vdv * VROW + vc * 16; *(LAS u32x2*)(vb_) = (u32x2){R.x, R.y}; *(LAS u32x2*)(vb_ + 8) = (u32x2){R.z, R.w}; } while (0)
#define ACT(t) (64 * (t) <= qw0 + 31)
        float m_ref = -INFINITY, l_run = 0.f; f32x16 o0, o1, sA0, sA1, sB0, sB1;
#pragma unroll
        for (int r = 0; r < 16; ++r) { o0[r] = 0.f; o1[r] = 0.f; }
        const LAS unsigned char* kbase = lds + r32 * KROW + hi * 16; const LAS unsigned char* vbase = lds + VOFF + r32 * VROW + hi * 8;
        LDK(Kx, 0); LDV(Vx, 0); STK(Kx, 0); STV(Vx, 0); LDK(Kx, 1); STK(Kx, 1);
        ATT_BAR();
        att_qk(kbase, qf, sA0, sA1);
        ATT_BAR();
        for (int t = 0; t < NT; t += 2) {
            if (t + 2 < NT) LDK(Kx, t + 2);
            LDV(Vx, t + 1);
            if (ACT(t + 1)) att_qk(kbase + KBUF, qf, sB0, sB1);
            if (ACT(t)) att_soft_pv<NOMAX>(vbase, sA0, sA1, o0, o1, m_ref, l_run, t, qw0, qabs, hi);
            if (t + 2 < NT) STK(Kx, 0);
            STV(Vx, 1);
            ATT_BAR();
            if (t + 3 < NT) LDK(Kx, t + 3);
            if (t + 2 < NT) LDV(Vx, t + 2);
            if (t + 2 < NT && ACT(t + 2)) att_qk(kbase, qf, sA0, sA1);
            if (ACT(t + 1)) att_soft_pv<NOMAX>(vbase + VBUF, sB0, sB1, o0, o1, m_ref, l_run, t + 1, qw0, qabs, hi);
            if (t + 3 < NT) STK(Kx, 1);
            if (t + 2 < NT) STV(Vx, 0);
            ATT_BAR();
        }
        {
            float lt = l_run; { auto rr = __builtin_amdgcn_permlane32_swap(__float_as_uint(lt), __float_as_uint(lt), false, false); lt = __uint_as_float(rr[0]) + __uint_as_float(rr[1]); }
            const float inv = 1.0f / lt;
            const int b = bh >> 4, h = bh & 15;
            bf16_t* Op = O + ((size_t)(b * SEQ + qabs)) * DM + h * 64 + 4 * hi;
#pragma unroll
            for (int rg = 0; rg < 4; ++rg) {
                u32x2 w0; w0.x = cvtpk(o0[4 * rg] * inv, o0[4 * rg + 1] * inv); w0.y = cvtpk(o0[4 * rg + 2] * inv, o0[4 * rg + 3] * inv);
                u32x2 w1; w1.x = cvtpk(o1[4 * rg] * inv, o1[4 * rg + 1] * inv); w1.y = cvtpk(o1[4 * rg + 2] * inv, o1[4 * rg + 3] * inv);
                *(u32x2*)(Op + 8 * rg) = w0; *(u32x2*)(Op + 32 + 8 * rg) = w1;
            }
        }
    }
#undef LDK
#undef LDV
#undef STK
#undef STV
#undef ACT
}
__device__ __forceinline__ void attn_phase(LAS unsigned char* lds, const bf16_t* __restrict__ Q, const bf16_t* __restrict__ K, const bf16_t* __restrict__ Vt, bf16_t* __restrict__ O, const float* __restrict__ qgain, const float* __restrict__ kgain, const float* __restrict__ cosT, const float* __restrict__ sinT, int vcu, int G, const int wave_s) {
    bool fast;
    { const int lane = pg8::lane_id_asm(); float gq = fabsf(qgain[lane]), gk = fabsf(kgain[lane]);
      if (lane < 32) { gq = fmaxf(gq, fabsf(qgain[64 + lane])); gk = fmaxf(gk, fabsf(kgain[64 + lane])); }
#pragma unroll
      for (int o = 1; o < 64; o <<= 1) { gq = fmaxf(gq, __shfl_xor(gq, o)); gk = fmaxf(gk, __shfl_xor(gk, o)); }
      fast = __builtin_amdgcn_readfirstlane((int)(14.14f * gq * gk < 60.0f)) != 0; }
    if (fast) attn_units<true>(lds, Q, K, Vt, O, qgain, cosT, sinT, vcu, G, wave_s); else attn_units<false>(lds, Q, K, Vt, O, qgain, cosT, sinT, vcu, G, wave_s);
    __builtin_amdgcn_s_waitcnt(0);
    {
    }
}

#define RLX_AGENT __ATOMIC_RELAXED, __HIP_MEMORY_SCOPE_AGENT
#define LDS_WAIT() asm volatile("s_waitcnt lgkmcnt(0)" ::: "memory")
#define VM_WAIT() asm volatile("s_waitcnt vmcnt(0)" ::: "memory")
__device__ __forceinline__ unsigned long long rt() { return __builtin_amdgcn_s_memrealtime(); }
__device__ __forceinline__ unsigned f2bf(float f) { unsigned u = __builtin_bit_cast(unsigned, f); return (u + 0x7fffu + ((u >> 16) & 1u)) >> 16; }
__device__ __forceinline__ unsigned pk2(float lo, float hi) { return f2bf(lo) | (f2bf(hi) << 16); }

#define XB_TMO      128
#define XB_XCNT(j)  (256  + 64 * (j))
#define XB_XSUB(j)  (1280 + 64 * (j))
#define XB_XGEN(j)  (2304 + 64 * (j))
#define XB_TOP      3328
#define XB_TOPGEN   3392
#define XCD_BAR_WORDS 3456
#define XB_SPIN_CAP (1u << 18)

__device__ __forceinline__ unsigned xb_ld(unsigned* p)              { return __hip_atomic_load(p, __ATOMIC_RELAXED, __HIP_MEMORY_SCOPE_AGENT); }
__device__ __forceinline__ unsigned xb_add(unsigned* p, unsigned v) { return __hip_atomic_fetch_add(p, v, __ATOMIC_RELAXED, __HIP_MEMORY_SCOPE_AGENT); }
__device__ __forceinline__ unsigned xb_xcc_id() { return (unsigned)__builtin_amdgcn_s_getreg((3 << 11) | 20) & 0xFu; }
#define XB_SPIN(cond, bar) do { unsigned _sp = 0; while (cond) { __builtin_amdgcn_s_sleep(1); \
    if ((++_sp & 255u) == 0u) { if (xb_ld(&(bar)[XB_TMO])) break; if (_sp > XB_SPIN_CAP) { atomicAdd(&(bar)[XB_TMO], 1u); break; } } } } while (0)

struct XcdBarrier {
    unsigned* bar; unsigned x;
    volatile LAS unsigned* st;
};

__device__ __forceinline__ XcdBarrier xcd_barrier_post(unsigned* bar, volatile LAS unsigned* st) {
    XcdBarrier b; b.bar = bar; b.x = xb_xcc_id(); b.st = st;
    if (threadIdx.x == 0) (void)xb_add(&bar[XB_XCNT(b.x)], 1u);
    return b;
}
__device__ __forceinline__ void xcd_barrier_complete(unsigned* bar, unsigned x, unsigned& nloc, unsigned& nx) {
    const unsigned G = gridDim.x * gridDim.y * gridDim.z;
    unsigned sum, cnt, mine, sp = 0u;
    for (;;) {
        sum = 0u; cnt = 0u; mine = 0u;
#pragma unroll
        for (unsigned j = 0; j < 16; ++j) { const unsigned c = xb_ld(&bar[XB_XCNT(j)]); sum += c; cnt += (c > 0u) ? 1u : 0u; mine = (j == x) ? c : mine; }
        if (sum == G) break;
        __builtin_amdgcn_s_sleep(1);
        if ((++sp & 255u) == 0u) { if (xb_ld(&bar[XB_TMO])) break; if (sp > XB_SPIN_CAP) { atomicAdd(&bar[XB_TMO], 1u); break; } }
    }
    nloc = mine > 0u ? mine : 1u; nx = cnt > 0u ? cnt : 1u;
}

__device__ __forceinline__ void xcd_barrier(const XcdBarrier& b) {
    asm volatile("s_waitcnt vmcnt(0)" ::: "memory");
    __syncthreads();
    if (threadIdx.x == 0) {
        unsigned* bar = b.bar;
        __builtin_amdgcn_s_waitcnt(0);
        unsigned nloc = b.st[0], nx = b.st[1];
        if (nloc == 0u) { xcd_barrier_complete(bar, b.x, nloc, nx); b.st[0] = nloc; b.st[1] = nx; }
        const unsigned old = xb_add(&bar[XB_XSUB(b.x)], 1u);
        const unsigned gen = old / nloc;
        if (old + 1u == (gen + 1u) * nloc) {
            __builtin_amdgcn_fence(__ATOMIC_RELEASE, "agent");
            asm volatile("s_waitcnt vmcnt(0)" ::: "memory");
            const unsigned og = xb_add(&bar[XB_TOP], 1u);
            const unsigned tg = og / nx;
            if (og + 1u == (tg + 1u) * nx) xb_add(&bar[XB_TOPGEN], 1u);
            else XB_SPIN(xb_ld(&bar[XB_TOPGEN]) == tg, bar);
            __builtin_amdgcn_fence(__ATOMIC_ACQUIRE, "agent");
            xb_add(&bar[XB_XGEN(b.x)], 1u);
            asm volatile("s_waitcnt vmcnt(0)" ::: "memory");
        } else {
            XB_SPIN(xb_ld(&bar[XB_XGEN(b.x)]) == gen, bar);
            __builtin_amdgcn_fence(__ATOMIC_ACQUIRE, "agent");
            asm volatile("s_waitcnt vmcnt(0)" ::: "memory");
        }
    }
    __syncthreads();
}

__global__ void __launch_bounds__(NTHREADS, 2) fwd_mega(Args a) {
    extern __shared__ __attribute__((aligned(16))) unsigned char lds_raw[];
    LAS unsigned char* lds = (LAS unsigned char*)lds_raw;
    cg::grid_group grid = cg::this_grid();
    const int wave_s = __builtin_amdgcn_readfirstlane(threadIdx.x >> 6);
#define TID_NOW (wave_s * 64 + pg8::lane_id_asm())
    if (threadIdx.x < 4) ((volatile LAS unsigned*)(lds + MISC_OFF))[threadIdx.x] = 0u;
    __syncthreads();
    (void)xcd_barrier_post((unsigned*)(a.ws + WS_CTL), (volatile LAS unsigned*)(lds + MISC_OFF));
#define PH_ON (true)
#define SEAM() do { { unsigned long long wsb_ = (unsigned long long)a.ws; asm volatile("" : "+s"(wsb_)); XcdBarrier b_; b_.bar = (unsigned*)((unsigned char*)wsb_ + WS_CTL); b_.x = xb_xcc_id(); b_.st = (volatile LAS unsigned*)(lds + MISC_OFF); xcd_barrier(b_); } } while (0)
#ifdef PROBE_SYNC2
#define PH_NEXT do { SEAM(); SEAM(); } while (0)
#else
#define PH_NEXT do { SEAM(); } while (0)
#endif
#define WS_LOCAL int G = gridDim.x; asm volatile("" : "+s"(G)); const int bx = blockIdx.x, vcu = (G % 8 == 0) ? (bx % 8) * (G / 8) + bx / 8 : bx; (void)vcu; unsigned long long wsi_ = (unsigned long long)a.ws; asm volatile("" : "+s"(wsi_)); unsigned char* ws = (unsigned char*)(GAS unsigned char*)wsi_; float* ss = (float*)(ws + WS_SS); bf16_t* xb = (bf16_t*)(ws + WS_XB); (void)ss; (void)xb

#ifndef DIS_P0
    if (PH_ON) { WS_LOCAL; const int tid = TID_NOW;
#ifdef PROBE_P02
#pragma unroll 1
        for (int rep_ = 0; rep_ < 2; ++rep_)
#endif
        prologue(a, lds, vcu, G, wave_s, tid & 63, tid); }
#endif
    if (a.ph_lo != 0) grid.sync();
    PH_NEXT;

#pragma unroll 1
    for (int li = 0; li < 4; ++li) {
#pragma unroll 1
        for (int j = 0; j < 2; ++j) {
            const int f = li * 2 + j;
            if (PH_ON) {
                WS_LOCAL; const bf16_t* wgu = (const bf16_t*)(ws + ffn_w_off(f));
                pg8::Gemm g{xb, wgu, M_TOK, 5632, 1024}; pg8::StaticOrder S; S.init(M_TOK, 5632, G, bx);
                EpiSwiglu E{ws, lds + EPI_OFF};
#ifndef DIS_F1
#ifdef PROBE_F12
#pragma unroll 1
                for (int rep_ = 0; rep_ < 2; ++rep_)
#endif
                pg8::gemm_phase<EpiSwiglu, pg8::StaticOrder, true, true>(lds, g, S, E, wave_s);
#endif
            }
            PH_NEXT;
            if (PH_ON) {
                WS_LOCAL; const bf16_t* wd = (const bf16_t*)(ws + ffn_w_off(f)) + (size_t)5632 * 1024;
                pg8::Gemm g{(const bf16_t*)(ws + T_H), wd, M_TOK, 1024, FF}; pg8::StaticOrder S; S.init(M_TOK, 1024, G, bx);
                EpiResid E{a.in[0], a.out, ws, 0.5f, f == 0 ? 1 : (f == 7 ? (2 | 4) : 0)};
#ifndef DIS_RES
                pg8::gemm_phase<EpiResid, pg8::StaticOrder, true, true>(lds, g, S, E, wave_s);
#endif
            }
            if (f != 7) PH_NEXT;
            if (j == 0) {
                const int kind = li % 3;
                if (kind == 0) {
                    const int ia = li == 0 ? 0 : 1;
                    if (PH_ON) {
                        WS_LOCAL; const bf16_t* win = (const bf16_t*)(ws + conv_w_off(ia));
                        pg8::Gemm g{xb, win, M_TOK, 3072, 1024}; pg8::StaticOrder S; S.init(M_TOK, 3072, G, bx);
                        EpiConvIn E{ws, lds + EPI_OFF};
#ifndef DIS_C1
                        pg8::gemm_phase<EpiConvIn, pg8::StaticOrder, true, true>(lds, g, S, E, wave_s);
#endif
                    }
                    PH_NEXT;
#ifndef DIS_E
                    if (PH_ON) { WS_LOCAL; const int tid = TID_NOW; conv_phase((const bf16_t*)(ws + T_Z), (const bf16_t*)(ws + T_BG), a.in[7] + (size_t)ia * 3 * 1024, (bf16_t*)(ws + T_G), vcu * NTHREADS + tid, G * NTHREADS); }
#endif
                    PH_NEXT;
                } else if (kind == 1) {
                    if (PH_ON) {
                        WS_LOCAL;
                        pg8::Gemm g{xb, (const bf16_t*)(ws + W_MLA_A), M_TOK, 512, 1024}; pg8::StaticOrder S; S.init(M_TOK, 512, G, bx);
                        EpiMlaA E{ws, lds + EPI_OFF};
#ifndef DIS_M1
                        pg8::gemm_phase<EpiMlaA, pg8::StaticOrder, true, true>(lds, g, S, E, wave_s);
#endif
                    }
                    PH_NEXT;
                    if (PH_ON) {
                        { WS_LOCAL; pg8::Gemm g{(const bf16_t*)(ws + T_AQ), (const bf16_t*)(ws + W_MLA_UQ), M_TOK, 2048, 256}; pg8::StaticOrder S; S.init(M_TOK, 2048, G, bx);
                          EpiQ E{ws};
#ifndef DIS_M2
                          pg8::gemm_phase<EpiQ, pg8::StaticOrder, true, true>(lds, g, S, E, wave_s);
#endif
                        }
                        { WS_LOCAL; pg8::Gemm g{(const bf16_t*)(ws + T_AKV), (const bf16_t*)(ws + W_MLA_UKV), M_TOK, 2048, 256}; pg8::StaticOrder S; S.init(M_TOK, 2048, G, bx);
                          EpiKV E{ws, a.out};
#ifndef DIS_M3
                          pg8::gemm_phase<EpiKV, pg8::StaticOrder, true, true>(lds, g, S, E, wave_s);
#endif
                        }
                    }
                    PH_NEXT;
#ifndef DIS_FIN
                    if (PH_ON) { WS_LOCAL; const int tid = TID_NOW; qk_finalize((bf16_t*)(ws + T_Q), (bf16_t*)(ws + T_K), (const float*)(ws + WS_KR), a.in[14], a.in[15], (const float*)(ws + WS_COS), (const float*)(ws + WS_SIN), vcu * NTHREADS + tid, G * NTHREADS); }
#endif
                    PH_NEXT;
#ifndef DIS_ATT
                    if (PH_ON) { WS_LOCAL;
#ifdef PROBE_ATT2
#pragma unroll 1
                        for (int rep_ = 0; rep_ < 2; ++rep_)
#endif
                        attn_phase(lds, (const bf16_t*)(ws + T_Q), (const bf16_t*)(ws + T_K), (const bf16_t*)((const unsigned char*)a.out + 64 * MiB), (bf16_t*)(ws + T_O), a.in[14], a.in[15], (const float*)(ws + WS_COS), (const float*)(ws + WS_SIN), vcu, G, wave_s); }
#endif
                    PH_NEXT;
                } else {
                    if (PH_ON) {
                        WS_LOCAL;
                        pg8::Gemm g{xb, (const bf16_t*)(ws + W_SG_IN), M_TOK, 2048, 1024}; pg8::StaticOrder S; S.init(M_TOK, 2048, G, bx);
                        EpiSgIn E{ws, lds + EPI_OFF};
#ifndef DIS_S1
                        pg8::gemm_phase<EpiSgIn, pg8::StaticOrder, true, true>(lds, g, S, E, wave_s);
#endif
                    }
                    PH_NEXT;
#ifndef DIS_S2
                    if (PH_ON) { WS_LOCAL; sg_phase(lds, (const bf16_t*)(ws + T_Z), (const bf16_t*)(ws + T_BG), (const float*)(ws + WS_SSV), a.in[18], (const bf16_t*)(ws + W_SG_S), a.in[20], (bf16_t*)(ws + T_G), vcu, G, wave_s); }
#endif
                    PH_NEXT;
                }
                if (PH_ON) {
                    WS_LOCAL;
                    const bf16_t* Amix = (const bf16_t*)(ws + (kind == 1 ? T_O : T_G));
                    const bf16_t* Wmix = kind == 0 ? (const bf16_t*)(ws + conv_w_off(li == 0 ? 0 : 1)) + (size_t)3072 * 1024 : kind == 1 ? (const bf16_t*)(ws + W_MLA_O) : (const bf16_t*)(ws + W_SG_OUT);
                    pg8::Gemm g{Amix, Wmix, M_TOK, 1024, 1024}; pg8::StaticOrder S; S.init(M_TOK, 1024, G, bx);
                    EpiResid E{a.in[0], a.out, ws, 1.0f, li == 3 ? 8 : 0};
#ifndef DIS_RES
                    pg8::gemm_phase<EpiResid, pg8::StaticOrder, true, true>(lds, g, S, E, wave_s);
#endif
                }
                PH_NEXT;
            }
        }
    }
}

#ifndef MK_PER_PHASE
#define MK_PER_PHASE 0
#endif
extern "C" void kernel_launch(void* const* d_in, const int* in_sizes, int n_in, void* d_out, int out_size, void* d_ws, size_t ws_size, hipStream_t stream) {
    static int grid = 0;
    if (grid == 0) {
        if (n_in != 22 || out_size != M_TOK * DM || ws_size < WS_END) { fprintf(stderr, "kernel_launch: unexpected shapes (n_in %d out %d ws %zu)\n", n_in, out_size, ws_size); grid = -1; return; }
        int dev = 0, cus = 0, per_cu = 0;
        hipGetDevice(&dev); hipDeviceGetAttribute(&cus, hipDeviceAttributeMultiprocessorCount, dev);
        if (hipFuncSetAttribute((const void*)fwd_mega, hipFuncAttributeMaxDynamicSharedMemorySize, LDS_BYTES) != hipSuccess) fprintf(stderr, "kernel_launch: hipFuncSetAttribute failed\n");
        if (hipOccupancyMaxActiveBlocksPerMultiprocessor(&per_cu, (const void*)fwd_mega, NTHREADS, LDS_BYTES) != hipSuccess || per_cu < 1) { fprintf(stderr, "kernel_launch: occupancy query says %d\n", per_cu); per_cu = 1; }
        (void)hipGetLastError();
        grid = cus * 1;
        fprintf(stderr, "kernel_launch: grid %d (per_cu %d)\n", grid, per_cu);
    }
    if (grid < 0) return;
    if (hipMemsetAsync((char*)d_ws + WS_CTL, 0, CTL_ZERO_BYTES, stream) != hipSuccess) { fprintf(stderr, "kernel_launch: memset failed\n"); return; }
    Args a{};
    for (int i = 0; i < 22; ++i) a.in[i] = (const float*)d_in[i];
    a.out = (float*)d_out; a.ws = (unsigned char*)d_ws;
    for (int i = 0; i < 16; ++i) { const float e = (float)(2 * i) / 32.0f; a.inv_freq[i] = 1.0f / powf(10000.0f, e); }
#if MK_PER_PHASE
    for (int p = 0; p < 31; ++p) { a.ph_lo = p; a.ph_hi = p + 1; hipLaunchKernelGGL(fwd_mega, dim3(grid), dim3(NTHREADS), LDS_BYTES, stream, a); }
#else
    a.ph_lo = 0; a.ph_hi = 1000;
    void* args[] = {&a};
    const hipError_t e = hipLaunchCooperativeKernel((const void*)fwd_mega, dim3(grid), dim3(NTHREADS), args, LDS_BYTES, stream);
    if (e != hipSuccess) fprintf(stderr, "kernel_launch: cooperative launch failed: %s (grid %d)\n", hipGetErrorString(e), grid);
#endif
}
```

```cpp
#include <hip/hip_runtime.h>
#include <hip/hip_cooperative_groups.h>
#include <cstdio>
#include <cstdint>
#include <cmath>
namespace cg = cooperative_groups;
namespace pg8 {
#define PG8_LAS __attribute__((address_space(3)))
typedef unsigned short bf16_t;
typedef short bf16x8 __attribute__((ext_vector_type(8)));
typedef float f32x4 __attribute__((ext_vector_type(4)));
typedef unsigned u32x4 __attribute__((ext_vector_type(4)));
constexpr int BM = 256, BK = 64, HALF = 128, HTB = HALF * BK * 2  , STAGE_BYTES = 8 * HTB, NXCD = 8, WGM = 4;

__host__ __device__ __forceinline__ int lds_byte(int r, int c) { const int st = (r >> 4) * 2 + (c >> 5), rr = r & 15, cc = c & 31, ob = rr * 64 + cc * 2; return st * 1024 + (ob ^ (((ob >> 9) & 1) << 5)); }
__host__ __device__ __forceinline__ void stage_rc(int b, int& R, int& C) { const int st = b / 1024, sb = b % 1024, swz = sb ^ (((sb >> 9) & 1) << 5); R = (st >> 1) * 16 + swz / 64; C = (st & 1) * 32 + (swz % 64) / 2; }
__host__ __device__ __forceinline__ int perm32(int rho) { const int n = rho >> 4, i = rho & 15; return 8 * (i >> 2) + 4 * n + (i & 3); }

__device__ __forceinline__ int lane_id_asm() { int l; asm volatile("v_mbcnt_lo_u32_b32 %0, -1, 0\n\tv_mbcnt_hi_u32_b32 %0, -1, %0" : "=v"(l)); return l; }
struct Unit { int pm, pn; };
struct Gemm { const bf16_t* A; const bf16_t* Bt; int M, N, K; };

struct StaticOrder {
    int nM, nN, nwg, G, c;
    __host__ __device__ void init(int M, int N, int G_, int c_) { nM = M / BM; nN = N / BM; nwg = nM * nN; G = G_; c = c_; }
    __host__ __device__ bool next(int i, Unit& u) const {
        const long L = (long)i * G + c; if (L >= nwg) return false;
        int wgid = (int)L; { const int q = nwg / NXCD, r = nwg % NXCD, xcd = wgid % NXCD, off = wgid / NXCD; wgid = (xcd < r ? xcd * (q + 1) : r * (q + 1) + (xcd - r) * q) + off; }
        const int nig = WGM * nN, gid = wgid / nig, fm = gid * WGM, gsz = (nM - fm) < WGM ? (nM - fm) : WGM;
        u.pm = fm + ((wgid % nig) % gsz); u.pn = (wgid % nig) / gsz; return true;
    }
    __device__ __forceinline__ void a_ready(const Unit&) const {}
    __device__ __forceinline__ void done(const Unit&) const {}
};

__device__ __forceinline__ unsigned cvt_pk_bf16(float lo, float hi) { unsigned r; asm volatile("v_cvt_pk_bf16_f32 %0, %1, %2" : "=v"(r) : "v"(lo), "v"(hi)); return r; }
typedef float f32x2 __attribute__((ext_vector_type(2)));
template <class Epi, class Sched, bool ALIGN_EPI = false, bool SP2 = false>
__device__ __forceinline__ void gemm_phase(PG8_LAS unsigned char* lds, const Gemm g, const Sched& S, const Epi& E, const int wave_id) {
    int wid_ = wave_id; asm volatile("" : "+s"(wid_)); const int lane = lane_id_asm(), wid = wid_, tid = wid * 64 + lane, wr = wid >> 2, wc = wid & 3, fr = lane & 15, fq = lane >> 4;
    const int K = g.K, nt = K / BK;
    unsigned voffA[2], voffB[2];
#pragma unroll
    for (int i = 0; i < 2; ++i) { int R, C; stage_rc(tid * 16 + i * 8192, R, C); const int Rb = Epi::PERM ? ((R & ~31) + perm32(R & 31)) : R;
        voffA[i] = (unsigned)(R * K + C) * 2u; voffB[i] = (unsigned)(Rb * K + C) * 2u; }
    const size_t kstep = (size_t)(BK * 2);
    const size_t hstep = (size_t)HALF * K * 2;
    const size_t tstep = 2 * hstep;
    const unsigned ldsw = (unsigned)wid * 1024u;
    const int aoff = lds_byte(wr * 64 + fr, fq * 8), boff = lds_byte(wc * 32 + fr, fq * 8);
#define PG8_SA(b, h) (((b) * 2 + (h)) * HTB)
#define PG8_SB(b, h) ((4 + (b) * 2 + (h)) * HTB)
#define PG8_STAGE(bufoff, gbase, voff) do { _Pragma("unroll") for (int _i = 0; _i < 2; ++_i) \
        __builtin_amdgcn_global_load_lds((const unsigned*)((const char*)(gbase) + (voff)[_i]), (PG8_LAS unsigned*)(lds + (bufoff) + ldsw + _i * 8192), 16, 0, 0); } while (0)
#define PG8_LDA(dst, b, h) do { _Pragma("unroll") for (int m = 0; m < 4; ++m) _Pragma("unroll") for (int k = 0; k < 2; ++k) dst[m][k] = *(const PG8_LAS bf16x8*)(lds + PG8_SA(b, h) + aoff + m * 2048 + k * 1024); } while (0)
#define PG8_LDB(dst, b, h) do { _Pragma("unroll") for (int n = 0; n < 2; ++n) _Pragma("unroll") for (int k = 0; k < 2; ++k) dst[n][k] = *(const PG8_LAS bf16x8*)(lds + PG8_SB(b, h) + boff + n * 2048 + k * 1024); } while (0)
#define PG8_MMA(ai, bj, At, Bt) do { __builtin_amdgcn_s_setprio(1); _Pragma("unroll") for (int m = 0; m < 4; ++m) _Pragma("unroll") for (int n = 0; n < 2; ++n) _Pragma("unroll") for (int k = 0; k < 2; ++k) \
        acc[ai][bj][m][n] = __builtin_amdgcn_mfma_f32_16x16x32_bf16(Bt[n][k], At[m][k], acc[ai][bj][m][n], 0, 0, 0); __builtin_amdgcn_s_setprio(0); } while (0)
#define PG8_WAIT_V(n) asm volatile("s_waitcnt vmcnt(" #n ")" ::: "memory")
#define PG8_WAIT_L(n) asm volatile("s_waitcnt lgkmcnt(" #n ")" ::: "memory")
#define PG8_BAR __builtin_amdgcn_s_barrier()
#define PG8_SCHED __builtin_amdgcn_sched_barrier(0)
    Unit cur, nxt; int ui = 0;
    if (!S.next(0, cur)) return;
    f32x4 acc[2][2][4][2];
#pragma unroll
    for (int a = 0; a < 2; ++a)
#pragma unroll
        for (int b = 0; b < 2; ++b)
#pragma unroll
            for (int m = 0; m < 4; ++m)
#pragma unroll
                for (int n = 0; n < 2; ++n) acc[a][b][m][n] = (f32x4){0.f, 0.f, 0.f, 0.f};
    bf16x8 At[4][2], B0[2][2], B1[2][2];
    const char* cA = (const char*)g.A + (size_t)cur.pm * tstep; const char* cB = (const char*)g.Bt + (size_t)cur.pn * tstep;
    S.a_ready(cur);
    if constexpr (SP2) {
        PG8_STAGE(PG8_SB(0, 0), cB, voffB); PG8_STAGE(PG8_SB(0, 1), cB + hstep, voffB); PG8_STAGE(PG8_SA(0, 0), cA, voffA); PG8_STAGE(PG8_SA(0, 1), cA + hstep, voffA);
        if (wr == 1) PG8_BAR;
        PG8_WAIT_V(2); PG8_BAR;
        PG8_STAGE(PG8_SB(1, 0), cB + kstep, voffB); PG8_STAGE(PG8_SA(1, 0), cA + kstep, voffA); PG8_STAGE(PG8_SB(1, 1), cB + hstep + kstep, voffB);
        PG8_WAIT_V(6); PG8_BAR;
    } else {
        PG8_STAGE(PG8_SB(0, 0), cB, voffB); PG8_STAGE(PG8_SA(0, 0), cA, voffA); PG8_STAGE(PG8_SB(0, 1), cB + hstep, voffB); PG8_STAGE(PG8_SA(0, 1), cA + hstep, voffA);
        if (wr == 1) PG8_BAR;
        PG8_WAIT_V(4); PG8_BAR;
        PG8_STAGE(PG8_SB(1, 0), cB + kstep, voffB); PG8_STAGE(PG8_SA(1, 0), cA + kstep, voffA); PG8_STAGE(PG8_SB(1, 1), cB + hstep + kstep, voffB);
        PG8_WAIT_V(6); PG8_BAR;
    }
    for (;;) {
        const bool has_next = S.next(ui + 1, nxt);
        const char* nA = has_next ? (const char*)g.A + (size_t)nxt.pm * tstep : cA; const char* nB = has_next ? (const char*)g.Bt + (size_t)nxt.pn * tstep : cB;
        for (int t = 0; t < nt; t += 2) {
            if (t == 2) E.prefetch(cur, wid, lane);
            const bool last = (t == nt - 2);
            const char* a1 = cA + (size_t)(t + 1) * kstep;
            const char* a2 = last ? nA : cA + (size_t)(t + 2) * kstep; const char* b2 = last ? nB : cB + (size_t)(t + 2) * kstep;
            const char* a3 = a2 + kstep; const char* b3 = b2 + kstep;
            if (last && has_next) S.a_ready(nxt);
            if constexpr (SP2) {
            PG8_LDB(B0, 0, 0); PG8_LDB(B1, 0, 1); PG8_SCHED; PG8_LDA(At, 0, 0); PG8_STAGE(PG8_SA(1, 1), a1 + hstep, voffA);
            PG8_WAIT_V(8); PG8_WAIT_L(0); PG8_BAR; PG8_MMA(0, 0, At, B0); PG8_MMA(0, 1, At, B1); PG8_BAR; PG8_SCHED;
            PG8_LDA(At, 0, 1); PG8_STAGE(PG8_SB(0, 0), b2, voffB); PG8_STAGE(PG8_SB(0, 1), b2 + hstep, voffB); PG8_STAGE(PG8_SA(0, 0), a2, voffA);
            PG8_WAIT_V(8); PG8_WAIT_L(0); PG8_BAR; PG8_MMA(1, 0, At, B0); PG8_MMA(1, 1, At, B1); PG8_BAR; PG8_SCHED;
            PG8_LDB(B0, 1, 0); PG8_LDB(B1, 1, 1); PG8_SCHED; PG8_LDA(At, 1, 0); PG8_STAGE(PG8_SA(0, 1), a2 + hstep, voffA);
            PG8_WAIT_V(8); PG8_WAIT_L(0); PG8_BAR; PG8_MMA(0, 0, At, B0); PG8_MMA(0, 1, At, B1); PG8_BAR; PG8_SCHED;
            PG8_LDA(At, 1, 1); PG8_STAGE(PG8_SB(1, 0), b3, voffB); PG8_STAGE(PG8_SB(1, 1), b3 + hstep, voffB); PG8_STAGE(PG8_SA(1, 0), a3, voffA);
            PG8_WAIT_V(8); PG8_WAIT_L(0); PG8_BAR; PG8_MMA(1, 0, At, B0); PG8_MMA(1, 1, At, B1); PG8_BAR; PG8_SCHED;
            } else {
            PG8_LDB(B0, 0, 0); PG8_SCHED; PG8_LDA(At, 0, 0); PG8_STAGE(PG8_SA(1, 1), a1 + hstep, voffA);
            PG8_WAIT_L(8); PG8_BAR; PG8_WAIT_L(0); PG8_MMA(0, 0, At, B0); PG8_BAR; PG8_SCHED;
            PG8_LDB(B1, 0, 1); PG8_STAGE(PG8_SB(0, 0), b2, voffB);
            PG8_BAR; PG8_WAIT_L(0); PG8_MMA(0, 1, At, B1); PG8_BAR;
            PG8_LDA(At, 0, 1); PG8_STAGE(PG8_SA(0, 0), a2, voffA);
            PG8_BAR; PG8_WAIT_L(0); PG8_MMA(1, 0, At, B0); PG8_BAR; PG8_SCHED;
            PG8_STAGE(PG8_SB(0, 1), b2 + hstep, voffB);
            PG8_WAIT_V(6); PG8_BAR; PG8_MMA(1, 1, At, B1); PG8_BAR;
            PG8_LDB(B0, 1, 0); PG8_SCHED; PG8_LDA(At, 1, 0); PG8_STAGE(PG8_SA(0, 1), a2 + hstep, voffA);
            PG8_WAIT_L(8); PG8_BAR; PG8_WAIT_L(0); PG8_MMA(0, 0, At, B0); PG8_BAR; PG8_SCHED;
            PG8_LDB(B1, 1, 1); PG8_STAGE(PG8_SB(1, 0), b3, voffB);
            PG8_BAR; PG8_WAIT_L(0); PG8_MMA(0, 1, At, B1); PG8_BAR;
            PG8_LDA(At, 1, 1); PG8_STAGE(PG8_SA(1, 0), a3, voffA);
            PG8_BAR; PG8_WAIT_L(0); PG8_MMA(1, 0, At, B0); PG8_BAR; PG8_SCHED;
            PG8_STAGE(PG8_SB(1, 1), b3 + hstep, voffB);
            PG8_WAIT_V(6); PG8_BAR; PG8_MMA(1, 1, At, B1); PG8_BAR;
            }
        }
        if constexpr (ALIGN_EPI) { if (wr == 0) PG8_BAR; }
        if constexpr (!Epi::AFTER_DRAIN) { E(acc, cur, wr, wc, fr, fq); S.done(cur); }
        if (!has_next) break;
#pragma unroll
        for (int a = 0; a < 2; ++a)
#pragma unroll
            for (int b = 0; b < 2; ++b)
#pragma unroll
                for (int m = 0; m < 4; ++m)
#pragma unroll
                    for (int n = 0; n < 2; ++n) acc[a][b][m][n] = (f32x4){0.f, 0.f, 0.f, 0.f};
        cur = nxt; cA = nA; cB = nB; ++ui;
        if constexpr (ALIGN_EPI) { if (wr == 1) PG8_BAR; }
    }
    PG8_WAIT_V(0);
    if constexpr (!ALIGN_EPI) { if (wr == 0) PG8_BAR; }
    PG8_BAR;
    if constexpr (Epi::AFTER_DRAIN) { E.fused(acc, cur, wr, wc, fr, fq, lds, wid, lane); S.done(cur); }
#undef PG8_SA
#undef PG8_SB
#undef PG8_STAGE
#undef PG8_LDA
#undef PG8_LDB
#undef PG8_MMA
#undef PG8_WAIT_V
#undef PG8_WAIT_L
#undef PG8_BAR
#undef PG8_SCHED
}
}

#define LAS __attribute__((address_space(3)))
#define GAS __attribute__((address_space(1)))
typedef unsigned short bf16_t;
typedef float f32x4 __attribute__((ext_vector_type(4)));
typedef float f32x16 __attribute__((ext_vector_type(16)));
typedef short bf16x8 __attribute__((ext_vector_type(8)));
typedef short s16x4 __attribute__((ext_vector_type(4)));
typedef unsigned u32x4 __attribute__((ext_vector_type(4)));
typedef unsigned u32x2 __attribute__((ext_vector_type(2)));

constexpr int M_TOK = 32768, DM = 1024, FF = 2816, SEQ = 8192;
constexpr float EPS = 1e-6f;
constexpr float QSCALE = 0.10206207261596575f * 1.4426950408889634f;
constexpr int NTHREADS = 512, NWAVES = 8;
constexpr size_t MiB = 1u << 20;
constexpr size_t WS_SS = 0, WS_SSV = 2 * MiB, WS_SSQ = 4 * MiB, WS_SSKV = 4 * MiB + 512 * 1024, WS_SSPE = 5 * MiB;
constexpr size_t WS_COS = 6 * MiB, WS_SIN = 8 * MiB, WS_KR = 10 * MiB;
constexpr size_t WS_CTL = 14 * MiB, CTL_ZERO_BYTES = 16384;
constexpr size_t WS_XB = 16 * MiB;
constexpr size_t WS_WB = 80 * MiB;
constexpr size_t FFN_BYTES = 16 * MiB + 512 * 1024;
constexpr size_t W_CONV1 = WS_WB + 6 * FFN_BYTES;
constexpr size_t W_MLA_A = W_CONV1 + 8 * MiB, W_MLA_UQ = W_MLA_A + 1 * MiB, W_MLA_UKV = W_MLA_UQ + 1 * MiB, W_MLA_O = W_MLA_UKV + 1 * MiB;
constexpr size_t W_SG_IN = W_MLA_O + 2 * MiB, W_SG_OUT = W_SG_IN + 4 * MiB, W_SG_S = W_SG_OUT + 2 * MiB;
constexpr size_t WS_WL0 = 198 * MiB + 512 * 1024;
constexpr size_t W_CONV0 = WS_WL0 + 2 * FFN_BYTES;
static_assert(W_SG_S + 256 * 1024 <= WS_WL0, "weights map");
constexpr size_t WS_T = 240 * MiB;
static_assert(W_CONV0 + 8 * MiB <= WS_T, "weights map 2");
constexpr size_t T_H = WS_T;
constexpr size_t T_Z = WS_T, T_BG = WS_T + 64 * MiB, T_G = WS_T + 128 * MiB;
constexpr size_t T_Q = WS_T, T_K = WS_T + 96 * MiB, T_O = WS_T + 192 * MiB, T_AQ = T_O, T_AKV = T_O + 16 * MiB;
constexpr size_t T_LO = WS_T + 192 * MiB;
constexpr size_t WS_END = 512 * MiB;
static_assert(T_O + 64 * MiB <= WS_END && T_H + 176 * MiB <= WS_END, "temp map");
constexpr int RING_BYTES = 131072, EPI_OFF = RING_BYTES  , MISC_OFF = RING_BYTES + 16384, LDS_BYTES = 147456 + 256;

__device__ __forceinline__ size_t ffn_w_off(int f) { return f < 2 ? WS_WL0 + (size_t)f * FFN_BYTES : WS_WB + (size_t)(f - 2) * FFN_BYTES; }
__device__ __forceinline__ size_t conv_w_off(int ia) { return ia == 0 ? W_CONV0 : W_CONV1; }

__device__ __forceinline__ unsigned cvtpk(float lo, float hi) { return pg8::cvt_pk_bf16(lo, hi); }
__device__ __forceinline__ u32x4 pack8(f32x4 a, f32x4 b) { u32x4 w; w.x = cvtpk(a[0], a[1]); w.y = cvtpk(a[2], a[3]); w.z = cvtpk(b[0], b[1]); w.w = cvtpk(b[2], b[3]); return w; }
__device__ __forceinline__ float bf_lo(unsigned w) { return __uint_as_float(w << 16); }
__device__ __forceinline__ float bf_hi(unsigned w) { return __uint_as_float(w & 0xffff0000u); }
__device__ __forceinline__ float dot4(f32x4 a) { return (a[0] * a[0] + a[1] * a[1]) + (a[2] * a[2] + a[3] * a[3]); }
__device__ __forceinline__ float wave_sum(float v) {
#pragma unroll
    for (int o = 1; o < 64; o <<= 1) v += __shfl_xor(v, o);
    return v;
}
__device__ __forceinline__ float swap32(float x, bool hi) { auto rr = __builtin_amdgcn_permlane32_swap(__float_as_uint(x), __float_as_uint(x), false, false); return __uint_as_float(hi ? rr[0] : rr[1]); }
__device__ __forceinline__ float red_fq(float s) { s += __shfl_xor(s, 16); s += __shfl_xor(s, 32); return s; }
__device__ __forceinline__ float row_rs16(const GAS float* ss, int row, int fq) {
    const f32x4 p = *(const GAS f32x4*)(ss + (size_t)row * 16 + 4 * fq);
    const float s = red_fq((p[0] + p[1]) + (p[2] + p[3]));
    return rsqrtf(s * (1.0f / 1024.0f) + EPS);
}
__device__ __forceinline__ float silu_f(float x) { return x * __builtin_amdgcn_rcpf(1.0f + __expf(-x)); }
__device__ __forceinline__ float gelu_tanh_f(float x) { const float u2 = 1.5957691216057308f * (x + 0.044715f * x * x * x); return x * __builtin_amdgcn_rcpf(1.0f + __expf(-u2)); }
#define EPI_FENCE() do { asm volatile("" ::: "memory"); __builtin_amdgcn_sched_barrier(0); } while (0)
#define EPI_BAR() do { asm volatile("s_waitcnt lgkmcnt(0)" ::: "memory"); __builtin_amdgcn_s_barrier(); EPI_FENCE(); } while (0)

typedef const pg8::f32x4 (&AccRef)[2][2][4][2];

__device__ __forceinline__ void ss_prefetch(unsigned char* ws, LAS unsigned char* ldsE, int pm, int wid, int lane) {
    unsigned long long wi_ = (unsigned long long)ws; asm volatile("" : "+s"(wi_));
    (void)lane; const unsigned lo16 = (unsigned)pg8::lane_id_asm() * 16u;
    const unsigned char* srcu = (const unsigned char*)wi_ + WS_SS + (size_t)pm * 16384 + wid * 2048;
    const unsigned char* src = srcu + lo16;
    __builtin_amdgcn_global_load_lds((const unsigned*)src, (LAS unsigned*)(ldsE + wid * 2048), 16, 0, 0);
    __builtin_amdgcn_global_load_lds((const unsigned*)(src + 1024), (LAS unsigned*)(ldsE + wid * 2048 + 1024), 16, 0, 0);
}

struct EpiSwiglu {
    static constexpr bool PERM = true, AFTER_DRAIN = false;
    unsigned char* ws; LAS unsigned char* ldsE;
    __device__ __forceinline__ void prefetch(const pg8::Unit& u, int wid, int lane) const { ss_prefetch(ws, ldsE, u.pm, wid, lane); }
    __device__ __forceinline__ void operator()(AccRef acc, const pg8::Unit& u, int wr, int wc, int fr_in, int fq_in) const {
        const int lane_e = pg8::lane_id_asm(); const int fr = lane_e & 15, fq = lane_e >> 4; (void)fr_in; (void)fq_in;
        unsigned long long wi_ = (unsigned long long)ws; asm volatile("" : "+s"(wi_)); GAS unsigned char* w = (GAS unsigned char*)wi_;
        const GAS float* ss = (const GAS float*)(w + WS_SS); GAS bf16_t* H = (GAS bf16_t*)(w + T_H);
        const int rowb = u.pm * 256 + wr * 64 + fr, hcol = u.pn * 128 + wc * 32 + 8 * fq;
        float rs8[8];
        { f32x4 pp[8];
#pragma unroll
          for (int q = 0; q < 8; ++q) pp[q] = *(const LAS f32x4*)(ldsE + ((q >> 2) * 128 + wr * 64 + (q & 3) * 16 + fr) * 64 + fq * 16);
#pragma unroll
          for (int q = 0; q < 8; ++q) rs8[q] = rsqrtf(red_fq((pp[q][0] + pp[q][1]) + (pp[q][2] + pp[q][3])) * (1.0f / 1024.0f) + EPS); }
        EPI_FENCE();
#pragma unroll
        for (int ai = 0; ai < 2; ++ai)
#pragma unroll
            for (int m = 0; m < 4; ++m) {
                const int row = rowb + ai * 128 + m * 16; const float rs = rs8[ai * 4 + m];
                const float k1 = rs * -1.4426950408889634f, r2 = rs * rs; (void)r2;
                f32x4 h0, h1;
#pragma unroll
                for (int j = 0; j < 4; ++j) {
                    { const float a = acc[ai][0][m][0][j], b = acc[ai][1][m][0][j]; { const float x = a * rs; h0[j] = (x * __builtin_amdgcn_rcpf(1.0f + __builtin_amdgcn_exp2f(a * k1))) * (b * rs); } }
                    { const float a = acc[ai][0][m][1][j], b = acc[ai][1][m][1][j]; { const float x = a * rs; h1[j] = (x * __builtin_amdgcn_rcpf(1.0f + __builtin_amdgcn_exp2f(a * k1))) * (b * rs); } }
                }
                *(GAS u32x4*)(H + (size_t)row * FF + hcol) = pack8(h0, h1);
            }
    }
};

struct EpiResid {
    static constexpr bool PERM = true, AFTER_DRAIN = false;
    const float* xf32; float* outp; unsigned char* ws; float alpha; int flags;
    __device__ __forceinline__ void prefetch(const pg8::Unit&, int, int) const {}
    __device__ __forceinline__ void operator()(AccRef acc, const pg8::Unit& u, int wr, int wc, int fr_in, int fq_in) const {
        const int lane_e = pg8::lane_id_asm(); const int fr = lane_e & 15, fq = lane_e >> 4; (void)fr_in; (void)fq_in;
        unsigned long long wi_ = (unsigned long long)ws; asm volatile("" : "+s"(wi_)); GAS unsigned char* w = (GAS unsigned char*)wi_;
        GAS float* ss = (GAS float*)(w + WS_SS); GAS bf16_t* xb = (GAS bf16_t*)(w + WS_XB);
        const bf16_t* lo_in = (flags & 4) ? (const bf16_t*)((unsigned char*)w + T_LO) : (const bf16_t*)outp;
        bf16_t* lo_out = (flags & 8) ? (bf16_t*)((unsigned char*)w + T_LO) : (bf16_t*)outp;
        const bool first = flags & 1, final_ = flags & 2;
        const int rowb = u.pm * 256 + wr * 64 + fr, colb = u.pn * 256 + wc * 32 + 8 * fq;
#pragma unroll
        for (int ai = 0; ai < 2; ++ai) {
            f32x4 xv[4][2][2];
            if (first) {
#pragma unroll
                for (int m = 0; m < 4; ++m)
#pragma unroll
                    for (int bj = 0; bj < 2; ++bj) { const size_t off = (size_t)(rowb + ai * 128 + m * 16) * DM + colb + bj * 128; xv[m][bj][0] = *(const f32x4*)(xf32 + off); xv[m][bj][1] = *(const f32x4*)(xf32 + off + 4); }
            } else {
                u32x4 rh[4][2], rl[4][2];
#pragma unroll
                for (int m = 0; m < 4; ++m)
#pragma unroll
                    for (int bj = 0; bj < 2; ++bj) { const size_t off = (size_t)(rowb + ai * 128 + m * 16) * DM + colb + bj * 128; rh[m][bj] = *(const GAS u32x4*)(xb + off); rl[m][bj] = *(const u32x4*)(lo_in + off); }
#pragma unroll
                for (int m = 0; m < 4; ++m)
#pragma unroll
                    for (int bj = 0; bj < 2; ++bj) { const u32x4 h = rh[m][bj], l = rl[m][bj];
                        xv[m][bj][0] = (f32x4){bf_lo(h.x) + bf_lo(l.x), bf_hi(h.x) + bf_hi(l.x), bf_lo(h.y) + bf_lo(l.y), bf_hi(h.y) + bf_hi(l.y)};
                        xv[m][bj][1] = (f32x4){bf_lo(h.z) + bf_lo(l.z), bf_hi(h.z) + bf_hi(l.z), bf_lo(h.w) + bf_lo(l.w), bf_hi(h.w) + bf_hi(l.w)}; }
            }
#pragma unroll
            for (int m = 0; m < 4; ++m) {
                const int row = rowb + ai * 128 + m * 16; float sq = 0.f;
#pragma unroll
                for (int bj = 0; bj < 2; ++bj) {
                    const size_t off = (size_t)row * DM + colb + bj * 128;
                    const f32x4 y0 = xv[m][bj][0] + acc[ai][bj][m][0] * alpha, y1 = xv[m][bj][1] + acc[ai][bj][m][1] * alpha;
                    if (final_) { *(f32x4*)(outp + off) = y0; *(f32x4*)(outp + off + 4) = y1; }
                    else {
                        const u32x4 h = pack8(y0, y1);
                        const f32x4 d0 = {y0[0] - bf_lo(h.x), y0[1] - bf_hi(h.x), y0[2] - bf_lo(h.y), y0[3] - bf_hi(h.y)}, d1 = {y1[0] - bf_lo(h.z), y1[1] - bf_hi(h.z), y1[2] - bf_lo(h.w), y1[3] - bf_hi(h.w)};
                        *(GAS u32x4*)(xb + off) = h; *(u32x4*)(lo_out + off) = pack8(d0, d1);
                        sq += dot4(y0) + dot4(y1);
                    }
                }
                if (!final_) { sq = red_fq(sq); if (fq == 0) ss[(size_t)row * 16 + u.pn * 4 + wc] = sq; }
            }
            EPI_FENCE();
        }
    }
};

struct EpiConvIn {
    static constexpr bool PERM = true, AFTER_DRAIN = false;
    unsigned char* ws; LAS unsigned char* ldsE;
    __device__ __forceinline__ void prefetch(const pg8::Unit& u, int wid, int lane) const { ss_prefetch(ws, ldsE, u.pm, wid, lane); }
    __device__ __forceinline__ void operator()(AccRef acc, const pg8::Unit& u, int wr, int wc, int fr_in, int fq_in) const {
        const int lane_e = pg8::lane_id_asm(); const int fr = lane_e & 15, fq = lane_e >> 4; (void)fr_in; (void)fq_in;
        unsigned long long wi_ = (unsigned long long)ws; asm volatile("" : "+s"(wi_)); GAS unsigned char* w = (GAS unsigned char*)wi_;
        const GAS float* ss = (const GAS float*)(w + WS_SS); GAS bf16_t* Z = (GAS bf16_t*)(w + T_Z); GAS bf16_t* Bg = (GAS bf16_t*)(w + T_BG);
        const int rowb = u.pm * 256 + wr * 64 + fr;
        float rs8[8];
        { f32x4 pp[8];
#pragma unroll
          for (int q = 0; q < 8; ++q) pp[q] = *(const LAS f32x4*)(ldsE + ((q >> 2) * 128 + wr * 64 + (q & 3) * 16 + fr) * 64 + fq * 16);
#pragma unroll
          for (int q = 0; q < 8; ++q) rs8[q] = rsqrtf(red_fq((pp[q][0] + pp[q][1]) + (pp[q][2] + pp[q][3])) * (1.0f / 1024.0f) + EPS); }
        EPI_FENCE();
#pragma unroll
        for (int ai = 0; ai < 2; ++ai)
#pragma unroll
            for (int m = 0; m < 4; ++m) {
                const int row = rowb + ai * 128 + m * 16; const float rs = rs8[ai * 4 + m];
                if (u.pn < 8) {
                    const float r2 = rs * rs;
                    const f32x4 z0 = acc[ai][0][m][0] * acc[ai][1][m][0] * r2, z1 = acc[ai][0][m][1] * acc[ai][1][m][1] * r2;
                    *(GAS u32x4*)(Z + (size_t)row * DM + u.pn * 128 + wc * 32 + 8 * fq) = pack8(z0, z1);
                } else {
#pragma unroll
                    for (int bj = 0; bj < 2; ++bj)
                        *(GAS u32x4*)(Bg + (size_t)row * DM + (u.pn - 8) * 256 + bj * 128 + wc * 32 + 8 * fq) = pack8(acc[ai][bj][m][0] * rs, acc[ai][bj][m][1] * rs);
                }
            }
    }
};

struct EpiMlaA {
    static constexpr bool PERM = true, AFTER_DRAIN = false;
    unsigned char* ws; LAS unsigned char* ldsE;
    __device__ __forceinline__ void prefetch(const pg8::Unit& u, int wid, int lane) const { ss_prefetch(ws, ldsE, u.pm, wid, lane); }
    __device__ __forceinline__ void operator()(AccRef acc, const pg8::Unit& u, int wr, int wc, int fr_in, int fq_in) const {
        const int lane_e = pg8::lane_id_asm(); const int fr = lane_e & 15, fq = lane_e >> 4; (void)fr_in; (void)fq_in;
        unsigned long long wi_ = (unsigned long long)ws; asm volatile("" : "+s"(wi_)); GAS unsigned char* w = (GAS unsigned char*)wi_;
        const GAS float* ss = (const GAS float*)(w + WS_SS); GAS bf16_t* Aq = (GAS bf16_t*)(w + T_AQ); GAS bf16_t* Akv = (GAS bf16_t*)(w + T_AKV); GAS float* ssq = (GAS float*)(w + WS_SSQ); GAS float* sskv = (GAS float*)(w + WS_SSKV);
        GAS float* sspe = (GAS float*)(w + WS_SSPE); GAS float* kr = (GAS float*)(w + WS_KR); const GAS float* cosT = (const GAS float*)(w + WS_COS); const GAS float* sinT = (const GAS float*)(w + WS_SIN);
        const int rowb = u.pm * 256 + wr * 64 + fr;
        float rs8[8];
        { f32x4 pp[8];
#pragma unroll
          for (int q = 0; q < 8; ++q) pp[q] = *(const LAS f32x4*)(ldsE + ((q >> 2) * 128 + wr * 64 + (q & 3) * 16 + fr) * 64 + fq * 16);
#pragma unroll
          for (int q = 0; q < 8; ++q) rs8[q] = rsqrtf(red_fq((pp[q][0] + pp[q][1]) + (pp[q][2] + pp[q][3])) * (1.0f / 1024.0f) + EPS); }
        EPI_FENCE();
#pragma unroll
        for (int ai = 0; ai < 2; ++ai)
#pragma unroll
            for (int m = 0; m < 4; ++m) {
                const int row = rowb + ai * 128 + m * 16; const float rs = rs8[ai * 4 + m];
                const f32x4 a00 = acc[ai][0][m][0] * rs, a01 = acc[ai][0][m][1] * rs, a10 = acc[ai][1][m][0] * rs, a11 = acc[ai][1][m][1] * rs;
                GAS bf16_t* dst = (u.pn == 0 ? Aq : Akv) + (size_t)row * 256 + wc * 32 + 8 * fq;
                *(GAS u32x4*)(dst) = pack8(a00, a01); *(GAS u32x4*)(dst + 128) = pack8(a10, a11);
                if (u.pn == 0) {
                    const float sq = red_fq(dot4(a00) + dot4(a01) + dot4(a10) + dot4(a11));
                    if (fq == 0) ssq[(size_t)row * 4 + wc] = sq;
                } else {
                    const float sq = red_fq(dot4(a00) + dot4(a01));
                    if (fq == 0) sskv[(size_t)row * 4 + wc] = sq;
                    if (wc == 0) {
                        *(GAS f32x4*)(kr + (size_t)row * 32 + 8 * fq) = a10; *(GAS f32x4*)(kr + (size_t)row * 32 + 8 * fq + 4) = a11;
                    }
                }
                EPI_FENCE();
            }
    }
};

struct EpiQ {
    static constexpr bool PERM = true, AFTER_DRAIN = false;
    unsigned char* ws;
    __device__ __forceinline__ void prefetch(const pg8::Unit&, int, int) const {}
    __device__ __forceinline__ void operator()(AccRef acc, const pg8::Unit& u, int wr, int wc, int fr_in, int fq_in) const {
        const int lane_e = pg8::lane_id_asm(); const int fr = lane_e & 15, fq = lane_e >> 4; (void)fr_in; (void)fq_in;
        unsigned long long wi_ = (unsigned long long)ws; asm volatile("" : "+s"(wi_)); GAS unsigned char* w = (GAS unsigned char*)wi_;
        const GAS float* ssq = (const GAS float*)(w + WS_SSQ); GAS bf16_t* Q = (GAS bf16_t*)(w + T_Q);
        const int rowb = u.pm * 256 + wr * 64 + fr;
        if (wc < 3) {
            float rs8[8];
            { f32x4 pp[8];
#pragma unroll
              for (int q = 0; q < 8; ++q) pp[q] = *(const GAS f32x4*)(ssq + (size_t)(rowb + (q >> 2) * 128 + (q & 3) * 16) * 4);
#pragma unroll
              for (int q = 0; q < 8; ++q) rs8[q] = rsqrtf(((pp[q][0] + pp[q][1]) + (pp[q][2] + pp[q][3])) * (1.0f / 256.0f) + EPS); }
            EPI_FENCE();
#pragma unroll
            for (int ai = 0; ai < 2; ++ai)
#pragma unroll
                for (int m = 0; m < 4; ++m) {
                    const int row = rowb + ai * 128 + m * 16, b = row >> 13, s = row & 8191;
                    const float rq = rs8[ai * 4 + m];
#pragma unroll
                    for (int bj = 0; bj < 2; ++bj) {
                        const int head = u.pn * 2 + bj;
                        *(GAS u32x4*)(Q + (unsigned)(((b * 16 + head) * SEQ + s) * 96 + wc * 32 + 8 * fq)) = pack8(acc[ai][bj][m][0] * rq, acc[ai][bj][m][1] * rq);
                    }
                    EPI_FENCE();
                }
        }
    }
};

struct EpiKV {
    static constexpr bool PERM = true, AFTER_DRAIN = false;
    unsigned char* ws; float* outp;
    __device__ __forceinline__ void prefetch(const pg8::Unit&, int, int) const {}
    __device__ __forceinline__ void operator()(AccRef acc, const pg8::Unit& u, int wr, int wc, int fr_in, int fq_in) const {
        const int lane_e = pg8::lane_id_asm(); const int fr = lane_e & 15, fq = lane_e >> 4; (void)fr_in; (void)fq_in;
        unsigned long long wi_ = (unsigned long long)ws; asm volatile("" : "+s"(wi_)); GAS unsigned char* w = (GAS unsigned char*)wi_;
        const GAS float* sskv = (const GAS float*)(w + WS_SSKV); GAS bf16_t* K = (GAS bf16_t*)(w + T_K); GAS bf16_t* Vt = (GAS bf16_t*)((GAS unsigned char*)(unsigned long long)outp + 64 * MiB);
        const int rowb = u.pm * 256 + wr * 64 + fr;
#pragma unroll
        for (int ai = 0; ai < 2; ++ai)
#pragma unroll
            for (int m = 0; m < 4; ++m) {
                const int row = rowb + ai * 128 + m * 16, b = row >> 13, s = row & 8191;
                const f32x4 pk = *(const GAS f32x4*)(sskv + (size_t)row * 4);
                const float r = rsqrtf(((pk[0] + pk[1]) + (pk[2] + pk[3])) * (1.0f / 128.0f) + EPS);
#pragma unroll
                for (int bj = 0; bj < 2; ++bj) {
                    const int head = u.pn * 2 + bj; const unsigned bh = (unsigned)(b * 16 + head);
                    const u32x4 wv = pack8(acc[ai][bj][m][0] * r, acc[ai][bj][m][1] * r);
                    if (wc < 2) {
                        *(GAS u32x4*)(K + ((bh * SEQ + s) * 96u + wc * 32 + 8 * fq)) = wv;
                    } else {
                        GAS bf16_t* vp = Vt + (bh * 64 + (wc - 2) * 32 + 8 * fq) * SEQ + s;
                        vp[0 * SEQ] = (bf16_t)(wv.x & 0xffff); vp[1 * SEQ] = (bf16_t)(wv.x >> 16); vp[2 * SEQ] = (bf16_t)(wv.y & 0xffff); vp[3 * SEQ] = (bf16_t)(wv.y >> 16);
                        vp[4 * SEQ] = (bf16_t)(wv.z & 0xffff); vp[5 * SEQ] = (bf16_t)(wv.z >> 16); vp[6 * SEQ] = (bf16_t)(wv.w & 0xffff); vp[7 * SEQ] = (bf16_t)(wv.w >> 16);
                    }
                }
                EPI_FENCE();
            }
    }
};

struct EpiSgIn {
    static constexpr bool PERM = true, AFTER_DRAIN = false;
    unsigned char* ws; LAS unsigned char* ldsE;
    __device__ __forceinline__ void prefetch(const pg8::Unit& u, int wid, int lane) const { ss_prefetch(ws, ldsE, u.pm, wid, lane); }
    __device__ __forceinline__ void operator()(AccRef acc, const pg8::Unit& u, int wr, int wc, int fr_in, int fq_in) const {
        const int lane_e = pg8::lane_id_asm(); const int fr = lane_e & 15, fq = lane_e >> 4; (void)fr_in; (void)fq_in;
        unsigned long long wi_ = (unsigned long long)ws; asm volatile("" : "+s"(wi_)); GAS unsigned char* w = (GAS unsigned char*)wi_;
        const GAS float* ss = (const GAS float*)(w + WS_SS); GAS bf16_t* U = (GAS bf16_t*)(w + T_Z); GAS bf16_t* V = (GAS bf16_t*)(w + T_BG); GAS float* ssv = (GAS float*)(w + WS_SSV);
        const int rowb = u.pm * 256 + wr * 64 + fr;
        GAS bf16_t* dstb = (u.pn < 4 ? U + u.pn * 256 : V + (u.pn - 4) * 256) + wc * 32 + 8 * fq;
        float rs8[8];
        { f32x4 pp[8];
#pragma unroll
          for (int q = 0; q < 8; ++q) pp[q] = *(const LAS f32x4*)(ldsE + ((q >> 2) * 128 + wr * 64 + (q & 3) * 16 + fr) * 64 + fq * 16);
#pragma unroll
          for (int q = 0; q < 8; ++q) rs8[q] = rsqrtf(red_fq((pp[q][0] + pp[q][1]) + (pp[q][2] + pp[q][3])) * (1.0f / 1024.0f) + EPS); }
        EPI_FENCE();
#pragma unroll
        for (int ai = 0; ai < 2; ++ai)
#pragma unroll
            for (int m = 0; m < 4; ++m) {
                const int row = rowb + ai * 128 + m * 16; const float rs = rs8[ai * 4 + m]; float sq = 0.f;
#pragma unroll
                for (int bj = 0; bj < 2; ++bj) {
                    f32x4 z0, z1;
#pragma unroll
                    for (int j = 0; j < 4; ++j) { z0[j] = gelu_tanh_f(acc[ai][bj][m][0][j] * rs); z1[j] = gelu_tanh_f(acc[ai][bj][m][1][j] * rs); }
                    *(GAS u32x4*)(dstb + (size_t)row * DM + bj * 128) = pack8(z0, z1);
                    sq += dot4(z0) + dot4(z1);
                }
                if (u.pn >= 4) { sq = red_fq(sq); if (fq == 0) ssv[(size_t)row * 16 + (u.pn - 4) * 4 + wc] = sq; } EPI_FENCE();
            }
    }
};

__device__ __forceinline__ int map_row(int kind, int n0) {
    switch (kind) {
        case 1: return (n0 >> 7) * 256 + (n0 & 127);
        case 2: return (n0 >> 7) * 256 + 128 + (n0 & 127);
        case 3: if (n0 < 1024) return 2048 + n0;
                if (n0 < 2048) { const int c = n0 - 1024; return (c >> 7) * 256 + (c & 127); }
                { const int c = n0 - 2048; return (c >> 7) * 256 + 128 + (c & 127); }
        case 4: return (n0 / 96) * 128 + (n0 % 96);
        default: return n0;
    }
}
__device__ __forceinline__ void tr_item(const float* __restrict__ W, int K, int N, bf16_t* __restrict__ WT, int pitch, const float* __restrict__ scale, int kind, LAS float* scr, int item, int lane) {
    const int nblk = N >> 5, kb = item / nblk, nb = item - kb * nblk, k0 = 64 * kb, n0 = 32 * nb, dr0 = map_row(kind, n0);
    {
        f32x4 v[8]; const int kr_ = lane >> 3, c4 = (lane & 7) * 4;
#pragma unroll
        for (int i = 0; i < 8; ++i) v[i] = *(const f32x4*)(W + (size_t)(k0 + 8 * i + kr_) * N + n0 + c4);
#pragma unroll
        for (int i = 0; i < 8; ++i) { const int kk = 8 * i + kr_; const float sc = scale ? scale[k0 + kk] : 1.0f;
            scr[kk * 33 + c4] = v[i][0] * sc; scr[kk * 33 + c4 + 1] = v[i][1] * sc; scr[kk * 33 + c4 + 2] = v[i][2] * sc; scr[kk * 33 + c4 + 3] = v[i][3] * sc; }
    }
    asm volatile("s_waitcnt lgkmcnt(0)" ::: "memory");
    const int c = lane & 7;
#pragma unroll
    for (int j = 0; j < 4; ++j) { const int n = (lane >> 3) + 8 * j; const LAS float* s = scr + (8 * c) * 33 + n;
        u32x4 o; o.x = cvtpk(s[0 * 33], s[1 * 33]); o.y = cvtpk(s[2 * 33], s[3 * 33]); o.z = cvtpk(s[4 * 33], s[5 * 33]); o.w = cvtpk(s[6 * 33], s[7 * 33]);
        *(u32x4*)(WT + (size_t)(dr0 + n) * pitch + k0 + 8 * c) = o; }
    asm volatile("s_waitcnt lgkmcnt(0)" ::: "memory");
}

struct Args {
    const float* in[22]; float* out; unsigned char* ws; float inv_freq[16]; int ph_lo, ph_hi;
};

__device__ __forceinline__ void prologue(const Args& a, LAS unsigned char* lds, int vcu, int G, int wave, int lane, int tid) {
    unsigned char* ws = a.ws;
    LAS float* scr = (LAS float*)(lds + wave * 16384);
    const int gw = vcu * NWAVES + wave, NGW = G * NWAVES;
    const float* norm_g = a.in[2];
    constexpr int I_FFN = 8 * 4224, I_CONV = 2 * 2048, I_MLA = 1040, I_SG = 1536, NITEMS = I_FFN + I_CONV + I_MLA + I_SG;
    for (int it = gw; it < NITEMS; it += NGW) {
        int r = it;
        if (r < I_FFN) {
            const int f = r / 4224, q = r % 4224, which = q / 1408, item = q % 1408, i = f >> 1, j = f & 1;
            bf16_t* wgu = (bf16_t*)(ws + ffn_w_off(f)); bf16_t* wd = wgu + (size_t)5632 * 1024;
            const float* g = norm_g + (size_t)(i * 3 + (j ? 2 : 0)) * 1024;
            if (which == 0) tr_item(a.in[3] + (size_t)f * 1024 * 2816, 1024, 2816, wgu, 1024, g, 1, scr, item, lane);
            else if (which == 1) tr_item(a.in[4] + (size_t)f * 1024 * 2816, 1024, 2816, wgu, 1024, g, 2, scr, item, lane);
            else tr_item(a.in[5] + (size_t)f * 2816 * 1024, 2816, 1024, wd, 2816, nullptr, 0, scr, item, lane);
            continue;
        }
        r -= I_FFN;
        if (r < I_CONV) {
            const int ia = r / 2048, q = r % 2048, li = ia == 0 ? 0 : 3;
            bf16_t* win = (bf16_t*)(ws + conv_w_off(ia)); bf16_t* wout = win + (size_t)3072 * 1024;
            if (q < 1536) tr_item(a.in[6] + (size_t)ia * 1024 * 3072, 1024, 3072, win, 1024, norm_g + (size_t)(li * 3 + 1) * 1024, 3, scr, q, lane);
            else tr_item(a.in[8] + (size_t)ia * 1024 * 1024, 1024, 1024, wout, 1024, nullptr, 0, scr, q - 1536, lane);
            continue;
        }
        r -= I_CONV;
        if (r < I_MLA) {
            if (r < 208) { tr_item(a.in[9], 1024, 416, (bf16_t*)(ws + W_MLA_A), 1024, norm_g + (size_t)(1 * 3 + 1) * 1024, 0, scr, r, lane); continue; }
            r -= 208;
            if (r < 192) { tr_item(a.in[11], 256, 1536, (bf16_t*)(ws + W_MLA_UQ), 256, a.in[10], 4, scr, r, lane); continue; }
            r -= 192;
            if (r < 128) { tr_item(a.in[13], 128, 2048, (bf16_t*)(ws + W_MLA_UKV), 256, a.in[12], 0, scr, r, lane); continue; }
            r -= 128;
            tr_item(a.in[16], 1024, 1024, (bf16_t*)(ws + W_MLA_O), 1024, nullptr, 0, scr, r, lane);
            continue;
        }
        r -= I_MLA;
        if (r < 1024) tr_item(a.in[17], 1024, 2048, (bf16_t*)(ws + W_SG_IN), 1024, norm_g + (size_t)(2 * 3 + 1) * 1024, 0, scr, r, lane);
        else tr_item(a.in[21], 1024, 1024, (bf16_t*)(ws + W_SG_OUT), 1024, nullptr, 0, scr, r - 1024, lane);
    }
    const int gt = vcu * NTHREADS + tid, NGT = G * NTHREADS;
    const u32x4 z4 = {0u, 0u, 0u, 0u};
    for (int p = gt; p < 12288; p += NGT) *(u32x4*)(ws + W_MLA_A + (size_t)416 * 2048 + (size_t)p * 16) = z4;
    for (int p = gt; p < 16384; p += NGT) { const int h = p >> 10, off = p & 1023; *(u32x4*)(ws + W_MLA_UQ + (size_t)(128 * h + 96) * 512 + (size_t)off * 16) = z4; }
    for (int p = gt; p < 32768; p += NGT) { const int row = p >> 4, c = p & 15; *(u32x4*)(ws + W_MLA_UKV + (size_t)row * 512 + 256 + c * 16) = z4; }
    for (int p = gt; p < 16384; p += NGT) {
        const int t = (p >> 4) & 127, s0 = (p & 15) * 8; const float* src = a.in[19] + (size_t)p * 8;
        const f32x4 w0 = *(const f32x4*)src, w1 = *(const f32x4*)(src + 4); f32x4 m0, m1;
#pragma unroll
        for (int j = 0; j < 4; ++j) { m0[j] = (s0 + j <= t) ? w0[j] : 0.f; m1[j] = (s0 + 4 + j <= t) ? w1[j] : 0.f; }
        *(u32x4*)(ws + W_SG_S + (size_t)p * 16) = pack8(m0, m1);
    }
    {
        const int* pos = (const int*)a.in[1]; float* cosT = (float*)(ws + WS_COS); float* sinT = (float*)(ws + WS_SIN);
        for (int p = gt; p < M_TOK * 16; p += NGT) {
            const int row = p >> 4, i = p & 15; const float ang = (float)pos[row] * a.inv_freq[i];
            const double ad = (double)ang, k = rint(ad * 0.15915494309189535); const float rr = (float)(ad - k * 6.283185307179586);
            cosT[p] = cosf(rr); sinT[p] = sinf(rr);
        }
    }
    {
        const float* x = a.in[0]; bf16_t* xb = (bf16_t*)(ws + WS_XB); float* ss = (float*)(ws + WS_SS);
        for (int row = gw; row < M_TOK; row += NGW) {
            const f32x4* xr = (const f32x4*)(x + (size_t)row * DM) + lane; f32x4 v[4]; float s = 0.f;
#pragma unroll
            for (int j = 0; j < 4; ++j) { v[j] = xr[64 * j]; s += dot4(v[j]); }
            s = wave_sum(s);
            u32x2* o = (u32x2*)(xb + (size_t)row * DM) + lane;
#pragma unroll
            for (int j = 0; j < 4; ++j) { u32x2 w; w.x = cvtpk(v[j][0], v[j][1]); w.y = cvtpk(v[j][2], v[j][3]); o[64 * j] = w; }
            if (lane < 16) ss[(size_t)row * 16 + lane] = lane == 0 ? s : 0.f;
        }
    }
}

__device__ __forceinline__ void unpack8(u32x4 w, float (&f)[8]) { f[0] = bf_lo(w.x); f[1] = bf_hi(w.x); f[2] = bf_lo(w.y); f[3] = bf_hi(w.y); f[4] = bf_lo(w.z); f[5] = bf_hi(w.z); f[6] = bf_lo(w.w); f[7] = bf_hi(w.w); }
__device__ __forceinline__ void conv_phase(const bf16_t* __restrict__ Z, const bf16_t* __restrict__ Bg, const float* __restrict__ ck, bf16_t* __restrict__ Gout, int gt, int NGT) {
    for (int it = gt; it < 2048 * 128; it += NGT) {
        const int cg8 = (it & 127) * 8, row0 = (it >> 7) * 16;
        float k0[8], k1[8], k2[8], zm2[8], zm1[8];
        { const f32x4 a0 = *(const f32x4*)(ck + cg8), a1 = *(const f32x4*)(ck + cg8 + 4), b0 = *(const f32x4*)(ck + 1024 + cg8), b1 = *(const f32x4*)(ck + 1024 + cg8 + 4), c0 = *(const f32x4*)(ck + 2048 + cg8), c1 = *(const f32x4*)(ck + 2048 + cg8 + 4);
#pragma unroll
          for (int j = 0; j < 4; ++j) { k0[j] = a0[j]; k0[4 + j] = a1[j]; k1[j] = b0[j]; k1[4 + j] = b1[j]; k2[j] = c0[j]; k2[4 + j] = c1[j]; } }
        if ((row0 & 8191) == 0) {
#pragma unroll
            for (int j = 0; j < 8; ++j) { zm2[j] = 0.f; zm1[j] = 0.f; }
        } else {
            unpack8(*(const u32x4*)(Z + (size_t)(row0 - 2) * DM + cg8), zm2); unpack8(*(const u32x4*)(Z + (size_t)(row0 - 1) * DM + cg8), zm1);
        }
#pragma unroll 4
        for (int r = 0; r < 16; ++r) {
            const size_t off = (size_t)(row0 + r) * DM + cg8; float z[8], b[8]; f32x4 o0, o1;
            unpack8(*(const u32x4*)(Z + off), z); unpack8(*(const u32x4*)(Bg + off), b);
#pragma unroll
            for (int j = 0; j < 4; ++j) { o0[j] = b[j] * (k0[j] * zm2[j] + k1[j] * zm1[j] + k2[j] * z[j]); o1[j] = b[4 + j] * (k0[4 + j] * zm2[4 + j] + k1[4 + j] * zm1[4 + j] + k2[4 + j] * z[4 + j]); }
            *(u32x4*)(Gout + off) = pack8(o0, o1);
#pragma unroll
            for (int j = 0; j < 8; ++j) { zm2[j] = zm1[j]; zm1[j] = z[j]; }
        }
    }
}

__device__ __forceinline__ void sg_phase(LAS unsigned char* lds, const bf16_t* __restrict__ U, const bf16_t* __restrict__ V, const float* __restrict__ ssv, const float* __restrict__ vnorm,
                                         const bf16_t* __restrict__ wsm, const float* __restrict__ bs, bf16_t* __restrict__ G2, int vcu, int G, const int wave_s) {
    constexpr int ROWB = 272, BOFF = 128 * ROWB;
    const int lane = pg8::lane_id_asm(), wid = wave_s, tid = wid * 64 + lane, fr = lane & 15, fq = lane >> 4;
    for (int u = vcu; u < 2048; u += G) {
        const int c = u >> 3, g = u & 7;
        for (int p = tid; p < 2048; p += NTHREADS) { const int t = p >> 4, cc = p & 15; *(LAS u32x4*)(lds + t * ROWB + cc * 16) = *(const u32x4*)(wsm + (size_t)g * 16384 + t * 128 + cc * 8); }
        for (int p = tid; p < 2048; p += NTHREADS) {
            const int s = p >> 4, cg8 = (p & 15) * 8, row = 128 * c + s;
            float v[8]; unpack8(*(const u32x4*)(V + (size_t)row * DM + 128 * g + cg8), v);
            const f32x4* sp = (const f32x4*)(ssv + (size_t)row * 16); const f32x4 a0 = sp[0], a1 = sp[1], a2 = sp[2], a3 = sp[3];
            const float tot = ((a0[0] + a0[1]) + (a0[2] + a0[3])) + ((a1[0] + a1[1]) + (a1[2] + a1[3])) + ((a2[0] + a2[1]) + (a2[2] + a2[3])) + ((a3[0] + a3[1]) + (a3[2] + a3[3]));
            const float rsv = rsqrtf(tot * (1.0f / 1024.0f) + EPS);
            const f32x4 n0 = *(const f32x4*)(vnorm + 128 * g + cg8), n1 = *(const f32x4*)(vnorm + 128 * g + cg8 + 4);
#pragma unroll
            for (int j = 0; j < 4; ++j) {
                const unsigned w = cvtpk(v[j] * rsv * n0[j], v[4 + j] * rsv * n1[j]);
                *(LAS bf16_t*)(lds + BOFF + (cg8 + j) * ROWB + s * 2) = (bf16_t)(w & 0xffff);
                *(LAS bf16_t*)(lds + BOFF + (cg8 + 4 + j) * ROWB + s * 2) = (bf16_t)(w >> 16);
            }
        }
        __syncthreads();
        f32x4 acc[8];
#pragma unroll
        for (int nb = 0; nb < 8; ++nb) acc[nb] = (f32x4){0.f, 0.f, 0.f, 0.f};
#pragma unroll
        for (int ks = 0; ks < 4; ++ks) {
            const bf16x8 wa = *(const LAS bf16x8*)(lds + (16 * wid + fr) * ROWB + (32 * ks + 8 * fq) * 2);
#pragma unroll
            for (int nb = 0; nb < 8; ++nb) {
                const bf16x8 vb = *(const LAS bf16x8*)(lds + BOFF + (16 * nb + fr) * ROWB + (32 * ks + 8 * fq) * 2);
                acc[nb] = __builtin_amdgcn_mfma_f32_16x16x32_bf16(vb, wa, acc[nb], 0, 0, 0);
            }
        }
        {
            const int t = 16 * wid + fr, row = 128 * c + t; const float bias = bs[g * 128 + t];
#pragma unroll
            for (int nb = 0; nb < 8; ++nb) {
                const size_t off = (size_t)row * DM + 128 * g + 16 * nb + 4 * fq;
                const u32x2 uu = *(const u32x2*)(U + off);
                u32x2 o; o.x = cvtpk(bf_lo(uu.x) * (acc[nb][0] + bias), bf_hi(uu.x) * (acc[nb][1] + bias)); o.y = cvtpk(bf_lo(uu.y) * (acc[nb][2] + bias), bf_hi(uu.y) * (acc[nb][3] + bias));
                *(u32x2*)(G2 + off) = o;
            }
        }
        __syncthreads();
    }
}

__device__ __forceinline__ void qk_finalize(bf16_t* __restrict__ Q, bf16_t* __restrict__ K, const float* __restrict__ kpe, const float* __restrict__ qgain, const float* __restrict__ kgain,
                                            const float* __restrict__ cosT, const float* __restrict__ sinT, int gt, int NGT) {
    for (int it = 16 * M_TOK + gt; it < 2 * 16 * M_TOK; it += NGT) {
        const bool isk = it >= 16 * M_TOK; const int rh = isk ? it - 16 * M_TOK : it;
        const int bh = rh >> 13, s = rh & 8191, row = (bh >> 4) * SEQ + s;
        bf16_t* p = (isk ? K : Q) + (size_t)rh * 96; const float* gain = isk ? kgain : qgain;
        float v[96];
        if (!isk) {
#pragma unroll
            for (int c = 0; c < 12; ++c) { const u32x4 w = *(const u32x4*)(p + 8 * c); v[8 * c] = bf_lo(w.x); v[8 * c + 1] = bf_hi(w.x); v[8 * c + 2] = bf_lo(w.y); v[8 * c + 3] = bf_hi(w.y); v[8 * c + 4] = bf_lo(w.z); v[8 * c + 5] = bf_hi(w.z); v[8 * c + 6] = bf_lo(w.w); v[8 * c + 7] = bf_hi(w.w); }
        } else {
#pragma unroll
            for (int c = 0; c < 8; ++c) { const u32x4 w = *(const u32x4*)(p + 8 * c); v[8 * c] = bf_lo(w.x); v[8 * c + 1] = bf_hi(w.x); v[8 * c + 2] = bf_lo(w.y); v[8 * c + 3] = bf_hi(w.y); v[8 * c + 4] = bf_lo(w.z); v[8 * c + 5] = bf_hi(w.z); v[8 * c + 6] = bf_lo(w.w); v[8 * c + 7] = bf_hi(w.w); }
#pragma unroll
            for (int c = 0; c < 8; ++c) { const f32x4 w = *(const f32x4*)(kpe + (size_t)row * 32 + 4 * c); v[64 + 4 * c] = w[0]; v[64 + 4 * c + 1] = w[1]; v[64 + 4 * c + 2] = w[2]; v[64 + 4 * c + 3] = w[3]; }
        }
        float ss = 0.f;
#pragma unroll
        for (int d = 0; d < 96; ++d) ss += v[d] * v[d];
        const float rsh = rsqrtf(ss * (1.0f / 96.0f) + EPS), osc = isk ? 1.0f : QSCALE;
#pragma unroll
        for (int d = 0; d < 96; ++d) v[d] *= rsh * gain[d];
#pragma unroll
        for (int c = 0; c < 4; ++c) {
            const f32x4 cs = *(const f32x4*)(cosT + (size_t)row * 16 + 4 * c), sn = *(const f32x4*)(sinT + (size_t)row * 16 + 4 * c);
#pragma unroll
            for (int j = 0; j < 4; ++j) { const int i = 4 * c + j; const float t1 = v[64 + i], t2 = v[80 + i]; v[64 + i] = t1 * cs[j] - t2 * sn[j]; v[80 + i] = t2 * cs[j] + t1 * sn[j]; }
        }
#pragma unroll
        for (int c = 0; c < 12; ++c) {
            u32x4 w; w.x = cvtpk(v[8 * c] * osc, v[8 * c + 1] * osc); w.y = cvtpk(v[8 * c + 2] * osc, v[8 * c + 3] * osc); w.z = cvtpk(v[8 * c + 4] * osc, v[8 * c + 5] * osc); w.w = cvtpk(v[8 * c + 6] * osc, v[8 * c + 7] * osc);
            *(u32x4*)(p + 8 * c) = w;
        }
    }
}

__device__ __forceinline__ float max3f_(float a, float b, float c) { return __builtin_fmaxf(__builtin_fmaxf(a, b), c); }
struct AttRegs { u32x4 k0, k1, v; };
#define ATT_BAR() asm volatile("s_waitcnt lgkmcnt(0)\n\ts_barrier" ::: "memory")
__device__ __forceinline__ void att_qk(const LAS unsigned char* kb, const bf16x8 (&qf)[6], f32x16& p0, f32x16& p1) {
    constexpr int KROW = 208;
    bf16x8 kf[12];
#pragma unroll
    for (int ds = 0; ds < 6; ++ds) { kf[2 * ds] = *(const LAS bf16x8*)(kb + ds * 32); kf[2 * ds + 1] = *(const LAS bf16x8*)(kb + 32 * KROW + ds * 32); }
#pragma unroll
    for (int r = 0; r < 16; ++r) { p0[r] = 0.f; p1[r] = 0.f; }
    __builtin_amdgcn_sched_barrier(0);
#pragma unroll
    for (int ds = 0; ds < 6; ++ds) {
        p0 = __builtin_amdgcn_mfma_f32_32x32x16_bf16(kf[2 * ds], qf[ds], p0, 0, 0, 0);
        p1 = __builtin_amdgcn_mfma_f32_32x32x16_bf16(kf[2 * ds + 1], qf[ds], p1, 0, 0, 0);
    }
    __builtin_amdgcn_sched_barrier(0);
}
template <bool NOMAX> __device__ __forceinline__ void att_soft_pv(const LAS unsigned char* vb, f32x16& p0, f32x16& p1, f32x16& o0, f32x16& o1, float& m_ref, float& l_run, int t, int qw0, int qabs, int hi) {
    constexpr int VROW = 136; constexpr float THR = 8.0f;
    s16x4 va[8], vb2[8];
#pragma unroll
    for (int ks = 0; ks < 4; ++ks) {
        va[2 * ks] = *(const LAS s16x4*)(vb + ks * 32); vb2[2 * ks] = *(const LAS s16x4*)(vb + ks * 32 + 16);
        va[2 * ks + 1] = *(const LAS s16x4*)(vb + 32 * VROW + ks * 32); vb2[2 * ks + 1] = *(const LAS s16x4*)(vb + 32 * VROW + ks * 32 + 16);
    }
    __builtin_amdgcn_sched_barrier(0);
    if (64 * t + 63 > qw0) {
        asm volatile("" ::: "memory");
#pragma unroll
        for (int r = 0; r < 16; ++r) { const int kv = 64 * t + (r & 3) + 8 * (r >> 2) + 4 * hi; if (kv > qabs) p0[r] = -INFINITY; if (kv + 32 > qabs) p1[r] = -INFINITY; }
    }
    if constexpr (!NOMAX) {
        float ma = max3f_(p0[0], p0[1], p1[0]), mb = max3f_(p0[2], p0[3], p1[1]); ma = max3f_(ma, p1[2], p1[3]);
#pragma unroll
        for (int r = 4; r < 16; r += 4) { ma = max3f_(ma, p0[r], p0[r + 1]); mb = max3f_(mb, p0[r + 2], p0[r + 3]); ma = max3f_(ma, p1[r], p1[r + 1]); mb = max3f_(mb, p1[r + 2], p1[r + 3]); }
        float mx = __builtin_fmaxf(ma, mb);
        { auto rr = __builtin_amdgcn_permlane32_swap(__float_as_uint(mx), __float_as_uint(mx), false, false); mx = __builtin_fmaxf(__uint_as_float(rr[0]), __uint_as_float(rr[1])); }
        if (__any(mx > m_ref + THR)) {
            const float mnew = __builtin_fmaxf(m_ref, mx), alpha = __builtin_amdgcn_exp2f(m_ref - mnew); m_ref = mnew; l_run *= alpha;
            o0 = o0 * alpha; o1 = o1 * alpha;
        }
        { const float negm = -m_ref; p0 = p0 + negm; p1 = p1 + negm; }
    }
#pragma unroll
    for (int r = 0; r < 16; ++r) { p0[r] = __builtin_amdgcn_exp2f(p0[r]); p1[r] = __builtin_amdgcn_exp2f(p1[r]); }
    { const f32x16 sv = p0 + p1; l_run += ((sv[0] + sv[1]) + (sv[2] + sv[3])) + ((sv[4] + sv[5]) + (sv[6] + sv[7])) + ((sv[8] + sv[9]) + (sv[10] + sv[11])) + ((sv[12] + sv[13]) + (sv[14] + sv[15])); }
    u32x4 pb[4];
    pb[0] = (u32x4){cvtpk(p0[0], p0[1]), cvtpk(p0[2], p0[3]), cvtpk(p0[4], p0[5]), cvtpk(p0[6], p0[7])};
    pb[1] = (u32x4){cvtpk(p0[8], p0[9]), cvtpk(p0[10], p0[11]), cvtpk(p0[12], p0[13]), cvtpk(p0[14], p0[15])};
    pb[2] = (u32x4){cvtpk(p1[0], p1[1]), cvtpk(p1[2], p1[3]), cvtpk(p1[4], p1[5]), cvtpk(p1[6], p1[7])};
    pb[3] = (u32x4){cvtpk(p1[8], p1[9]), cvtpk(p1[10], p1[11]), cvtpk(p1[12], p1[13]), cvtpk(p1[14], p1[15])};
    __builtin_amdgcn_sched_barrier(0);
#pragma unroll
    for (int ks = 0; ks < 4; ++ks) {
        const bf16x8 pf = __builtin_bit_cast(bf16x8, pb[ks]);
        { const s16x4 a = va[2 * ks], b = vb2[2 * ks];
          const bf16x8 vf = {a[0], a[1], a[2], a[3], b[0], b[1], b[2], b[3]};
          o0 = __builtin_amdgcn_mfma_f32_32x32x16_bf16(vf, pf, o0, 0, 0, 0); }
        { const s16x4 a = va[2 * ks + 1], b = vb2[2 * ks + 1];
          const bf16x8 vf = {a[0], a[1], a[2], a[3], b[0], b[1], b[2], b[3]};
          o1 = __builtin_amdgcn_mfma_f32_32x32x16_bf16(vf, pf, o1, 0, 0, 0); }
    }
}
struct AttK { u32x4 k0, k1; };
template <bool NOMAX> __device__ __forceinline__ void attn_units(LAS unsigned char* lds, const bf16_t* __restrict__ Q, const bf16_t* __restrict__ K, const bf16_t* __restrict__ Vt, bf16_t* __restrict__ O, const float* __restrict__ qgain, const float* __restrict__ cosT, const float* __restrict__ sinT, int vcu, int G, const int wave_s) {
    constexpr int KROW = 208, VROW = 136, KBUF = 64 * KROW, VBUF = 64 * VROW, VOFF = 2 * KBUF;
    const int lane = pg8::lane_id_asm(), wid = wave_s, tid = wid * 64 + lane, r32 = lane & 31, hi = lane >> 5;
    const int kp0r = tid / 12, kp0c = tid % 12, kp1r = (512 + tid) / 12, kp1c = (512 + tid) % 12, vdv = tid >> 3, vc = tid & 7;
    for (int u = vcu; u < 2048; u += G) {
        const int v = u & 255, i = u >> 8, bh = v >> 2, s4 = v & 3, pr = i >> 1, qb = (i & 1) ? 8 * pr + 7 - s4 : 8 * pr + s4;
        const int q0 = qb * 256, NT = (q0 + 256) / 64, qw0 = q0 + 32 * wid, qabs = qw0 + r32;
        const bf16_t* Qp = Q + ((size_t)bh * SEQ + qabs) * 96 + 8 * hi;
        bf16x8 qf[6];
#pragma unroll
        for (int ds = 0; ds < 6; ++ds) qf[ds] = *(const bf16x8*)(Qp + 16 * ds);
        {
            float ssq_ = 0.f;
#pragma unroll
            for (int ds = 0; ds < 6; ++ds) { const u32x4 w = __builtin_bit_cast(u32x4, qf[ds]);
                const float a0 = bf_lo(w.x), a1 = bf_hi(w.x), a2 = bf_lo(w.y), a3 = bf_hi(w.y), a4 = bf_lo(w.z), a5 = bf_hi(w.z), a6 = bf_lo(w.w), a7 = bf_hi(w.w);
                ssq_ += ((a0 * a0 + a1 * a1) + (a2 * a2 + a3 * a3)) + ((a4 * a4 + a5 * a5) + (a6 * a6 + a7 * a7)); }
            { auto rr = __builtin_amdgcn_permlane32_swap(__float_as_uint(ssq_), __float_as_uint(ssq_), false, false); ssq_ = __uint_as_float(rr[0]) + __uint_as_float(rr[1]); }
            float rq = rsqrtf(ssq_ * (1.0f / 96.0f) + EPS) * QSCALE; asm volatile("" : "+v"(rq));
#pragma unroll
            for (int ds = 0; ds < 6; ++ds) asm volatile("" : "+v"(qf[ds]));
#pragma unroll
            for (int ds = 0; ds < 4; ++ds) {
                const u32x4 w = __builtin_bit_cast(u32x4, qf[ds]);
                const f32x4 g0 = *(const f32x4*)(qgain + 16 * ds + 8 * hi), g1 = *(const f32x4*)(qgain + 16 * ds + 8 * hi + 4);
                u32x4 o; o.x = cvtpk(bf_lo(w.x) * g0[0] * rq, bf_hi(w.x) * g0[1] * rq); o.y = cvtpk(bf_lo(w.y) * g0[2] * rq, bf_hi(w.y) * g0[3] * rq);
                o.z = cvtpk(bf_lo(w.z) * g1[0] * rq, bf_hi(w.z) * g1[1] * rq); o.w = cvtpk(bf_lo(w.w) * g1[2] * rq, bf_hi(w.w) * g1[3] * rq);
                qf[ds] = __builtin_bit_cast(bf16x8, o);
                asm volatile("" ::: "memory");
            }
            {
                const u32x4 w1 = __builtin_bit_cast(u32x4, qf[4]), w2 = __builtin_bit_cast(u32x4, qf[5]);
                const size_t trow = (size_t)((bh >> 4) * SEQ + qabs) * 16 + 8 * hi;
                u32x4 p1, p2;
                {   const f32x4 ga = *(const f32x4*)(qgain + 64 + 8 * hi), gb = *(const f32x4*)(qgain + 80 + 8 * hi), c = *(const f32x4*)(cosT + trow), sn = *(const f32x4*)(sinT + trow);
                    const f32x4 t1 = {bf_lo(w1.x) * ga[0], bf_hi(w1.x) * ga[1], bf_lo(w1.y) * ga[2], bf_hi(w1.y) * ga[3]}, t2 = {bf_lo(w2.x) * gb[0], bf_hi(w2.x) * gb[1], bf_lo(w2.y) * gb[2], bf_hi(w2.y) * gb[3]};
                    const f32x4 o1 = (t1 * c - t2 * sn) * rq, o2 = (t2 * c + t1 * sn) * rq;
                    p1.x = cvtpk(o1[0], o1[1]); p1.y = cvtpk(o1[2], o1[3]); p2.x = cvtpk(o2[0], o2[1]); p2.y = cvtpk(o2[2], o2[3]); }
                asm volatile("" ::: "memory");
                {   const f32x4 ga = *(const f32x4*)(qgain + 64 + 8 * hi + 4), gb = *(const f32x4*)(qgain + 80 + 8 * hi + 4), c = *(const f32x4*)(cosT + trow + 4), sn = *(const f32x4*)(sinT + trow + 4);
                    const f32x4 t1 = {bf_lo(w1.z) * ga[0], bf_hi(w1.z) * ga[1], bf_lo(w1.w) * ga[2], bf_hi(w1.w) * ga[3]}, t2 = {bf_lo(w2.z) * gb[0], bf_hi(w2.z) * gb[1], bf_lo(w2.w) * gb[2], bf_hi(w2.w) * gb[3]};
                    const f32x4 o1 = (t1 * c - t2 * sn) * rq, o2 = (t2 * c + t1 * sn) * rq;
                    p1.z = cvtpk(o1[0], o1[1]); p1.w = cvtpk(o1[2], o1[3]); p2.z = cvtpk(o2[0], o2[1]); p2.w = cvtpk(o2[2], o2[3]); }
                qf[4] = __builtin_bit_cast(bf16x8, p1); qf[5] = __builtin_bit_cast(bf16x8, p2);
            }
        }
        const bf16_t* Kb = K + (size_t)bh * SEQ * 96; const bf16_t* Vb = Vt + (size_t)bh * 64 * SEQ + (size_t)vdv * SEQ + vc * 8;
        AttK Kx; Kx.k1 = (u32x4){0u, 0u, 0u, 0u}; u32x4 Vx;
#define LDK(R, t) do { const bf16_t* kt_ = Kb + (size_t)(t) * 6144; R.k0 = *(const u32x4*)(kt_ + tid * 8); if (tid < 256) R.k1 = *(const u32x4*)(kt_ + (512 + tid) * 8); } while (0)
#define LDV(R, t) do { R = *(const u32x4*)(Vb + (t) * 64); } while (0)
#define STK(R, sl) do { LAS unsigned char* kb_ = lds + (sl) * KBUF; *(LAS u32x4*)(kb_ + kp0r * KROW + kp0c * 16) = R.k0; if (tid < 256) *(LAS u32x4*)(kb_ + kp1r * KROW + kp1c * 16) = R.k1; } while (0)
#define STV(R, sl) do { LAS unsigned char* vb_ = lds + VOFF + (sl) * VBUF + vdv * VROW + vc * 16; *(LAS u32x2*)(vb_) = (u32x2){R.x, R.y}; *(LAS u32x2*)(vb_ + 8) = (u32x2){R.z, R.w}; } while (0)
#define ACT(t) (64 * (t) <= qw0 + 31)
        float m_ref = -INFINITY, l_run = 0.f; f32x16 o0, o1, sA0, sA1, sB0, sB1;
#pragma unroll
        for (int r = 0; r < 16; ++r) { o0[r] = 0.f; o1[r] = 0.f; }
        const LAS unsigned char* kbase = lds + r32 * KROW + hi * 16; const LAS unsigned char* vbase = lds + VOFF + r32 * VROW + hi * 8;
        LDK(Kx, 0); LDV(Vx, 0); STK(Kx, 0); STV(Vx, 0); LDK(Kx, 1); STK(Kx, 1);
        ATT_BAR();
        att_qk(kbase, qf, sA0, sA1);
        ATT_BAR();
        for (int t = 0; t < NT; t += 2) {
            if (t + 2 < NT) LDK(Kx, t + 2);
            LDV(Vx, t + 1);
            if (ACT(t + 1)) att_qk(kbase + KBUF, qf, sB0, sB1);
            if (ACT(t)) att_soft_pv<NOMAX>(vbase, sA0, sA1, o0, o1, m_ref, l_run, t, qw0, qabs, hi);
            if (t + 2 < NT) STK(Kx, 0);
            STV(Vx, 1);
            ATT_BAR();
            if (t + 3 < NT) LDK(Kx, t + 3);
            if (t + 2 < NT) LDV(Vx, t + 2);
            if (t + 2 < NT && ACT(t + 2)) att_qk(kbase, qf, sA0, sA1);
            if (ACT(t + 1)) att_soft_pv<NOMAX>(vbase + VBUF, sB0, sB1, o0, o1, m_ref, l_run, t + 1, qw0, qabs, hi);
            if (t + 3 < NT) STK(Kx, 1);
            if (t + 2 < NT) STV(Vx, 0);
            ATT_BAR();
        }
        {
            float lt = l_run; { auto rr = __builtin_amdgcn_permlane32_swap(__float_as_uint(lt), __float_as_uint(lt), false, false); lt = __uint_as_float(rr[0]) + __uint_as_float(rr[1]); }
            const float inv = 1.0f / lt;
            const int b = bh >> 4, h = bh & 15;
            bf16_t* Op = O + ((size_t)(b * SEQ + qabs)) * DM + h * 64 + 4 * hi;
#pragma unroll
            for (int rg = 0; rg < 4; ++rg) {
                u32x2 w0; w0.x = cvtpk(o0[4 * rg] * inv, o0[4 * rg + 1] * inv); w0.y = cvtpk(o0[4 * rg + 2] * inv, o0[4 * rg + 3] * inv);
                u32x2 w1; w1.x = cvtpk(o1[4 * rg] * inv, o1[4 * rg + 1] * inv); w1.y = cvtpk(o1[4 * rg + 2] * inv, o1[4 * rg + 3] * inv);
                *(u32x2*)(Op + 8 * rg) = w0; *(u32x2*)(Op + 32 + 8 * rg) = w1;
            }
        }
    }
#undef LDK
#undef LDV
#undef STK
#undef STV
#undef ACT
}
__device__ __forceinline__ void attn_phase(LAS unsigned char* lds, const bf16_t* __restrict__ Q, const bf16_t* __restrict__ K, const bf16_t* __restrict__ Vt, bf16_t* __restrict__ O, const float* __restrict__ qgain, const float* __restrict__ kgain, const float* __restrict__ cosT, const float* __restrict__ sinT, int vcu, int G, const int wave_s) {
    bool fast;
    { const int lane = pg8::lane_id_asm(); float gq = fabsf(qgain[lane]), gk = fabsf(kgain[lane]);
      if (lane < 32) { gq = fmaxf(gq, fabsf(qgain[64 + lane])); gk = fmaxf(gk, fabsf(kgain[64 + lane])); }
#pragma unroll
      for (int o = 1; o < 64; o <<= 1) { gq = fmaxf(gq, __shfl_xor(gq, o)); gk = fmaxf(gk, __shfl_xor(gk, o)); }
      fast = __builtin_amdgcn_readfirstlane((int)(14.14f * gq * gk < 60.0f)) != 0; }
    if (fast) attn_units<true>(lds, Q, K, Vt, O, qgain, cosT, sinT, vcu, G, wave_s); else attn_units<false>(lds, Q, K, Vt, O, qgain, cosT, sinT, vcu, G, wave_s);
    __builtin_amdgcn_s_waitcnt(0);
    {
    }
}

#define RLX_AGENT __ATOMIC_RELAXED, __HIP_MEMORY_SCOPE_AGENT
#define LDS_WAIT() asm volatile("s_waitcnt lgkmcnt(0)" ::: "memory")
#define VM_WAIT() asm volatile("s_waitcnt vmcnt(0)" ::: "memory")
__device__ __forceinline__ unsigned long long rt() { return __builtin_amdgcn_s_memrealtime(); }
__device__ __forceinline__ unsigned f2bf(float f) { unsigned u = __builtin_bit_cast(unsigned, f); return (u + 0x7fffu + ((u >> 16) & 1u)) >> 16; }
__device__ __forceinline__ unsigned pk2(float lo, float hi) { return f2bf(lo) | (f2bf(hi) << 16); }

#define XB_TMO      128
#define XB_XCNT(j)  (256  + 64 * (j))
#define XB_XSUB(j)  (1280 + 64 * (j))
#define XB_XGEN(j)  (2304 + 64 * (j))
#define XB_TOP      3328
#define XB_TOPGEN   3392
#define XCD_BAR_WORDS 3456
#define XB_SPIN_CAP (1u << 18)

__device__ __forceinline__ unsigned xb_ld(unsigned* p)              { return __hip_atomic_load(p, __ATOMIC_RELAXED, __HIP_MEMORY_SCOPE_AGENT); }
__device__ __forceinline__ unsigned xb_add(unsigned* p, unsigned v) { return __hip_atomic_fetch_add(p, v, __ATOMIC_RELAXED, __HIP_MEMORY_SCOPE_AGENT); }
__device__ __forceinline__ unsigned xb_xcc_id() { return (unsigned)__builtin_amdgcn_s_getreg((3 << 11) | 20) & 0xFu; }
#define XB_SPIN(cond, bar) do { unsigned _sp = 0; while (cond) { __builtin_amdgcn_s_sleep(1); \
    if ((++_sp & 255u) == 0u) { if (xb_ld(&(bar)[XB_TMO])) break; if (_sp > XB_SPIN_CAP) { atomicAdd(&(bar)[XB_TMO], 1u); break; } } } } while (0)

struct XcdBarrier {
    unsigned* bar; unsigned x;
    volatile LAS unsigned* st;
};

__device__ __forceinline__ XcdBarrier xcd_barrier_post(unsigned* bar, volatile LAS unsigned* st) {
    XcdBarrier b; b.bar = bar; b.x = xb_xcc_id(); b.st = st;
    if (threadIdx.x == 0) (void)xb_add(&bar[XB_XCNT(b.x)], 1u);
    return b;
}
__device__ __forceinline__ void xcd_barrier_complete(unsigned* bar, unsigned x, unsigned& nloc, unsigned& nx) {
    const unsigned G = gridDim.x * gridDim.y * gridDim.z;
    unsigned sum, cnt, mine, sp = 0u;
    for (;;) {
        sum = 0u; cnt = 0u; mine = 0u;
#pragma unroll
        for (unsigned j = 0; j < 16; ++j) { const unsigned c = xb_ld(&bar[XB_XCNT(j)]); sum += c; cnt += (c > 0u) ? 1u : 0u; mine = (j == x) ? c : mine; }
        if (sum == G) break;
        __builtin_amdgcn_s_sleep(1);
        if ((++sp & 255u) == 0u) { if (xb_ld(&bar[XB_TMO])) break; if (sp > XB_SPIN_CAP) { atomicAdd(&bar[XB_TMO], 1u); break; } }
    }
    nloc = mine > 0u ? mine : 1u; nx = cnt > 0u ? cnt : 1u;
}

__device__ __forceinline__ void xcd_barrier(const XcdBarrier& b) {
    asm volatile("s_waitcnt vmcnt(0)" ::: "memory");
    __syncthreads();
    if (threadIdx.x == 0) {
        unsigned* bar = b.bar;
        __builtin_amdgcn_s_waitcnt(0);
        unsigned nloc = b.st[0], nx = b.st[1];
        if (nloc == 0u) { xcd_barrier_complete(bar, b.x, nloc, nx); b.st[0] = nloc; b.st[1] = nx; }
        const unsigned old = xb_add(&bar[XB_XSUB(b.x)], 1u);
        const unsigned gen = old / nloc;
        if (old + 1u == (gen + 1u) * nloc) {
            __builtin_amdgcn_fence(__ATOMIC_RELEASE, "agent");
            asm volatile("s_waitcnt vmcnt(0)" ::: "memory");
            const unsigned og = xb_add(&bar[XB_TOP], 1u);
            const unsigned tg = og / nx;
            if (og + 1u == (tg + 1u) * nx) xb_add(&bar[XB_TOPGEN], 1u);
            else XB_SPIN(xb_ld(&bar[XB_TOPGEN]) == tg, bar);
            __builtin_amdgcn_fence(__ATOMIC_ACQUIRE, "agent");
            xb_add(&bar[XB_XGEN(b.x)], 1u);
            asm volatile("s_waitcnt vmcnt(0)" ::: "memory");
        } else {
            XB_SPIN(xb_ld(&bar[XB_XGEN(b.x)]) == gen, bar);
            __builtin_amdgcn_fence(__ATOMIC_ACQUIRE, "agent");
            asm volatile("s_waitcnt vmcnt(0)" ::: "memory");
        }
    }
    __syncthreads();
}

__global__ void __launch_bounds__(NTHREADS, 2) fwd_mega(Args a) {
    extern __shared__ __attribute__((aligned(16))) unsigned char lds_raw[];
    LAS unsigned char* lds = (LAS unsigned char*)lds_raw;
    cg::grid_group grid = cg::this_grid();
    const int wave_s = __builtin_amdgcn_readfirstlane(threadIdx.x >> 6);
#define TID_NOW (wave_s * 64 + pg8::lane_id_asm())
    if (threadIdx.x < 4) ((volatile LAS unsigned*)(lds + MISC_OFF))[threadIdx.x] = 0u;
    __syncthreads();
    (void)xcd_barrier_post((unsigned*)(a.ws + WS_CTL), (volatile LAS unsigned*)(lds + MISC_OFF));
#define PH_ON (true)
#define SEAM() do { { unsigned long long wsb_ = (unsigned long long)a.ws; asm volatile("" : "+s"(wsb_)); XcdBarrier b_; b_.bar = (unsigned*)((unsigned char*)wsb_ + WS_CTL); b_.x = xb_xcc_id(); b_.st = (volatile LAS unsigned*)(lds + MISC_OFF); xcd_barrier(b_); } } while (0)
#ifdef PROBE_SYNC2
#define PH_NEXT do { SEAM(); SEAM(); } while (0)
#else
#define PH_NEXT do { SEAM(); } while (0)
#endif
#define WS_LOCAL int G = gridDim.x; asm volatile("" : "+s"(G)); const int bx = blockIdx.x, vcu = (G % 8 == 0) ? (bx % 8) * (G / 8) + bx / 8 : bx; (void)vcu; unsigned long long wsi_ = (unsigned long long)a.ws; asm volatile("" : "+s"(wsi_)); unsigned char* ws = (unsigned char*)(GAS unsigned char*)wsi_; float* ss = (float*)(ws + WS_SS); bf16_t* xb = (bf16_t*)(ws + WS_XB); (void)ss; (void)xb

#ifndef DIS_P0
    if (PH_ON) { WS_LOCAL; const int tid = TID_NOW;
#ifdef PROBE_P02
#pragma unroll 1
        for (int rep_ = 0; rep_ < 2; ++rep_)
#endif
        prologue(a, lds, vcu, G, wave_s, tid & 63, tid); }
#endif
    if (a.ph_lo != 0) grid.sync();
    PH_NEXT;

#pragma unroll 1
    for (int li = 0; li < 4; ++li) {
#pragma unroll 1
        for (int j = 0; j < 2; ++j) {
            const int f = li * 2 + j;
            if (PH_ON) {
                WS_LOCAL; const bf16_t* wgu = (const bf16_t*)(ws + ffn_w_off(f));
                pg8::Gemm g{xb, wgu, M_TOK, 5632, 1024}; pg8::StaticOrder S; S.init(M_TOK, 5632, G, bx);
                EpiSwiglu E{ws, lds + EPI_OFF};
#ifndef DIS_F1
#ifdef PROBE_F12
#pragma unroll 1
                for (int rep_ = 0; rep_ < 2; ++rep_)
#endif
                pg8::gemm_phase<EpiSwiglu, pg8::StaticOrder, true, true>(lds, g, S, E, wave_s);
#endif
            }
            PH_NEXT;
            if (PH_ON) {
                WS_LOCAL; const bf16_t* wd = (const bf16_t*)(ws + ffn_w_off(f)) + (size_t)5632 * 1024;
                pg8::Gemm g{(const bf16_t*)(ws + T_H), wd, M_TOK, 1024, FF}; pg8::StaticOrder S; S.init(M_TOK, 1024, G, bx);
                EpiResid E{a.in[0], a.out, ws, 0.5f, f == 0 ? 1 : (f == 7 ? (2 | 4) : 0)};
#ifndef DIS_RES
                pg8::gemm_phase<EpiResid, pg8::StaticOrder, true, true>(lds, g, S, E, wave_s);
#endif
            }
            if (f != 7) PH_NEXT;
            if (j == 0) {
                const int kind = li % 3;
                if (kind == 0) {
                    const int ia = li == 0 ? 0 : 1;
                    if (PH_ON) {
                        WS_LOCAL; const bf16_t* win = (const bf16_t*)(ws + conv_w_off(ia));
                        pg8::Gemm g{xb, win, M_TOK, 3072, 1024}; pg8::StaticOrder S; S.init(M_TOK, 3072, G, bx);
                        EpiConvIn E{ws, lds + EPI_OFF};
#ifndef DIS_C1
                        pg8::gemm_phase<EpiConvIn, pg8::StaticOrder, true, true>(lds, g, S, E, wave_s);
#endif
                    }
                    PH_NEXT;
#ifndef DIS_E
                    if (PH_ON) { WS_LOCAL; const int tid = TID_NOW; conv_phase((const bf16_t*)(ws + T_Z), (const bf16_t*)(ws + T_BG), a.in[7] + (size_t)ia * 3 * 1024, (bf16_t*)(ws + T_G), vcu * NTHREADS + tid, G * NTHREADS); }
#endif
                    PH_NEXT;
                } else if (kind == 1) {
                    if (PH_ON) {
                        WS_LOCAL;
                        pg8::Gemm g{xb, (const bf16_t*)(ws + W_MLA_A), M_TOK, 512, 1024}; pg8::StaticOrder S; S.init(M_TOK, 512, G, bx);
                        EpiMlaA E{ws, lds + EPI_OFF};
#ifndef DIS_M1
                        pg8::gemm_phase<EpiMlaA, pg8::StaticOrder, true, true>(lds, g, S, E, wave_s);
#endif
                    }
                    PH_NEXT;
                    if (PH_ON) {
                        { WS_LOCAL; pg8::Gemm g{(const bf16_t*)(ws + T_AQ), (const bf16_t*)(ws + W_MLA_UQ), M_TOK, 2048, 256}; pg8::StaticOrder S; S.init(M_TOK, 2048, G, bx);
                          EpiQ E{ws};
#ifndef DIS_M2
                          pg8::gemm_phase<EpiQ, pg8::StaticOrder, true, true>(lds, g, S, E, wave_s);
#endif
                        }
                        { WS_LOCAL; pg8::Gemm g{(const bf16_t*)(ws + T_AKV), (const bf16_t*)(ws + W_MLA_UKV), M_TOK, 2048, 256}; pg8::StaticOrder S; S.init(M_TOK, 2048, G, bx);
                          EpiKV E{ws, a.out};
#ifndef DIS_M3
                          pg8::gemm_phase<EpiKV, pg8::StaticOrder, true, true>(lds, g, S, E, wave_s);
#endif
                        }
                    }
                    PH_NEXT;
#ifndef DIS_FIN
                    if (PH_ON) { WS_LOCAL; const int tid = TID_NOW; qk_finalize((bf16_t*)(ws + T_Q), (bf16_t*)(ws + T_K), (const float*)(ws + WS_KR), a.in[14], a.in[15], (const float*)(ws + WS_COS), (const float*)(ws + WS_SIN), vcu * NTHREADS + tid, G * NTHREADS); }
#endif
                    PH_NEXT;
#ifndef DIS_ATT
                    if (PH_ON) { WS_LOCAL;
#ifdef PROBE_ATT2
#pragma unroll 1
                        for (int rep_ = 0; rep_ < 2; ++rep_)
#endif
                        attn_phase(lds, (const bf16_t*)(ws + T_Q), (const bf16_t*)(ws + T_K), (const bf16_t*)((const unsigned char*)a.out + 64 * MiB), (bf16_t*)(ws + T_O), a.in[14], a.in[15], (const float*)(ws + WS_COS), (const float*)(ws + WS_SIN), vcu, G, wave_s); }
#endif
                    PH_NEXT;
                } else {
                    if (PH_ON) {
                        WS_LOCAL;
                        pg8::Gemm g{xb, (const bf16_t*)(ws + W_SG_IN), M_TOK, 2048, 1024}; pg8::StaticOrder S; S.init(M_TOK, 2048, G, bx);
                        EpiSgIn E{ws, lds + EPI_OFF};
#ifndef DIS_S1
                        pg8::gemm_phase<EpiSgIn, pg8::StaticOrder, true, true>(lds, g, S, E, wave_s);
#endif
                    }
                    PH_NEXT;
#ifndef DIS_S2
                    if (PH_ON) { WS_LOCAL; sg_phase(lds, (const bf16_t*)(ws + T_Z), (const bf16_t*)(ws + T_BG), (const float*)(ws + WS_SSV), a.in[18], (const bf16_t*)(ws + W_SG_S), a.in[20], (bf16_t*)(ws + T_G), vcu, G, wave_s); }
#endif
                    PH_NEXT;
                }
                if (PH_ON) {
                    WS_LOCAL;
                    const bf16_t* Amix = (const bf16_t*)(ws + (kind == 1 ? T_O : T_G));
                    const bf16_t* Wmix = kind == 0 ? (const bf16_t*)(ws + conv_w_off(li == 0 ? 0 : 1)) + (size_t)3072 * 1024 : kind == 1 ? (const bf16_t*)(ws + W_MLA_O) : (const bf16_t*)(ws + W_SG_OUT);
                    pg8::Gemm g{Amix, Wmix, M_TOK, 1024, 1024}; pg8::StaticOrder S; S.init(M_TOK, 1024, G, bx);
                    EpiResid E{a.in[0], a.out, ws, 1.0f, li == 3 ? 8 : 0};
#ifndef DIS_RES
                    pg8::gemm_phase<EpiResid, pg8::StaticOrder, true, true>(lds, g, S, E, wave_s);
#endif
                }
                PH_NEXT;
            }
        }
    }
}

#ifndef MK_PER_PHASE
#define MK_PER_PHASE 0
#endif
extern "C" void kernel_launch(void* const* d_in, const int* in_sizes, int n_in, void* d_out, int out_size, void* d_ws, size_t ws_size, hipStream_t stream) {
    static int grid = 0;
    if (grid == 0) {
        if (n_in != 22 || out_size != M_TOK * DM || ws_size < WS_END) { fprintf(stderr, "kernel_launch: unexpected shapes (n_in %d out %d ws %zu)\n", n_in, out_size, ws_size); grid = -1; return; }
        int dev = 0, cus = 0, per_cu = 0;
        hipGetDevice(&dev); hipDeviceGetAttribute(&cus, hipDeviceAttributeMultiprocessorCount, dev);
        if (hipFuncSetAttribute((const void*)fwd_mega, hipFuncAttributeMaxDynamicSharedMemorySize, LDS_BYTES) != hipSuccess) fprintf(stderr, "kernel_launch: hipFuncSetAttribute failed\n");
        if (hipOccupancyMaxActiveBlocksPerMultiprocessor(&per_cu, (const void*)fwd_mega, NTHREADS, LDS_BYTES) != hipSuccess || per_cu < 1) { fprintf(stderr, "kernel_launch: occupancy query says %d\n", per_cu); per_cu = 1; }
        (void)hipGetLastError();
        grid = cus * 1;
        fprintf(stderr, "kernel_launch: grid %d (per_cu %d)\n", grid, per_cu);
    }
    if (grid < 0) return;
    if (hipMemsetAsync((char*)d_ws + WS_CTL, 0, CTL_ZERO_BYTES, stream) != hipSuccess) { fprintf(stderr, "kernel_launch: memset failed\n"); return; }
    Args a{};
    for (int i = 0; i < 22; ++i) a.in[i] = (const float*)d_in[i];
    a.out = (float*)d_out; a.ws = (unsigned char*)d_ws;
    for (int i = 0; i < 16; ++i) { const float e = (float)(2 * i) / 32.0f; a.inv_freq[i] = 1.0f / powf(10000.0f, e); }
#if MK_PER_PHASE
    for (int p = 0; p < 31; ++p) { a.ph_lo = p; a.ph_hi = p + 1; hipLaunchKernelGGL(fwd_mega, dim3(grid), dim3(NTHREADS), LDS_BYTES, stream, a); }
#else
    a.ph_lo = 0; a.ph_hi = 1000;
    void* args[] = {&a};
    const hipError_t e = hipLaunchCooperativeKernel((const void*)fwd_mega, dim3(grid), dim3(NTHREADS), args, LDS_BYTES, stream);
    if (e != hipSuccess) fprintf(stderr, "kernel_launch: cooperative launch failed: %s (grid %d)\n", hipGetErrorString(e), grid);
#endif
}
```

```cpp
#include <hip/hip_runtime.h>
#include <hip/hip_cooperative_groups.h>
#include <cstdio>
#include <cstdint>
#include <cmath>
namespace cg = cooperative_groups;
namespace pg8 {
#define PG8_LAS __attribute__((address_space(3)))
typedef unsigned short bf16_t;
typedef short bf16x8 __attribute__((ext_vector_type(8)));
typedef float f32x4 __attribute__((ext_vector_type(4)));
typedef unsigned u32x4 __attribute__((ext_vector_type(4)));
constexpr int BM = 256, BK = 64, HALF = 128, HTB = HALF * BK * 2  , STAGE_BYTES = 8 * HTB, NXCD = 8, WGM = 4;

__host__ __device__ __forceinline__ int lds_byte(int r, int c) { const int st = (r >> 4) * 2 + (c >> 5), rr = r & 15, cc = c & 31, ob = rr * 64 + cc * 2; return st * 1024 + (ob ^ (((ob >> 9) & 1) << 5)); }
__host__ __device__ __forceinline__ void stage_rc(int b, int& R, int& C) { const int st = b / 1024, sb = b % 1024, swz = sb ^ (((sb >> 9) & 1) << 5); R = (st >> 1) * 16 + swz / 64; C = (st & 1) * 32 + (swz % 64) / 2; }
__host__ __device__ __forceinline__ int perm32(int rho) { const int n = rho >> 4, i = rho & 15; return 8 * (i >> 2) + 4 * n + (i & 3); }

__device__ __forceinline__ int lane_id_asm() { int l; asm volatile("v_mbcnt_lo_u32_b32 %0, -1, 0\n\tv_mbcnt_hi_u32_b32 %0, -1, %0" : "=v"(l)); return l; }
struct Unit { int pm, pn; };
struct Gemm { const bf16_t* A; const bf16_t* Bt; int M, N, K; int tiledA; };

struct StaticOrder {
    int nM, nN, nwg, G, c;
    __host__ __device__ void init(int M, int N, int G_, int c_) { nM = M / BM; nN = N / BM; nwg = nM * nN; G = G_; c = c_; }
    __host__ __device__ bool next(int i, Unit& u) const {
        const long L = (long)i * G + c; if (L >= nwg) return false;
        int wgid = (int)L; { const int q = nwg / NXCD, r = nwg % NXCD, xcd = wgid % NXCD, off = wgid / NXCD; wgid = (xcd < r ? xcd * (q + 1) : r * (q + 1) + (xcd - r) * q) + off; }
        const int nig = WGM * nN, gid = wgid / nig, fm = gid * WGM, gsz = (nM - fm) < WGM ? (nM - fm) : WGM;
        u.pm = fm + ((wgid % nig) % gsz); u.pn = (wgid % nig) / gsz; return true;
    }
    __device__ __forceinline__ void a_ready(const Unit&) const {}
    __device__ __forceinline__ void done(const Unit&) const {}
};

__device__ __forceinline__ unsigned cvt_pk_bf16(float lo, float hi) { unsigned r; asm volatile("v_cvt_pk_bf16_f32 %0, %1, %2" : "=v"(r) : "v"(lo), "v"(hi)); return r; }
typedef float f32x2 __attribute__((ext_vector_type(2)));
template <class Epi, class Sched, bool ALIGN_EPI = false, bool SP2 = false>
__device__ __forceinline__ void gemm_phase(PG8_LAS unsigned char* lds, const Gemm g, const Sched& S, const Epi& E, const int wave_id) {
    int wid_ = wave_id; asm volatile("" : "+s"(wid_)); const int lane = lane_id_asm(), wid = wid_, tid = wid * 64 + lane, wr = wid >> 2, wc = wid & 3, fr = lane & 15, fq = lane >> 4;
    const int K = g.K, nt = K / BK;
    unsigned voffA[2], voffB[2];
#pragma unroll
    for (int i = 0; i < 2; ++i) { int R, C; stage_rc(tid * 16 + i * 8192, R, C); const int Rb = Epi::PERM ? ((R & ~31) + perm32(R & 31)) : R;
        voffA[i] = (unsigned)(R * (g.tiledA ? 64 : K) + C) * 2u; voffB[i] = (unsigned)(Rb * K + C) * 2u; }
    const size_t kstep = (size_t)(BK * 2);
    const size_t hstep = (size_t)HALF * K * 2;
    const size_t tstep = 2 * hstep;
    const size_t kstepA = g.tiledA ? (size_t)32768 : kstep, hstepA = g.tiledA ? (size_t)16384 : hstep, tstepA = g.tiledA ? (size_t)(K / BK) * 32768 : tstep;
    const unsigned ldsw = (unsigned)wid * 1024u;
    const int aoff = lds_byte(wr * 64 + fr, fq * 8), boff = lds_byte(wc * 32 + fr, fq * 8);
#define PG8_SA(b, h) (((b) * 2 + (h)) * HTB)
#define PG8_SB(b, h) ((4 + (b) * 2 + (h)) * HTB)
#define PG8_STAGE(bufoff, gbase, voff) do { _Pragma("unroll") for (int _i = 0; _i < 2; ++_i) \
        __builtin_amdgcn_global_load_lds((const unsigned*)((const char*)(gbase) + (voff)[_i]), (PG8_LAS unsigned*)(lds + (bufoff) + ldsw + _i * 8192), 16, 0, 0); } while (0)
#define PG8_LDA(dst, b, h) do { _Pragma("unroll") for (int m = 0; m < 4; ++m) _Pragma("unroll") for (int k = 0; k < 2; ++k) dst[m][k] = *(const PG8_LAS bf16x8*)(lds + PG8_SA(b, h) + aoff + m * 2048 + k * 1024); } while (0)
#define PG8_LDB(dst, b, h) do { _Pragma("unroll") for (int n = 0; n < 2; ++n) _Pragma("unroll") for (int k = 0; k < 2; ++k) dst[n][k] = *(const PG8_LAS bf16x8*)(lds + PG8_SB(b, h) + boff + n * 2048 + k * 1024); } while (0)
#define PG8_MMA(ai, bj, At, Bt) do { __builtin_amdgcn_s_setprio(1); _Pragma("unroll") for (int m = 0; m < 4; ++m) _Pragma("unroll") for (int n = 0; n < 2; ++n) _Pragma("unroll") for (int k = 0; k < 2; ++k) \
        acc[ai][bj][m][n] = __builtin_amdgcn_mfma_f32_16x16x32_bf16(Bt[n][k], At[m][k], acc[ai][bj][m][n], 0, 0, 0); __builtin_amdgcn_s_setprio(0); } while (0)
#define PG8_WAIT_V(n) asm volatile("s_waitcnt vmcnt(" #n ")" ::: "memory")
#define PG8_WAIT_L(n) asm volatile("s_waitcnt lgkmcnt(" #n ")" ::: "memory")
#define PG8_BAR __builtin_amdgcn_s_barrier()
#define PG8_SCHED __builtin_amdgcn_sched_barrier(0)
    Unit cur, nxt; int ui = 0;
    if (!S.next(0, cur)) return;
    f32x4 acc[2][2][4][2];
#pragma unroll
    for (int a = 0; a < 2; ++a)
#pragma unroll
        for (int b = 0; b < 2; ++b)
#pragma unroll
            for (int m = 0; m < 4; ++m)
#pragma unroll
                for (int n = 0; n < 2; ++n) acc[a][b][m][n] = (f32x4){0.f, 0.f, 0.f, 0.f};
    bf16x8 At[4][2], B0[2][2], B1[2][2];
    const char* cA = (const char*)g.A + (size_t)cur.pm * tstepA; const char* cB = (const char*)g.Bt + (size_t)cur.pn * tstep;
    S.a_ready(cur);
    if constexpr (SP2) {
        PG8_STAGE(PG8_SB(0, 0), cB, voffB); PG8_STAGE(PG8_SB(0, 1), cB + hstep, voffB); PG8_STAGE(PG8_SA(0, 0), cA, voffA); PG8_STAGE(PG8_SA(0, 1), cA + hstepA, voffA);
        if (wr == 1) PG8_BAR;
        PG8_WAIT_V(2); PG8_BAR;
        PG8_STAGE(PG8_SB(1, 0), cB + kstep, voffB); PG8_STAGE(PG8_SA(1, 0), cA + kstepA, voffA); PG8_STAGE(PG8_SB(1, 1), cB + hstep + kstep, voffB);
        PG8_WAIT_V(6); PG8_BAR;
    } else {
        PG8_STAGE(PG8_SB(0, 0), cB, voffB); PG8_STAGE(PG8_SA(0, 0), cA, voffA); PG8_STAGE(PG8_SB(0, 1), cB + hstep, voffB); PG8_STAGE(PG8_SA(0, 1), cA + hstepA, voffA);
        if (wr == 1) PG8_BAR;
        PG8_WAIT_V(4); PG8_BAR;
        PG8_STAGE(PG8_SB(1, 0), cB + kstep, voffB); PG8_STAGE(PG8_SA(1, 0), cA + kstepA, voffA); PG8_STAGE(PG8_SB(1, 1), cB + hstep + kstep, voffB);
        PG8_WAIT_V(6); PG8_BAR;
    }
    for (;;) {
        const bool has_next = S.next(ui + 1, nxt);
        const char* nA = has_next ? (const char*)g.A + (size_t)nxt.pm * tstepA : cA; const char* nB = has_next ? (const char*)g.Bt + (size_t)nxt.pn * tstep : cB;
        for (int t = 0; t < nt; t += 2) {
            if (t == 2) E.prefetch(cur, wid, lane);
            const bool last = (t == nt - 2);
            const char* a1 = cA + (size_t)(t + 1) * kstepA;
            const char* a2 = last ? nA : cA + (size_t)(t + 2) * kstepA; const char* b2 = last ? nB : cB + (size_t)(t + 2) * kstep;
            const char* a3 = a2 + kstepA; const char* b3 = b2 + kstep;
            if (last && has_next) S.a_ready(nxt);
            if constexpr (SP2) {
            PG8_LDB(B0, 0, 0); PG8_LDB(B1, 0, 1); PG8_SCHED; PG8_LDA(At, 0, 0); PG8_STAGE(PG8_SA(1, 1), a1 + hstepA, voffA);
            PG8_WAIT_V(8); PG8_WAIT_L(0); PG8_BAR; PG8_MMA(0, 0, At, B0); PG8_MMA(0, 1, At, B1); PG8_BAR; PG8_SCHED;
            PG8_LDA(At, 0, 1); PG8_STAGE(PG8_SB(0, 0), b2, voffB); PG8_STAGE(PG8_SB(0, 1), b2 + hstep, voffB); PG8_STAGE(PG8_SA(0, 0), a2, voffA);
            PG8_WAIT_V(8); PG8_WAIT_L(0); PG8_BAR; PG8_MMA(1, 0, At, B0); PG8_MMA(1, 1, At, B1); PG8_BAR; PG8_SCHED;
            PG8_LDB(B0, 1, 0); PG8_LDB(B1, 1, 1); PG8_SCHED; PG8_LDA(At, 1, 0); PG8_STAGE(PG8_SA(0, 1), a2 + hstepA, voffA);
            PG8_WAIT_V(8); PG8_WAIT_L(0); PG8_BAR; PG8_MMA(0, 0, At, B0); PG8_MMA(0, 1, At, B1); PG8_BAR; PG8_SCHED;
            PG8_LDA(At, 1, 1); PG8_STAGE(PG8_SB(1, 0), b3, voffB); PG8_STAGE(PG8_SB(1, 1), b3 + hstep, voffB); PG8_STAGE(PG8_SA(1, 0), a3, voffA);
            PG8_WAIT_V(8); PG8_WAIT_L(0); PG8_BAR; PG8_MMA(1, 0, At, B0); PG8_MMA(1, 1, At, B1); PG8_BAR; PG8_SCHED;
            } else {
            PG8_LDB(B0, 0, 0); PG8_SCHED; PG8_LDA(At, 0, 0); PG8_STAGE(PG8_SA(1, 1), a1 + hstepA, voffA);
            PG8_WAIT_L(8); PG8_BAR; PG8_WAIT_L(0); PG8_MMA(0, 0, At, B0); PG8_BAR; PG8_SCHED;
            PG8_LDB(B1, 0, 1); PG8_STAGE(PG8_SB(0, 0), b2, voffB);
            PG8_BAR; PG8_WAIT_L(0); PG8_MMA(0, 1, At, B1); PG8_BAR;
            PG8_LDA(At, 0, 1); PG8_STAGE(PG8_SA(0, 0), a2, voffA);
            PG8_BAR; PG8_WAIT_L(0); PG8_MMA(1, 0, At, B0); PG8_BAR; PG8_SCHED;
            PG8_STAGE(PG8_SB(0, 1), b2 + hstep, voffB);
            PG8_WAIT_V(6); PG8_BAR; PG8_MMA(1, 1, At, B1); PG8_BAR;
            PG8_LDB(B0, 1, 0); PG8_SCHED; PG8_LDA(At, 1, 0); PG8_STAGE(PG8_SA(0, 1), a2 + hstepA, voffA);
            PG8_WAIT_L(8); PG8_BAR; PG8_WAIT_L(0); PG8_MMA(0, 0, At, B0); PG8_BAR; PG8_SCHED;
            PG8_LDB(B1, 1, 1); PG8_STAGE(PG8_SB(1, 0), b3, voffB);
            PG8_BAR; PG8_WAIT_L(0); PG8_MMA(0, 1, At, B1); PG8_BAR;
            PG8_LDA(At, 1, 1); PG8_STAGE(PG8_SA(1, 0), a3, voffA);
            PG8_BAR; PG8_WAIT_L(0); PG8_MMA(1, 0, At, B0); PG8_BAR; PG8_SCHED;
            PG8_STAGE(PG8_SB(1, 1), b3 + hstep, voffB);
            PG8_WAIT_V(6); PG8_BAR; PG8_MMA(1, 1, At, B1); PG8_BAR;
            }
        }
        if constexpr (ALIGN_EPI) { if (wr == 0) PG8_BAR; }
        if constexpr (!Epi::AFTER_DRAIN) { E(acc, cur, wr, wc, fr, fq); S.done(cur); }
        if (!has_next) break;
#pragma unroll
        for (int a = 0; a < 2; ++a)
#pragma unroll
            for (int b = 0; b < 2; ++b)
#pragma unroll
                for (int m = 0; m < 4; ++m)
#pragma unroll
                    for (int n = 0; n < 2; ++n) acc[a][b][m][n] = (f32x4){0.f, 0.f, 0.f, 0.f};
        cur = nxt; cA = nA; cB = nB; ++ui;
        if constexpr (ALIGN_EPI) { if (wr == 1) PG8_BAR; }
    }
    PG8_WAIT_V(0);
    if constexpr (!ALIGN_EPI) { if (wr == 0) PG8_BAR; }
    PG8_BAR;
    if constexpr (Epi::AFTER_DRAIN) { E.fused(acc, cur, wr, wc, fr, fq, lds, wid, lane); S.done(cur); }
#undef PG8_SA
#undef PG8_SB
#undef PG8_STAGE
#undef PG8_LDA
#undef PG8_LDB
#undef PG8_MMA
#undef PG8_WAIT_V
#undef PG8_WAIT_L
#undef PG8_BAR
#undef PG8_SCHED
}
}

#define LAS __attribute__((address_space(3)))
#define GAS __attribute__((address_space(1)))
typedef unsigned short bf16_t;
typedef float f32x4 __attribute__((ext_vector_type(4)));
typedef float f32x16 __attribute__((ext_vector_type(16)));
typedef short bf16x8 __attribute__((ext_vector_type(8)));
typedef short s16x4 __attribute__((ext_vector_type(4)));
typedef unsigned u32x4 __attribute__((ext_vector_type(4)));
typedef unsigned u32x2 __attribute__((ext_vector_type(2)));

constexpr int M_TOK = 32768, DM = 1024, FF = 2816, SEQ = 8192;
constexpr float EPS = 1e-6f;
constexpr float QSCALE = 0.10206207261596575f * 1.4426950408889634f;
constexpr int NTHREADS = 512, NWAVES = 8;
constexpr size_t MiB = 1u << 20;
constexpr size_t WS_SS = 0, WS_SSV = 2 * MiB, WS_SSQ = 4 * MiB, WS_SSKV = 4 * MiB + 512 * 1024, WS_SSPE = 5 * MiB;
constexpr size_t WS_COS = 6 * MiB, WS_SIN = 8 * MiB, WS_KR = 10 * MiB;
constexpr size_t WS_CTL = 14 * MiB, CTL_ZERO_BYTES = 16384;
constexpr size_t WS_XB = 16 * MiB;
constexpr size_t WS_WB = 80 * MiB;
constexpr size_t FFN_BYTES = 16 * MiB + 512 * 1024;
constexpr size_t W_CONV1 = WS_WB + 6 * FFN_BYTES;
constexpr size_t W_MLA_A = W_CONV1 + 8 * MiB, W_MLA_UQ = W_MLA_A + 1 * MiB, W_MLA_UKV = W_MLA_UQ + 1 * MiB, W_MLA_O = W_MLA_UKV + 1 * MiB;
constexpr size_t W_SG_IN = W_MLA_O + 2 * MiB, W_SG_OUT = W_SG_IN + 4 * MiB, W_SG_S = W_SG_OUT + 2 * MiB;
constexpr size_t WS_WL0 = 198 * MiB + 512 * 1024;
constexpr size_t W_CONV0 = WS_WL0 + 2 * FFN_BYTES;
static_assert(W_SG_S + 256 * 1024 <= WS_WL0, "weights map");
constexpr size_t WS_T = 240 * MiB;
static_assert(W_CONV0 + 8 * MiB <= WS_T, "weights map 2");
constexpr size_t T_H = WS_T;
constexpr size_t T_Z = WS_T, T_BG = WS_T + 64 * MiB, T_G = WS_T + 128 * MiB;
constexpr size_t T_Q = WS_T, T_K = WS_T + 96 * MiB, T_O = WS_T + 192 * MiB, T_AQ = T_O, T_AKV = T_O + 16 * MiB;
constexpr size_t T_LO = WS_T + 192 * MiB;
constexpr size_t WS_END = 512 * MiB;
static_assert(T_O + 64 * MiB <= WS_END && T_H + 176 * MiB <= WS_END, "temp map");
constexpr int RING_BYTES = 131072, EPI_OFF = RING_BYTES  , MISC_OFF = RING_BYTES + 16384, LDS_BYTES = 147456 + 256;

__device__ __forceinline__ size_t ffn_w_off(int f) { return f < 2 ? WS_WL0 + (size_t)f * FFN_BYTES : WS_WB + (size_t)(f - 2) * FFN_BYTES; }
__device__ __forceinline__ size_t conv_w_off(int ia) { return ia == 0 ? W_CONV0 : W_CONV1; }

__device__ __forceinline__ unsigned cvtpk(float lo, float hi) { return pg8::cvt_pk_bf16(lo, hi); }
__device__ __forceinline__ u32x4 pack8(f32x4 a, f32x4 b) { u32x4 w; w.x = cvtpk(a[0], a[1]); w.y = cvtpk(a[2], a[3]); w.z = cvtpk(b[0], b[1]); w.w = cvtpk(b[2], b[3]); return w; }
__device__ __forceinline__ float bf_lo(unsigned w) { return __uint_as_float(w << 16); }
__device__ __forceinline__ float bf_hi(unsigned w) { return __uint_as_float(w & 0xffff0000u); }
__device__ __forceinline__ float dot4(f32x4 a) { return (a[0] * a[0] + a[1] * a[1]) + (a[2] * a[2] + a[3] * a[3]); }
__device__ __forceinline__ float wave_sum(float v) {
#pragma unroll
    for (int o = 1; o < 64; o <<= 1) v += __shfl_xor(v, o);
    return v;
}
__device__ __forceinline__ float swap32(float x, bool hi) { auto rr = __builtin_amdgcn_permlane32_swap(__float_as_uint(x), __float_as_uint(x), false, false); return __uint_as_float(hi ? rr[0] : rr[1]); }
__device__ __forceinline__ float red_fq(float s) { s += __shfl_xor(s, 16); s += __shfl_xor(s, 32); return s; }
__device__ __forceinline__ float row_rs16(const GAS float* ss, int row, int fq) {
    const f32x4 p = *(const GAS f32x4*)(ss + (size_t)row * 16 + 4 * fq);
    const float s = red_fq((p[0] + p[1]) + (p[2] + p[3]));
    return rsqrtf(s * (1.0f / 1024.0f) + EPS);
}
__device__ __forceinline__ float silu_f(float x) { return x * __builtin_amdgcn_rcpf(1.0f + __expf(-x)); }
__device__ __forceinline__ float gelu_tanh_f(float x) { const float u2 = 1.5957691216057308f * (x + 0.044715f * x * x * x); return x * __builtin_amdgcn_rcpf(1.0f + __expf(-u2)); }
#define EPI_FENCE() do { asm volatile("" ::: "memory"); __builtin_amdgcn_sched_barrier(0); } while (0)
#define EPI_BAR() do { asm volatile("s_waitcnt lgkmcnt(0)" ::: "memory"); __builtin_amdgcn_s_barrier(); EPI_FENCE(); } while (0)

typedef const pg8::f32x4 (&AccRef)[2][2][4][2];

__device__ __forceinline__ void ss_prefetch(unsigned char* ws, LAS unsigned char* ldsE, int pm, int wid, int lane) {
    unsigned long long wi_ = (unsigned long long)ws; asm volatile("" : "+s"(wi_));
    (void)lane; const unsigned lo16 = (unsigned)pg8::lane_id_asm() * 16u;
    const unsigned char* srcu = (const unsigned char*)wi_ + WS_SS + (size_t)pm * 16384 + wid * 2048;
    const unsigned char* src = srcu + lo16;
    __builtin_amdgcn_global_load_lds((const unsigned*)src, (LAS unsigned*)(ldsE + wid * 2048), 16, 0, 0);
    __builtin_amdgcn_global_load_lds((const unsigned*)(src + 1024), (LAS unsigned*)(ldsE + wid * 2048 + 1024), 16, 0, 0);
}

struct EpiSwiglu {
    static constexpr bool PERM = true, AFTER_DRAIN = false;
    unsigned char* ws; LAS unsigned char* ldsE;
    __device__ __forceinline__ void prefetch(const pg8::Unit& u, int wid, int lane) const { ss_prefetch(ws, ldsE, u.pm, wid, lane); }
    __device__ __forceinline__ void operator()(AccRef acc, const pg8::Unit& u, int wr, int wc, int fr_in, int fq_in) const {
        const int lane_e = pg8::lane_id_asm(); const int fr = lane_e & 15, fq = lane_e >> 4; (void)fr_in; (void)fq_in;
        unsigned long long wi_ = (unsigned long long)ws; asm volatile("" : "+s"(wi_)); GAS unsigned char* w = (GAS unsigned char*)wi_;
        const GAS float* ss = (const GAS float*)(w + WS_SS); GAS bf16_t* H = (GAS bf16_t*)(w + T_H);
        const int rowb = u.pm * 256 + wr * 64 + fr, hcol = u.pn * 128 + wc * 32 + 8 * fq;
        float rs8[8];
        { f32x4 pp[8];
#pragma unroll
          for (int q = 0; q < 8; ++q) pp[q] = *(const LAS f32x4*)(ldsE + ((q >> 2) * 128 + wr * 64 + (q & 3) * 16 + fr) * 64 + fq * 16);
#pragma unroll
          for (int q = 0; q < 8; ++q) rs8[q] = rsqrtf(red_fq((pp[q][0] + pp[q][1]) + (pp[q][2] + pp[q][3])) * (1.0f / 1024.0f) + EPS); }
        EPI_FENCE();
#pragma unroll
        for (int ai = 0; ai < 2; ++ai)
#pragma unroll
            for (int m = 0; m < 4; ++m) {
                const int row = rowb + ai * 128 + m * 16; const float rs = rs8[ai * 4 + m];
                const float k1 = rs * -1.4426950408889634f, r2 = rs * rs; (void)r2;
                f32x4 h0, h1;
#pragma unroll
                for (int j = 0; j < 4; ++j) {
                    { const float a = acc[ai][0][m][0][j], b = acc[ai][1][m][0][j]; { const float x = a * rs; h0[j] = (x * __builtin_amdgcn_rcpf(1.0f + __builtin_amdgcn_exp2f(a * k1))) * (b * rs); } }
                    { const float a = acc[ai][0][m][1][j], b = acc[ai][1][m][1][j]; { const float x = a * rs; h1[j] = (x * __builtin_amdgcn_rcpf(1.0f + __builtin_amdgcn_exp2f(a * k1))) * (b * rs); } }
                }
                *(GAS u32x4*)(H + ((size_t)(u.pm * 44 + 2 * u.pn + (wc >> 1)) * 256 + (size_t)(ai * 128 + wr * 64 + m * 16 + fr)) * 64 + (wc & 1) * 32 + 8 * fq) = pack8(h0, h1);
            }
    }
};

struct EpiResid {
    static constexpr bool PERM = true, AFTER_DRAIN = false;
    const float* xf32; float* outp; unsigned char* ws; float alpha; int flags;
    __device__ __forceinline__ void prefetch(const pg8::Unit&, int, int) const {}
    __device__ __forceinline__ void operator()(AccRef acc, const pg8::Unit& u, int wr, int wc, int fr_in, int fq_in) const {
        const int lane_e = pg8::lane_id_asm(); const int fr = lane_e & 15, fq = lane_e >> 4; (void)fr_in; (void)fq_in;
        unsigned long long wi_ = (unsigned long long)ws; asm volatile("" : "+s"(wi_)); GAS unsigned char* w = (GAS unsigned char*)wi_;
        GAS float* ss = (GAS float*)(w + WS_SS); GAS bf16_t* xb = (GAS bf16_t*)(w + WS_XB);
        const bf16_t* lo_in = (flags & 4) ? (const bf16_t*)((unsigned char*)w + T_LO) : (const bf16_t*)outp;
        bf16_t* lo_out = (flags & 8) ? (bf16_t*)((unsigned char*)w + T_LO) : (bf16_t*)outp;
        const bool first = flags & 1, final_ = flags & 2;
        const int rowb = u.pm * 256 + wr * 64 + fr, colb = u.pn * 256 + wc * 32 + 8 * fq;
#pragma unroll
        for (int ai = 0; ai < 2; ++ai) {
            f32x4 xv[4][2][2];
            if (first) {
#pragma unroll
                for (int m = 0; m < 4; ++m)
#pragma unroll
                    for (int bj = 0; bj < 2; ++bj) { const size_t off = (size_t)(rowb + ai * 128 + m * 16) * DM + colb + bj * 128; xv[m][bj][0] = *(const f32x4*)(xf32 + off); xv[m][bj][1] = *(const f32x4*)(xf32 + off + 4); }
            } else {
                u32x4 rh[4][2], rl[4][2];
#pragma unroll
                for (int m = 0; m < 4; ++m)
#pragma unroll
                    for (int bj = 0; bj < 2; ++bj) { const size_t off = (size_t)(rowb + ai * 128 + m * 16) * DM + colb + bj * 128; rh[m][bj] = *(const GAS u32x4*)(xb + off); rl[m][bj] = *(const u32x4*)(lo_in + off); }
#pragma unroll
                for (int m = 0; m < 4; ++m)
#pragma unroll
                    for (int bj = 0; bj < 2; ++bj) { const u32x4 h = rh[m][bj], l = rl[m][bj];
                        xv[m][bj][0] = (f32x4){bf_lo(h.x) + bf_lo(l.x), bf_hi(h.x) + bf_hi(l.x), bf_lo(h.y) + bf_lo(l.y), bf_hi(h.y) + bf_hi(l.y)};
                        xv[m][bj][1] = (f32x4){bf_lo(h.z) + bf_lo(l.z), bf_hi(h.z) + bf_hi(l.z), bf_lo(h.w) + bf_lo(l.w), bf_hi(h.w) + bf_hi(l.w)}; }
            }
#pragma unroll
            for (int m = 0; m < 4; ++m) {
                const int row = rowb + ai * 128 + m * 16; float sq = 0.f;
#pragma unroll
                for (int bj = 0; bj < 2; ++bj) {
                    const size_t off = (size_t)row * DM + colb + bj * 128;
                    const f32x4 y0 = xv[m][bj][0] + acc[ai][bj][m][0] * alpha, y1 = xv[m][bj][1] + acc[ai][bj][m][1] * alpha;
                    if (final_) { *(f32x4*)(outp + off) = y0; *(f32x4*)(outp + off + 4) = y1; }
                    else {
                        const u32x4 h = pack8(y0, y1);
                        const f32x4 d0 = {y0[0] - bf_lo(h.x), y0[1] - bf_hi(h.x), y0[2] - bf_lo(h.y), y0[3] - bf_hi(h.y)}, d1 = {y1[0] - bf_lo(h.z), y1[1] - bf_hi(h.z), y1[2] - bf_lo(h.w), y1[3] - bf_hi(h.w)};
                        *(GAS u32x4*)(xb + off) = h; *(u32x4*)(lo_out + off) = pack8(d0, d1);
                        sq += dot4(y0) + dot4(y1);
                    }
                }
                if (!final_) { sq = red_fq(sq); if (fq == 0) ss[(size_t)row * 16 + u.pn * 4 + wc] = sq; }
            }
            EPI_FENCE();
        }
    }
};

struct EpiConvIn {
    static constexpr bool PERM = true, AFTER_DRAIN = false;
    unsigned char* ws; LAS unsigned char* ldsE;
    __device__ __forceinline__ void prefetch(const pg8::Unit& u, int wid, int lane) const { ss_prefetch(ws, ldsE, u.pm, wid, lane); }
    __device__ __forceinline__ void operator()(AccRef acc, const pg8::Unit& u, int wr, int wc, int fr_in, int fq_in) const {
        const int lane_e = pg8::lane_id_asm(); const int fr = lane_e & 15, fq = lane_e >> 4; (void)fr_in; (void)fq_in;
        unsigned long long wi_ = (unsigned long long)ws; asm volatile("" : "+s"(wi_)); GAS unsigned char* w = (GAS unsigned char*)wi_;
        const GAS float* ss = (const GAS float*)(w + WS_SS); GAS bf16_t* Z = (GAS bf16_t*)(w + T_Z); GAS bf16_t* Bg = (GAS bf16_t*)(w + T_BG);
        const int rowb = u.pm * 256 + wr * 64 + fr;
        float rs8[8];
        { f32x4 pp[8];
#pragma unroll
          for (int q = 0; q < 8; ++q) pp[q] = *(const LAS f32x4*)(ldsE + ((q >> 2) * 128 + wr * 64 + (q & 3) * 16 + fr) * 64 + fq * 16);
#pragma unroll
          for (int q = 0; q < 8; ++q) rs8[q] = rsqrtf(red_fq((pp[q][0] + pp[q][1]) + (pp[q][2] + pp[q][3])) * (1.0f / 1024.0f) + EPS); }
        EPI_FENCE();
#pragma unroll
        for (int ai = 0; ai < 2; ++ai)
#pragma unroll
            for (int m = 0; m < 4; ++m) {
                const int row = rowb + ai * 128 + m * 16; const float rs = rs8[ai * 4 + m];
                if (u.pn < 8) {
                    const float r2 = rs * rs;
                    const f32x4 z0 = acc[ai][0][m][0] * acc[ai][1][m][0] * r2, z1 = acc[ai][0][m][1] * acc[ai][1][m][1] * r2;
                    *(GAS u32x4*)(Z + (size_t)row * DM + u.pn * 128 + wc * 32 + 8 * fq) = pack8(z0, z1);
                } else {
#pragma unroll
                    for (int bj = 0; bj < 2; ++bj)
                        *(GAS u32x4*)(Bg + (size_t)row * DM + (u.pn - 8) * 256 + bj * 128 + wc * 32 + 8 * fq) = pack8(acc[ai][bj][m][0] * rs, acc[ai][bj][m][1] * rs);
                }
            }
    }
};

struct EpiMlaA {
    static constexpr bool PERM = true, AFTER_DRAIN = false;
    unsigned char* ws; LAS unsigned char* ldsE;
    __device__ __forceinline__ void prefetch(const pg8::Unit& u, int wid, int lane) const { ss_prefetch(ws, ldsE, u.pm, wid, lane); }
    __device__ __forceinline__ void operator()(AccRef acc, const pg8::Unit& u, int wr, int wc, int fr_in, int fq_in) const {
        const int lane_e = pg8::lane_id_asm(); const int fr = lane_e & 15, fq = lane_e >> 4; (void)fr_in; (void)fq_in;
        unsigned long long wi_ = (unsigned long long)ws; asm volatile("" : "+s"(wi_)); GAS unsigned char* w = (GAS unsigned char*)wi_;
        const GAS float* ss = (const GAS float*)(w + WS_SS); GAS bf16_t* Aq = (GAS bf16_t*)(w + T_AQ); GAS bf16_t* Akv = (GAS bf16_t*)(w + T_AKV); GAS float* ssq = (GAS float*)(w + WS_SSQ); GAS float* sskv = (GAS float*)(w + WS_SSKV);
        GAS float* sspe = (GAS float*)(w + WS_SSPE); GAS float* kr = (GAS float*)(w + WS_KR); const GAS float* cosT = (const GAS float*)(w + WS_COS); const GAS float* sinT = (const GAS float*)(w + WS_SIN);
        const int rowb = u.pm * 256 + wr * 64 + fr;
        float rs8[8];
        { f32x4 pp[8];
#pragma unroll
          for (int q = 0; q < 8; ++q) pp[q] = *(const LAS f32x4*)(ldsE + ((q >> 2) * 128 + wr * 64 + (q & 3) * 16 + fr) * 64 + fq * 16);
#pragma unroll
          for (int q = 0; q < 8; ++q) rs8[q] = rsqrtf(red_fq((pp[q][0] + pp[q][1]) + (pp[q][2] + pp[q][3])) * (1.0f / 1024.0f) + EPS); }
        EPI_FENCE();
#pragma unroll
        for (int ai = 0; ai < 2; ++ai)
#pragma unroll
            for (int m = 0; m < 4; ++m) {
                const int row = rowb + ai * 128 + m * 16; const float rs = rs8[ai * 4 + m];
                const f32x4 a00 = acc[ai][0][m][0] * rs, a01 = acc[ai][0][m][1] * rs, a10 = acc[ai][1][m][0] * rs, a11 = acc[ai][1][m][1] * rs;
                GAS bf16_t* dst = (u.pn == 0 ? Aq : Akv) + (size_t)row * 256 + wc * 32 + 8 * fq;
                *(GAS u32x4*)(dst) = pack8(a00, a01); *(GAS u32x4*)(dst + 128) = pack8(a10, a11);
                if (u.pn == 0) {
                    const float sq = red_fq(dot4(a00) + dot4(a01) + dot4(a10) + dot4(a11));
                    if (fq == 0) ssq[(size_t)row * 4 + wc] = sq;
                } else {
                    const float sq = red_fq(dot4(a00) + dot4(a01));
                    if (fq == 0) sskv[(size_t)row * 4 + wc] = sq;
                    if (wc == 0) {
                        *(GAS f32x4*)(kr + (size_t)row * 32 + 8 * fq) = a10; *(GAS f32x4*)(kr + (size_t)row * 32 + 8 * fq + 4) = a11;
                    }
                }
                EPI_FENCE();
            }
    }
};

struct EpiQ {
    static constexpr bool PERM = true, AFTER_DRAIN = false;
    unsigned char* ws;
    __device__ __forceinline__ void prefetch(const pg8::Unit&, int, int) const {}
    __device__ __forceinline__ void operator()(AccRef acc, const pg8::Unit& u, int wr, int wc, int fr_in, int fq_in) const {
        const int lane_e = pg8::lane_id_asm(); const int fr = lane_e & 15, fq = lane_e >> 4; (void)fr_in; (void)fq_in;
        unsigned long long wi_ = (unsigned long long)ws; asm volatile("" : "+s"(wi_)); GAS unsigned char* w = (GAS unsigned char*)wi_;
        const GAS float* ssq = (const GAS float*)(w + WS_SSQ); GAS bf16_t* Q = (GAS bf16_t*)(w + T_Q);
        const int rowb = u.pm * 256 + wr * 64 + fr;
        if (wc < 3) {
            float rs8[8];
            { f32x4 pp[8];
#pragma unroll
              for (int q = 0; q < 8; ++q) pp[q] = *(const GAS f32x4*)(ssq + (size_t)(rowb + (q >> 2) * 128 + (q & 3) * 16) * 4);
#pragma unroll
              for (int q = 0; q < 8; ++q) rs8[q] = rsqrtf(((pp[q][0] + pp[q][1]) + (pp[q][2] + pp[q][3])) * (1.0f / 256.0f) + EPS); }
            EPI_FENCE();
#pragma unroll
            for (int ai = 0; ai < 2; ++ai)
#pragma unroll
                for (int m = 0; m < 4; ++m) {
                    const int row = rowb + ai * 128 + m * 16, b = row >> 13, s = row & 8191;
                    const float rq = rs8[ai * 4 + m];
#pragma unroll
                    for (int bj = 0; bj < 2; ++bj) {
                        const int head = u.pn * 2 + bj;
                        *(GAS u32x4*)(Q + (unsigned)(((b * 16 + head) * SEQ + s) * 96 + wc * 32 + 8 * fq)) = pack8(acc[ai][bj][m][0] * rq, acc[ai][bj][m][1] * rq);
                    }
                    EPI_FENCE();
                }
        }
    }
};

struct EpiKV {
    static constexpr bool PERM = true, AFTER_DRAIN = false;
    unsigned char* ws; float* outp;
    __device__ __forceinline__ void prefetch(const pg8::Unit&, int, int) const {}
    __device__ __forceinline__ void operator()(AccRef acc, const pg8::Unit& u, int wr, int wc, int fr_in, int fq_in) const {
        const int lane_e = pg8::lane_id_asm(); const int fr = lane_e & 15, fq = lane_e >> 4; (void)fr_in; (void)fq_in;
        unsigned long long wi_ = (unsigned long long)ws; asm volatile("" : "+s"(wi_)); GAS unsigned char* w = (GAS unsigned char*)wi_;
        const GAS float* sskv = (const GAS float*)(w + WS_SSKV); GAS bf16_t* K = (GAS bf16_t*)(w + T_K); GAS bf16_t* Vt = (GAS bf16_t*)((GAS unsigned char*)(unsigned long long)outp + 64 * MiB);
        const int rowb = u.pm * 256 + wr * 64 + fr;
#pragma unroll
        for (int ai = 0; ai < 2; ++ai)
#pragma unroll
            for (int m = 0; m < 4; ++m) {
                const int row = rowb + ai * 128 + m * 16, b = row >> 13, s = row & 8191;
                const f32x4 pk = *(const GAS f32x4*)(sskv + (size_t)row * 4);
                const float r = rsqrtf(((pk[0] + pk[1]) + (pk[2] + pk[3])) * (1.0f / 128.0f) + EPS);
#pragma unroll
                for (int bj = 0; bj < 2; ++bj) {
                    const int head = u.pn * 2 + bj; const unsigned bh = (unsigned)(b * 16 + head);
                    const u32x4 wv = pack8(acc[ai][bj][m][0] * r, acc[ai][bj][m][1] * r);
                    if (wc < 2) {
                        *(GAS u32x4*)(K + ((bh * SEQ + s) * 96u + wc * 32 + 8 * fq)) = wv;
                    } else {
                        GAS bf16_t* vp = Vt + (bh * 64 + (wc - 2) * 32 + 8 * fq) * SEQ + s;
                        vp[0 * SEQ] = (bf16_t)(wv.x & 0xffff); vp[1 * SEQ] = (bf16_t)(wv.x >> 16); vp[2 * SEQ] = (bf16_t)(wv.y & 0xffff); vp[3 * SEQ] = (bf16_t)(wv.y >> 16);
                        vp[4 * SEQ] = (bf16_t)(wv.z & 0xffff); vp[5 * SEQ] = (bf16_t)(wv.z >> 16); vp[6 * SEQ] = (bf16_t)(wv.w & 0xffff); vp[7 * SEQ] = (bf16_t)(wv.w >> 16);
                    }
                }
                EPI_FENCE();
            }
    }
};

struct EpiSgIn {
    static constexpr bool PERM = true, AFTER_DRAIN = false;
    unsigned char* ws; LAS unsigned char* ldsE;
    __device__ __forceinline__ void prefetch(const pg8::Unit& u, int wid, int lane) const { ss_prefetch(ws, ldsE, u.pm, wid, lane); }
    __device__ __forceinline__ void operator()(AccRef acc, const pg8::Unit& u, int wr, int wc, int fr_in, int fq_in) const {
        const int lane_e = pg8::lane_id_asm(); const int fr = lane_e & 15, fq = lane_e >> 4; (void)fr_in; (void)fq_in;
        unsigned long long wi_ = (unsigned long long)ws; asm volatile("" : "+s"(wi_)); GAS unsigned char* w = (GAS unsigned char*)wi_;
        const GAS float* ss = (const GAS float*)(w + WS_SS); GAS bf16_t* U = (GAS bf16_t*)(w + T_Z); GAS bf16_t* V = (GAS bf16_t*)(w + T_BG); GAS float* ssv = (GAS float*)(w + WS_SSV);
        const int rowb = u.pm * 256 + wr * 64 + fr;
        GAS bf16_t* dstb = (u.pn < 4 ? U + u.pn * 256 : V + (u.pn - 4) * 256) + wc * 32 + 8 * fq;
        float rs8[8];
        { f32x4 pp[8];
#pragma unroll
          for (int q = 0; q < 8; ++q) pp[q] = *(const LAS f32x4*)(ldsE + ((q >> 2) * 128 + wr * 64 + (q & 3) * 16 + fr) * 64 + fq * 16);
#pragma unroll
          for (int q = 0; q < 8; ++q) rs8[q] = rsqrtf(red_fq((pp[q][0] + pp[q][1]) + (pp[q][2] + pp[q][3])) * (1.0f / 1024.0f) + EPS); }
        EPI_FENCE();
#pragma unroll
        for (int ai = 0; ai < 2; ++ai)
#pragma unroll
            for (int m = 0; m < 4; ++m) {
                const int row = rowb + ai * 128 + m * 16; const float rs = rs8[ai * 4 + m]; float sq = 0.f;
#pragma unroll
                for (int bj = 0; bj < 2; ++bj) {
                    f32x4 z0, z1;
#pragma unroll
                    for (int j = 0; j < 4; ++j) { z0[j] = gelu_tanh_f(acc[ai][bj][m][0][j] * rs); z1[j] = gelu_tanh_f(acc[ai][bj][m][1][j] * rs); }
                    *(GAS u32x4*)(dstb + (size_t)row * DM + bj * 128) = pack8(z0, z1);
                    sq += dot4(z0) + dot4(z1);
                }
                if (u.pn >= 4) { sq = red_fq(sq); if (fq == 0) ssv[(size_t)row * 16 + (u.pn - 4) * 4 + wc] = sq; } EPI_FENCE();
            }
    }
};

__device__ __forceinline__ int map_row(int kind, int n0) {
    switch (kind) {
        case 1: return (n0 >> 7) * 256 + (n0 & 127);
        case 2: return (n0 >> 7) * 256 + 128 + (n0 & 127);
        case 3: if (n0 < 1024) return 2048 + n0;
                if (n0 < 2048) { const int c = n0 - 1024; return (c >> 7) * 256 + (c & 127); }
                { const int c = n0 - 2048; return (c >> 7) * 256 + 128 + (c & 127); }
        case 4: return (n0 / 96) * 128 + (n0 % 96);
        default: return n0;
    }
}
__device__ __forceinline__ void tr_item(const float* __restrict__ W, int K, int N, bf16_t* __restrict__ WT, int pitch, const float* __restrict__ scale, int kind, LAS float* scr, int item, int lane) {
    const int nblk = N >> 5, kb = item / nblk, nb = item - kb * nblk, k0 = 64 * kb, n0 = 32 * nb, dr0 = map_row(kind, n0);
    {
        f32x4 v[8]; const int kr_ = lane >> 3, c4 = (lane & 7) * 4;
#pragma unroll
        for (int i = 0; i < 8; ++i) v[i] = *(const f32x4*)(W + (size_t)(k0 + 8 * i + kr_) * N + n0 + c4);
#pragma unroll
        for (int i = 0; i < 8; ++i) { const int kk = 8 * i + kr_; const float sc = scale ? scale[k0 + kk] : 1.0f;
            scr[kk * 33 + c4] = v[i][0] * sc; scr[kk * 33 + c4 + 1] = v[i][1] * sc; scr[kk * 33 + c4 + 2] = v[i][2] * sc; scr[kk * 33 + c4 + 3] = v[i][3] * sc; }
    }
    asm volatile("s_waitcnt lgkmcnt(0)" ::: "memory");
    const int c = lane & 7;
#pragma unroll
    for (int j = 0; j < 4; ++j) { const int n = (lane >> 3) + 8 * j; const LAS float* s = scr + (8 * c) * 33 + n;
        u32x4 o; o.x = cvtpk(s[0 * 33], s[1 * 33]); o.y = cvtpk(s[2 * 33], s[3 * 33]); o.z = cvtpk(s[4 * 33], s[5 * 33]); o.w = cvtpk(s[6 * 33], s[7 * 33]);
        *(u32x4*)(WT + (size_t)(dr0 + n) * pitch + k0 + 8 * c) = o; }
    asm volatile("s_waitcnt lgkmcnt(0)" ::: "memory");
}

struct Args {
    const float* in[22]; float* out; unsigned char* ws; float inv_freq[16]; int ph_lo, ph_hi;
};

__device__ __forceinline__ void prologue(const Args& a, LAS unsigned char* lds, int vcu, int G, int wave, int lane, int tid) {
    unsigned char* ws = a.ws;
    LAS float* scr = (LAS float*)(lds + wave * 16384);
    const int gw = vcu * NWAVES + wave, NGW = G * NWAVES;
    const float* norm_g = a.in[2];
    constexpr int I_FFN = 8 * 4224, I_CONV = 2 * 2048, I_MLA = 1040, I_SG = 1536, NITEMS = I_FFN + I_CONV + I_MLA + I_SG;
    for (int it = gw; it < NITEMS; it += NGW) {
        int r = it;
        if (r < I_FFN) {
            const int f = r / 4224, q = r % 4224, which = q / 1408, item = q % 1408, i = f >> 1, j = f & 1;
            bf16_t* wgu = (bf16_t*)(ws + ffn_w_off(f)); bf16_t* wd = wgu + (size_t)5632 * 1024;
            const float* g = norm_g + (size_t)(i * 3 + (j ? 2 : 0)) * 1024;
            if (which == 0) tr_item(a.in[3] + (size_t)f * 1024 * 2816, 1024, 2816, wgu, 1024, g, 1, scr, item, lane);
            else if (which == 1) tr_item(a.in[4] + (size_t)f * 1024 * 2816, 1024, 2816, wgu, 1024, g, 2, scr, item, lane);
            else tr_item(a.in[5] + (size_t)f * 2816 * 1024, 2816, 1024, wd, 2816, nullptr, 0, scr, item, lane);
            continue;
        }
        r -= I_FFN;
        if (r < I_CONV) {
            const int ia = r / 2048, q = r % 2048, li = ia == 0 ? 0 : 3;
            bf16_t* win = (bf16_t*)(ws + conv_w_off(ia)); bf16_t* wout = win + (size_t)3072 * 1024;
            if (q < 1536) tr_item(a.in[6] + (size_t)ia * 1024 * 3072, 1024, 3072, win, 1024, norm_g + (size_t)(li * 3 + 1) * 1024, 3, scr, q, lane);
            else tr_item(a.in[8] + (size_t)ia * 1024 * 1024, 1024, 1024, wout, 1024, nullptr, 0, scr, q - 1536, lane);
            continue;
        }
        r -= I_CONV;
        if (r < I_MLA) {
            if (r < 208) { tr_item(a.in[9], 1024, 416, (bf16_t*)(ws + W_MLA_A), 1024, norm_g + (size_t)(1 * 3 + 1) * 1024, 0, scr, r, lane); continue; }
            r -= 208;
            if (r < 192) { tr_item(a.in[11], 256, 1536, (bf16_t*)(ws + W_MLA_UQ), 256, a.in[10], 4, scr, r, lane); continue; }
            r -= 192;
            if (r < 128) { tr_item(a.in[13], 128, 2048, (bf16_t*)(ws + W_MLA_UKV), 256, a.in[12], 0, scr, r, lane); continue; }
            r -= 128;
            tr_item(a.in[16], 1024, 1024, (bf16_t*)(ws + W_MLA_O), 1024, nullptr, 0, scr, r, lane);
            continue;
        }
        r -= I_MLA;
        if (r < 1024) tr_item(a.in[17], 1024, 2048, (bf16_t*)(ws + W_SG_IN), 1024, norm_g + (size_t)(2 * 3 + 1) * 1024, 0, scr, r, lane);
        else tr_item(a.in[21], 1024, 1024, (bf16_t*)(ws + W_SG_OUT), 1024, nullptr, 0, scr, r - 1024, lane);
    }
    const int gt = vcu * NTHREADS + tid, NGT = G * NTHREADS;
    const u32x4 z4 = {0u, 0u, 0u, 0u};
    for (int p = gt; p < 12288; p += NGT) *(u32x4*)(ws + W_MLA_A + (size_t)416 * 2048 + (size_t)p * 16) = z4;
    for (int p = gt; p < 16384; p += NGT) { const int h = p >> 10, off = p & 1023; *(u32x4*)(ws + W_MLA_UQ + (size_t)(128 * h + 96) * 512 + (size_t)off * 16) = z4; }
    for (int p = gt; p < 32768; p += NGT) { const int row = p >> 4, c = p & 15; *(u32x4*)(ws + W_MLA_UKV + (size_t)row * 512 + 256 + c * 16) = z4; }
    for (int p = gt; p < 16384; p += NGT) {
        const int t = (p >> 4) & 127, s0 = (p & 15) * 8; const float* src = a.in[19] + (size_t)p * 8;
        const f32x4 w0 = *(const f32x4*)src, w1 = *(const f32x4*)(src + 4); f32x4 m0, m1;
#pragma unroll
        for (int j = 0; j < 4; ++j) { m0[j] = (s0 + j <= t) ? w0[j] : 0.f; m1[j] = (s0 + 4 + j <= t) ? w1[j] : 0.f; }
        *(u32x4*)(ws + W_SG_S + (size_t)p * 16) = pack8(m0, m1);
    }
    {
        const int* pos = (const int*)a.in[1]; float* cosT = (float*)(ws + WS_COS); float* sinT = (float*)(ws + WS_SIN);
        for (int p = gt; p < M_TOK * 16; p += NGT) {
            const int row = p >> 4, i = p & 15; const float ang = (float)pos[row] * a.inv_freq[i];
            const double ad = (double)ang, k = rint(ad * 0.15915494309189535); const float rr = (float)(ad - k * 6.283185307179586);
            cosT[p] = cosf(rr); sinT[p] = sinf(rr);
        }
    }
    {
        const float* x = a.in[0]; bf16_t* xb = (bf16_t*)(ws + WS_XB); float* ss = (float*)(ws + WS_SS);
        for (int row = gw; row < M_TOK; row += NGW) {
            const f32x4* xr = (const f32x4*)(x + (size_t)row * DM) + lane; f32x4 v[4]; float s = 0.f;
#pragma unroll
            for (int j = 0; j < 4; ++j) { v[j] = xr[64 * j]; s += dot4(v[j]); }
            s = wave_sum(s);
            u32x2* o = (u32x2*)(xb + (size_t)row * DM) + lane;
#pragma unroll
            for (int j = 0; j < 4; ++j) { u32x2 w; w.x = cvtpk(v[j][0], v[j][1]); w.y = cvtpk(v[j][2], v[j][3]); o[64 * j] = w; }
            if (lane < 16) ss[(size_t)row * 16 + lane] = lane == 0 ? s : 0.f;
        }
    }
}

__device__ __forceinline__ void unpack8(u32x4 w, float (&f)[8]) { f[0] = bf_lo(w.x); f[1] = bf_hi(w.x); f[2] = bf_lo(w.y); f[3] = bf_hi(w.y); f[4] = bf_lo(w.z); f[5] = bf_hi(w.z); f[6] = bf_lo(w.w); f[7] = bf_hi(w.w); }
__device__ __forceinline__ void conv_phase(const bf16_t* __restrict__ Z, const bf16_t* __restrict__ Bg, const float* __restrict__ ck, bf16_t* __restrict__ Gout, int gt, int NGT) {
    for (int it = gt; it < 2048 * 128; it += NGT) {
        const int cg8 = (it & 127) * 8, row0 = (it >> 7) * 16;
        float k0[8], k1[8], k2[8], zm2[8], zm1[8];
        { const f32x4 a0 = *(const f32x4*)(ck + cg8), a1 = *(const f32x4*)(ck + cg8 + 4), b0 = *(const f32x4*)(ck + 1024 + cg8), b1 = *(const f32x4*)(ck + 1024 + cg8 + 4), c0 = *(const f32x4*)(ck + 2048 + cg8), c1 = *(const f32x4*)(ck + 2048 + cg8 + 4);
#pragma unroll
          for (int j = 0; j < 4; ++j) { k0[j] = a0[j]; k0[4 + j] = a1[j]; k1[j] = b0[j]; k1[4 + j] = b1[j]; k2[j] = c0[j]; k2[4 + j] = c1[j]; } }
        if ((row0 & 8191) == 0) {
#pragma unroll
            for (int j = 0; j < 8; ++j) { zm2[j] = 0.f; zm1[j] = 0.f; }
        } else {
            unpack8(*(const u32x4*)(Z + (size_t)(row0 - 2) * DM + cg8), zm2); unpack8(*(const u32x4*)(Z + (size_t)(row0 - 1) * DM + cg8), zm1);
        }
#pragma unroll 4
        for (int r = 0; r < 16; ++r) {
            const size_t off = (size_t)(row0 + r) * DM + cg8; float z[8], b[8]; f32x4 o0, o1;
            unpack8(*(const u32x4*)(Z + off), z); unpack8(*(const u32x4*)(Bg + off), b);
#pragma unroll
            for (int j = 0; j < 4; ++j) { o0[j] = b[j] * (k0[j] * zm2[j] + k1[j] * zm1[j] + k2[j] * z[j]); o1[j] = b[4 + j] * (k0[4 + j] * zm2[4 + j] + k1[4 + j] * zm1[4 + j] + k2[4 + j] * z[4 + j]); }
            *(u32x4*)(Gout + off) = pack8(o0, o1);
#pragma unroll
            for (int j = 0; j < 8; ++j) { zm2[j] = zm1[j]; zm1[j] = z[j]; }
        }
    }
}

__device__ __forceinline__ void sg_phase(LAS unsigned char* lds, const bf16_t* __restrict__ U, const bf16_t* __restrict__ V, const float* __restrict__ ssv, const float* __restrict__ vnorm,
                                         const bf16_t* __restrict__ wsm, const float* __restrict__ bs, bf16_t* __restrict__ G2, int vcu, int G, const int wave_s) {
    constexpr int ROWB = 272, BOFF = 128 * ROWB;
    const int lane = pg8::lane_id_asm(), wid = wave_s, tid = wid * 64 + lane, fr = lane & 15, fq = lane >> 4;
    for (int u = vcu; u < 2048; u += G) {
        const int c = u >> 3, g = u & 7;
        for (int p = tid; p < 2048; p += NTHREADS) { const int t = p >> 4, cc = p & 15; *(LAS u32x4*)(lds + t * ROWB + cc * 16) = *(const u32x4*)(wsm + (size_t)g * 16384 + t * 128 + cc * 8); }
        for (int p = tid; p < 2048; p += NTHREADS) {
            const int s = p >> 4, cg8 = (p & 15) * 8, row = 128 * c + s;
            float v[8]; unpack8(*(const u32x4*)(V + (size_t)row * DM + 128 * g + cg8), v);
            const f32x4* sp = (const f32x4*)(ssv + (size_t)row * 16); const f32x4 a0 = sp[0], a1 = sp[1], a2 = sp[2], a3 = sp[3];
            const float tot = ((a0[0] + a0[1]) + (a0[2] + a0[3])) + ((a1[0] + a1[1]) + (a1[2] + a1[3])) + ((a2[0] + a2[1]) + (a2[2] + a2[3])) + ((a3[0] + a3[1]) + (a3[2] + a3[3]));
            const float rsv = rsqrtf(tot * (1.0f / 1024.0f) + EPS);
            const f32x4 n0 = *(const f32x4*)(vnorm + 128 * g + cg8), n1 = *(const f32x4*)(vnorm + 128 * g + cg8 + 4);
#pragma unroll
            for (int j = 0; j < 4; ++j) {
                const unsigned w = cvtpk(v[j] * rsv * n0[j], v[4 + j] * rsv * n1[j]);
                *(LAS bf16_t*)(lds + BOFF + (cg8 + j) * ROWB + s * 2) = (bf16_t)(w & 0xffff);
                *(LAS bf16_t*)(lds + BOFF + (cg8 + 4 + j) * ROWB + s * 2) = (bf16_t)(w >> 16);
            }
        }
        __syncthreads();
        f32x4 acc[8];
#pragma unroll
        for (int nb = 0; nb < 8; ++nb) acc[nb] = (f32x4){0.f, 0.f, 0.f, 0.f};
#pragma unroll
        for (int ks = 0; ks < 4; ++ks) {
            const bf16x8 wa = *(const LAS bf16x8*)(lds + (16 * wid + fr) * ROWB + (32 * ks + 8 * fq) * 2);
#pragma unroll
            for (int nb = 0; nb < 8; ++nb) {
                const bf16x8 vb = *(const LAS bf16x8*)(lds + BOFF + (16 * nb + fr) * ROWB + (32 * ks + 8 * fq) * 2);
                acc[nb] = __builtin_amdgcn_mfma_f32_16x16x32_bf16(vb, wa, acc[nb], 0, 0, 0);
            }
        }
        {
            const int t = 16 * wid + fr, row = 128 * c + t; const float bias = bs[g * 128 + t];
#pragma unroll
            for (int nb = 0; nb < 8; ++nb) {
                const size_t off = (size_t)row * DM + 128 * g + 16 * nb + 4 * fq;
                const u32x2 uu = *(const u32x2*)(U + off);
                u32x2 o; o.x = cvtpk(bf_lo(uu.x) * (acc[nb][0] + bias), bf_hi(uu.x) * (acc[nb][1] + bias)); o.y = cvtpk(bf_lo(uu.y) * (acc[nb][2] + bias), bf_hi(uu.y) * (acc[nb][3] + bias));
                *(u32x2*)(G2 + off) = o;
            }
        }
        __syncthreads();
    }
}

__device__ __forceinline__ void qk_finalize(bf16_t* __restrict__ Q, bf16_t* __restrict__ K, const float* __restrict__ kpe, const float* __restrict__ qgain, const float* __restrict__ kgain,
                                            const float* __restrict__ cosT, const float* __restrict__ sinT, int gt, int NGT) {
    for (int it = 16 * M_TOK + gt; it < 2 * 16 * M_TOK; it += NGT) {
        const bool isk = it >= 16 * M_TOK; const int rh = isk ? it - 16 * M_TOK : it;
        const int bh = rh >> 13, s = rh & 8191, row = (bh >> 4) * SEQ + s;
        bf16_t* p = (isk ? K : Q) + (size_t)rh * 96; const float* gain = isk ? kgain : qgain;
        float v[96];
        if (!isk) {
#pragma unroll
            for (int c = 0; c < 12; ++c) { const u32x4 w = *(const u32x4*)(p + 8 * c); v[8 * c] = bf_lo(w.x); v[8 * c + 1] = bf_hi(w.x); v[8 * c + 2] = bf_lo(w.y); v[8 * c + 3] = bf_hi(w.y); v[8 * c + 4] = bf_lo(w.z); v[8 * c + 5] = bf_hi(w.z); v[8 * c + 6] = bf_lo(w.w); v[8 * c + 7] = bf_hi(w.w); }
        } else {
#pragma unroll
            for (int c = 0; c < 8; ++c) { const u32x4 w = *(const u32x4*)(p + 8 * c); v[8 * c] = bf_lo(w.x); v[8 * c + 1] = bf_hi(w.x); v[8 * c + 2] = bf_lo(w.y); v[8 * c + 3] = bf_hi(w.y); v[8 * c + 4] = bf_lo(w.z); v[8 * c + 5] = bf_hi(w.z); v[8 * c + 6] = bf_lo(w.w); v[8 * c + 7] = bf_hi(w.w); }
#pragma unroll
            for (int c = 0; c < 8; ++c) { const f32x4 w = *(const f32x4*)(kpe + (size_t)row * 32 + 4 * c); v[64 + 4 * c] = w[0]; v[64 + 4 * c + 1] = w[1]; v[64 + 4 * c + 2] = w[2]; v[64 + 4 * c + 3] = w[3]; }
        }
        float ss = 0.f;
#pragma unroll
        for (int d = 0; d < 96; ++d) ss += v[d] * v[d];
        const float rsh = rsqrtf(ss * (1.0f / 96.0f) + EPS), osc = isk ? 1.0f : QSCALE;
#pragma unroll
        for (int d = 0; d < 96; ++d) v[d] *= rsh * gain[d];
#pragma unroll
        for (int c = 0; c < 4; ++c) {
            const f32x4 cs = *(const f32x4*)(cosT + (size_t)row * 16 + 4 * c), sn = *(const f32x4*)(sinT + (size_t)row * 16 + 4 * c);
#pragma unroll
            for (int j = 0; j < 4; ++j) { const int i = 4 * c + j; const float t1 = v[64 + i], t2 = v[80 + i]; v[64 + i] = t1 * cs[j] - t2 * sn[j]; v[80 + i] = t2 * cs[j] + t1 * sn[j]; }
        }
#pragma unroll
        for (int c = 0; c < 12; ++c) {
            u32x4 w; w.x = cvtpk(v[8 * c] * osc, v[8 * c + 1] * osc); w.y = cvtpk(v[8 * c + 2] * osc, v[8 * c + 3] * osc); w.z = cvtpk(v[8 * c + 4] * osc, v[8 * c + 5] * osc); w.w = cvtpk(v[8 * c + 6] * osc, v[8 * c + 7] * osc);
            *(u32x4*)(p + 8 * c) = w;
        }
    }
}

__device__ __forceinline__ float max3f_(float a, float b, float c) { return __builtin_fmaxf(__builtin_fmaxf(a, b), c); }
struct AttRegs { u32x4 k0, k1, v; };
#define ATT_BAR() asm volatile("s_waitcnt lgkmcnt(0)\n\ts_barrier" ::: "memory")
__device__ __forceinline__ void att_qk(const LAS unsigned char* kb, const bf16x8 (&qf)[6], f32x16& p0, f32x16& p1) {
    constexpr int KROW = 208;
    bf16x8 kf[12];
#pragma unroll
    for (int ds = 0; ds < 6; ++ds) { kf[2 * ds] = *(const LAS bf16x8*)(kb + ds * 32); kf[2 * ds + 1] = *(const LAS bf16x8*)(kb + 32 * KROW + ds * 32); }
#pragma unroll
    for (int r = 0; r < 16; ++r) { p0[r] = 0.f; p1[r] = 0.f; }
    __builtin_amdgcn_sched_barrier(0);
#pragma unroll
    for (int ds = 0; ds < 6; ++ds) {
        p0 = __builtin_amdgcn_mfma_f32_32x32x16_bf16(kf[2 * ds], qf[ds], p0, 0, 0, 0);
        p1 = __builtin_amdgcn_mfma_f32_32x32x16_bf16(kf[2 * ds + 1], qf[ds], p1, 0, 0, 0);
    }
    __builtin_amdgcn_sched_barrier(0);
}
template <bool NOMAX> __device__ __forceinline__ void att_soft_pv(const LAS unsigned char* vb, f32x16& p0, f32x16& p1, f32x16& o0, f32x16& o1, float& m_ref, float& l_run, int t, int qw0, int qabs, int hi) {
    constexpr int VROW = 136; constexpr float THR = 8.0f;
    s16x4 va[8], vb2[8];
#pragma unroll
    for (int ks = 0; ks < 4; ++ks) {
        va[2 * ks] = *(const LAS s16x4*)(vb + ks * 32); vb2[2 * ks] = *(const LAS s16x4*)(vb + ks * 32 + 16);
        va[2 * ks + 1] = *(const LAS s16x4*)(vb + 32 * VROW + ks * 32); vb2[2 * ks + 1] = *(const LAS s16x4*)(vb + 32 * VROW + ks * 32 + 16);
    }
    __builtin_amdgcn_sched_barrier(0);
    if (64 * t + 63 > qw0) {
        asm volatile("" ::: "memory");
#pragma unroll
        for (int r = 0; r < 16; ++r) { const int kv = 64 * t + (r & 3) + 8 * (r >> 2) + 4 * hi; if (kv > qabs) p0[r] = -INFINITY; if (kv + 32 > qabs) p1[r] = -INFINITY; }
    }
    if constexpr (!NOMAX) {
        float ma = max3f_(p0[0], p0[1], p1[0]), mb = max3f_(p0[2], p0[3], p1[1]); ma = max3f_(ma, p1[2], p1[3]);
#pragma unroll
        for (int r = 4; r < 16; r += 4) { ma = max3f_(ma, p0[r], p0[r + 1]); mb = max3f_(mb, p0[r + 2], p0[r + 3]); ma = max3f_(ma, p1[r], p1[r + 1]); mb = max3f_(mb, p1[r + 2], p1[r + 3]); }
        float mx = __builtin_fmaxf(ma, mb);
        { auto rr = __builtin_amdgcn_permlane32_swap(__float_as_uint(mx), __float_as_uint(mx), false, false); mx = __builtin_fmaxf(__uint_as_float(rr[0]), __uint_as_float(rr[1])); }
        if (__any(mx > m_ref + THR)) {
            const float mnew = __builtin_fmaxf(m_ref, mx), alpha = __builtin_amdgcn_exp2f(m_ref - mnew); m_ref = mnew; l_run *= alpha;
            o0 = o0 * alpha; o1 = o1 * alpha;
        }
        { const float negm = -m_ref; p0 = p0 + negm; p1 = p1 + negm; }
    }
#pragma unroll
    for (int r = 0; r < 16; ++r) { p0[r] = __builtin_amdgcn_exp2f(p0[r]); p1[r] = __builtin_amdgcn_exp2f(p1[r]); }
    { const f32x16 sv = p0 + p1; l_run += ((sv[0] + sv[1]) + (sv[2] + sv[3])) + ((sv[4] + sv[5]) + (sv[6] + sv[7])) + ((sv[8] + sv[9]) + (sv[10] + sv[11])) + ((sv[12] + sv[13]) + (sv[14] + sv[15])); }
    u32x4 pb[4];
    pb[0] = (u32x4){cvtpk(p0[0], p0[1]), cvtpk(p0[2], p0[3]), cvtpk(p0[4], p0[5]), cvtpk(p0[6], p0[7])};
    pb[1] = (u32x4){cvtpk(p0[8], p0[9]), cvtpk(p0[10], p0[11]), cvtpk(p0[12], p0[13]), cvtpk(p0[14], p0[15])};
    pb[2] = (u32x4){cvtpk(p1[0], p1[1]), cvtpk(p1[2], p1[3]), cvtpk(p1[4], p1[5]), cvtpk(p1[6], p1[7])};
    pb[3] = (u32x4){cvtpk(p1[8], p1[9]), cvtpk(p1[10], p1[11]), cvtpk(p1[12], p1[13]), cvtpk(p1[14], p1[15])};
    __builtin_amdgcn_sched_barrier(0);
#pragma unroll
    for (int ks = 0; ks < 4; ++ks) {
        const bf16x8 pf = __builtin_bit_cast(bf16x8, pb[ks]);
        { const s16x4 a = va[2 * ks], b = vb2[2 * ks];
          const bf16x8 vf = {a[0], a[1], a[2], a[3], b[0], b[1], b[2], b[3]};
          o0 = __builtin_amdgcn_mfma_f32_32x32x16_bf16(vf, pf, o0, 0, 0, 0); }
        { const s16x4 a = va[2 * ks + 1], b = vb2[2 * ks + 1];
          const bf16x8 vf = {a[0], a[1], a[2], a[3], b[0], b[1], b[2], b[3]};
          o1 = __builtin_amdgcn_mfma_f32_32x32x16_bf16(vf, pf, o1, 0, 0, 0); }
    }
}
struct AttK { u32x4 k0, k1; };
template <bool NOMAX> __device__ __forceinline__ void attn_units(LAS unsigned char* lds, const bf16_t* __restrict__ Q, const bf16_t* __restrict__ K, const bf16_t* __restrict__ Vt, bf16_t* __restrict__ O, const float* __restrict__ qgain, const float* __restrict__ cosT, const float* __restrict__ sinT, int vcu, int G, const int wave_s) {
    constexpr int KROW = 208, VROW = 136, KBUF = 64 * KROW, VBUF = 64 * VROW, VOFF = 2 * KBUF;
    const int lane = pg8::lane_id_asm(), wid = wave_s, tid = wid * 64 + lane, r32 = lane & 31, hi = lane >> 5;
    const int kp0r = tid / 12, kp0c = tid % 12, kp1r = (512 + tid) / 12, kp1c = (512 + tid) % 12, vdv = tid >> 3, vc = tid & 7;
    for (int u = vcu; u < 2048; u += G) {
        const int v = u & 255, i = u >> 8, bh = v >> 2, s4 = v & 3, pr = i >> 1, qb = (i & 1) ? 8 * pr + 7 - s4 : 8 * pr + s4;
        const int q0 = qb * 256, NT = (q0 + 256) / 64, qw0 = q0 + 32 * wid, qabs = qw0 + r32;
        const bf16_t* Qp = Q + ((size_t)bh * SEQ + qabs) * 96 + 8 * hi;
        bf16x8 qf[6];
#pragma unroll
        for (int ds = 0; ds < 6; ++ds) qf[ds] = *(const bf16x8*)(Qp + 16 * ds);
        {
            float ssq_ = 0.f;
#pragma unroll
            for (int ds = 0; ds < 6; ++ds) { const u32x4 w = __builtin_bit_cast(u32x4, qf[ds]);
                const float a0 = bf_lo(w.x), a1 = bf_hi(w.x), a2 = bf_lo(w.y), a3 = bf_hi(w.y), a4 = bf_lo(w.z), a5 = bf_hi(w.z), a6 = bf_lo(w.w), a7 = bf_hi(w.w);
                ssq_ += ((a0 * a0 + a1 * a1) + (a2 * a2 + a3 * a3)) + ((a4 * a4 + a5 * a5) + (a6 * a6 + a7 * a7)); }
            { auto rr = __builtin_amdgcn_permlane32_swap(__float_as_uint(ssq_), __float_as_uint(ssq_), false, false); ssq_ = __uint_as_float(rr[0]) + __uint_as_float(rr[1]); }
            float rq = rsqrtf(ssq_ * (1.0f / 96.0f) + EPS) * QSCALE; asm volatile("" : "+v"(rq));
#pragma unroll
            for (int ds = 0; ds < 6; ++ds) asm volatile("" : "+v"(qf[ds]));
#pragma unroll
            for (int ds = 0; ds < 4; ++ds) {
                const u32x4 w = __builtin_bit_cast(u32x4, qf[ds]);
                const f32x4 g0 = *(const f32x4*)(qgain + 16 * ds + 8 * hi), g1 = *(const f32x4*)(qgain + 16 * ds + 8 * hi + 4);
                u32x4 o; o.x = cvtpk(bf_lo(w.x) * g0[0] * rq, bf_hi(w.x) * g0[1] * rq); o.y = cvtpk(bf_lo(w.y) * g0[2] * rq, bf_hi(w.y) * g0[3] * rq);
                o.z = cvtpk(bf_lo(w.z) * g1[0] * rq, bf_hi(w.z) * g1[1] * rq); o.w = cvtpk(bf_lo(w.w) * g1[2] * rq, bf_hi(w.w) * g1[3] * rq);
                qf[ds] = __builtin_bit_cast(bf16x8, o);
                asm volatile("" ::: "memory");
            }
            {
                const u32x4 w1 = __builtin_bit_cast(u32x4, qf[4]), w2 = __builtin_bit_cast(u32x4, qf[5]);
                const size_t trow = (size_t)((bh >> 4) * SEQ + qabs) * 16 + 8 * hi;
                u32x4 p1, p2;
                {   const f32x4 ga = *(const f32x4*)(qgain + 64 + 8 * hi), gb = *(const f32x4*)(qgain + 80 + 8 * hi), c = *(const f32x4*)(cosT + trow), sn = *(const f32x4*)(sinT + trow);
                    const f32x4 t1 = {bf_lo(w1.x) * ga[0], bf_hi(w1.x) * ga[1], bf_lo(w1.y) * ga[2], bf_hi(w1.y) * ga[3]}, t2 = {bf_lo(w2.x) * gb[0], bf_hi(w2.x) * gb[1], bf_lo(w2.y) * gb[2], bf_hi(w2.y) * gb[3]};
                    const f32x4 o1 = (t1 * c - t2 * sn) * rq, o2 = (t2 * c + t1 * sn) * rq;
                    p1.x = cvtpk(o1[0], o1[1]); p1.y = cvtpk(o1[2], o1[3]); p2.x = cvtpk(o2[0], o2[1]); p2.y = cvtpk(o2[2], o2[3]); }
                asm volatile("" ::: "memory");
                {   const f32x4 ga = *(const f32x4*)(qgain + 64 + 8 * hi + 4), gb = *(const f32x4*)(qgain + 80 + 8 * hi + 4), c = *(const f32x4*)(cosT + trow + 4), sn = *(const f32x4*)(sinT + trow + 4);
                    const f32x4 t1 = {bf_lo(w1.z) * ga[0], bf_hi(w1.z) * ga[1], bf_lo(w1.w) * ga[2], bf_hi(w1.w) * ga[3]}, t2 = {bf_lo(w2.z) * gb[0], bf_hi(w2.z) * gb[1], bf_lo(w2.w) * gb[2], bf_hi(w2.w) * gb[3]};
                    const f32x4 o1 = (t1 * c - t2 * sn) * rq, o2 = (t2 * c + t1 * sn) * rq;
                    p1.z = cvtpk(o1[0], o1[1]); p1.w = cvtpk(o1[2], o1[3]); p2.z = cvtpk(o2[0], o2[1]); p2.w = cvtpk(o2[2], o2[3]); }
                qf[4] = __builtin_bit_cast(bf16x8, p1); qf[5] = __builtin_bit_cast(bf16x8, p2);
            }
        }
        const bf16_t* Kb = K + (size_t)bh * SEQ * 96; const bf16_t* Vb = Vt + (size_t)bh * 64 * SEQ + (size_t)vdv * SEQ + vc * 8;
        AttK Kx; Kx.k1 = (u32x4){0u, 0u, 0u, 0u}; u32x4 Vx;
#define LDK(R, t) do { const bf16_t* kt_ = Kb + (size_t)(t) * 6144; R.k0 = *(const u32x4*)(kt_ + tid * 8); if (tid < 256) R.k1 = *(const u32x4*)(kt_ + (512 + tid) * 8); } while (0)
#define LDV(R, t) do { R = *(const u32x4*)(Vb + (t) * 64); } while (0)
#define STK(R, sl) do { LAS unsigned char* kb_ = lds + (sl) * KBUF; *(LAS u32x4*)(kb_ + kp0r * KROW + kp0c * 16) = R.k0; if (tid < 256) *(LAS u32x4*)(kb_ + kp1r * KROW + kp1c * 16) = R.k1; } while (0)
#define STV(R, sl) do { LAS unsigned char* vb_ = lds + VOFF + (sl) * VBUF + vdv * VROW + vc * 16; *(LAS u32x2*)(vb_) = (u32x2){R.x, R.y}; *(LAS u32x2*)(vb_ + 8) = (u32x2){R.z, R.w}; } while (0)
#define ACT(t) (64 * (t) <= qw0 + 31)
        float m_ref = -INFINITY, l_run = 0.f; f32x16 o0, o1, sA0, sA1, sB0, sB1;
#pragma unroll
        for (int r = 0; r < 16; ++r) { o0[r] = 0.f; o1[r] = 0.f; }
        const LAS unsigned char* kbase = lds + r32 * KROW + hi * 16; const LAS unsigned char* vbase = lds + VOFF + r32 * VROW + hi * 8;
        LDK(Kx, 0); LDV(Vx, 0); STK(Kx, 0); STV(Vx, 0); LDK(Kx, 1); STK(Kx, 1);
        ATT_BAR();
        att_qk(kbase, qf, sA0, sA1);
        ATT_BAR();
        for (int t = 0; t < NT; t += 2) {
            if (t + 2 < NT) LDK(Kx, t + 2);
            LDV(Vx, t + 1);
            if (ACT(t + 1)) att_qk(kbase + KBUF, qf, sB0, sB1);
            if (ACT(t)) att_soft_pv<NOMAX>(vbase, sA0, sA1, o0, o1, m_ref, l_run, t, qw0, qabs, hi);
            if (t + 2 < NT) STK(Kx, 0);
            STV(Vx, 1);
            ATT_BAR();
            if (t + 3 < NT) LDK(Kx, t + 3);
            if (t + 2 < NT) LDV(Vx, t + 2);
            if (t + 2 < NT && ACT(t + 2)) att_qk(kbase, qf, sA0, sA1);
            if (ACT(t + 1)) att_soft_pv<NOMAX>(vbase + VBUF, sB0, sB1, o0, o1, m_ref, l_run, t + 1, qw0, qabs, hi);
            if (t + 3 < NT) STK(Kx, 1);
            if (t + 2 < NT) STV(Vx, 0);
            ATT_BAR();
        }
        {
            float lt = l_run; { auto rr = __builtin_amdgcn_permlane32_swap(__float_as_uint(lt), __float_as_uint(lt), false, false); lt = __uint_as_float(rr[0]) + __uint_as_float(rr[1]); }
            const float inv = 1.0f / lt;
            const int b = bh >> 4, h = bh & 15;
            bf16_t* Op = O + ((size_t)(b * SEQ + qabs)) * DM + h * 64 + 4 * hi;
#pragma unroll
            for (int rg = 0; rg < 4; ++rg) {
                u32x2 w0; w0.x = cvtpk(o0[4 * rg] * inv, o0[4 * rg + 1] * inv); w0.y = cvtpk(o0[4 * rg + 2] * inv, o0[4 * rg + 3] * inv);
                u32x2 w1; w1.x = cvtpk(o1[4 * rg] * inv, o1[4 * rg + 1] * inv); w1.y = cvtpk(o1[4 * rg + 2] * inv, o1[4 * rg + 3] * inv);
                *(u32x2*)(Op + 8 * rg) = w0; *(u32x2*)(Op + 32 + 8 * rg) = w1;
            }
        }
    }
#undef LDK
#undef LDV
#undef STK
#undef STV
#undef ACT
}
__device__ __forceinline__ void attn_phase(LAS unsigned char* lds, const bf16_t* __restrict__ Q, const bf16_t* __restrict__ K, const bf16_t* __restrict__ Vt, bf16_t* __restrict__ O, const float* __restrict__ qgain, const float* __restrict__ kgain, const float* __restrict__ cosT, const float* __restrict__ sinT, int vcu, int G, const int wave_s) {
    bool fast;
    { const int lane = pg8::lane_id_asm(); float gq = fabsf(qgain[lane]), gk = fabsf(kgain[lane]);
      if (lane < 32) { gq = fmaxf(gq, fabsf(qgain[64 + lane])); gk = fmaxf(gk, fabsf(kgain[64 + lane])); }
#pragma unroll
      for (int o = 1; o < 64; o <<= 1) { gq = fmaxf(gq, __shfl_xor(gq, o)); gk = fmaxf(gk, __shfl_xor(gk, o)); }
      fast = __builtin_amdgcn_readfirstlane((int)(14.14f * gq * gk < 60.0f)) != 0; }
    if (fast) attn_units<true>(lds, Q, K, Vt, O, qgain, cosT, sinT, vcu, G, wave_s); else attn_units<false>(lds, Q, K, Vt, O, qgain, cosT, sinT, vcu, G, wave_s);
    __builtin_amdgcn_s_waitcnt(0);
    {
    }
}

#define RLX_AGENT __ATOMIC_RELAXED, __HIP_MEMORY_SCOPE_AGENT
#define LDS_WAIT() asm volatile("s_waitcnt lgkmcnt(0)" ::: "memory")
#define VM_WAIT() asm volatile("s_waitcnt vmcnt(0)" ::: "memory")
__device__ __forceinline__ unsigned long long rt() { return __builtin_amdgcn_s_memrealtime(); }
__device__ __forceinline__ unsigned f2bf(float f) { unsigned u = __builtin_bit_cast(unsigned, f); return (u + 0x7fffu + ((u >> 16) & 1u)) >> 16; }
__device__ __forceinline__ unsigned pk2(float lo, float hi) { return f2bf(lo) | (f2bf(hi) << 16); }

#define XB_TMO      128
#define XB_XCNT(j)  (256  + 64 * (j))
#define XB_XSUB(j)  (1280 + 64 * (j))
#define XB_XGEN(j)  (2304 + 64 * (j))
#define XB_TOP      3328
#define XB_TOPGEN   3392
#define XCD_BAR_WORDS 3456
#define XB_SPIN_CAP (1u << 18)

__device__ __forceinline__ unsigned xb_ld(unsigned* p)              { return __hip_atomic_load(p, __ATOMIC_RELAXED, __HIP_MEMORY_SCOPE_AGENT); }
__device__ __forceinline__ unsigned xb_add(unsigned* p, unsigned v) { return __hip_atomic_fetch_add(p, v, __ATOMIC_RELAXED, __HIP_MEMORY_SCOPE_AGENT); }
__device__ __forceinline__ unsigned xb_xcc_id() { return (unsigned)__builtin_amdgcn_s_getreg((3 << 11) | 20) & 0xFu; }
#define XB_SPIN(cond, bar) do { unsigned _sp = 0; while (cond) { __builtin_amdgcn_s_sleep(1); \
    if ((++_sp & 255u) == 0u) { if (xb_ld(&(bar)[XB_TMO])) break; if (_sp > XB_SPIN_CAP) { atomicAdd(&(bar)[XB_TMO], 1u); break; } } } } while (0)

struct XcdBarrier {
    unsigned* bar; unsigned x;
    volatile LAS unsigned* st;
};

__device__ __forceinline__ XcdBarrier xcd_barrier_post(unsigned* bar, volatile LAS unsigned* st) {
    XcdBarrier b; b.bar = bar; b.x = xb_xcc_id(); b.st = st;
    if (threadIdx.x == 0) (void)xb_add(&bar[XB_XCNT(b.x)], 1u);
    return b;
}
__device__ __forceinline__ void xcd_barrier_complete(unsigned* bar, unsigned x, unsigned& nloc, unsigned& nx) {
    const unsigned G = gridDim.x * gridDim.y * gridDim.z;
    unsigned sum, cnt, mine, sp = 0u;
    for (;;) {
        sum = 0u; cnt = 0u; mine = 0u;
#pragma unroll
        for (unsigned j = 0; j < 16; ++j) { const unsigned c = xb_ld(&bar[XB_XCNT(j)]); sum += c; cnt += (c > 0u) ? 1u : 0u; mine = (j == x) ? c : mine; }
        if (sum == G) break;
        __builtin_amdgcn_s_sleep(1);
        if ((++sp & 255u) == 0u) { if (xb_ld(&bar[XB_TMO])) break; if (sp > XB_SPIN_CAP) { atomicAdd(&bar[XB_TMO], 1u); break; } }
    }
    nloc = mine > 0u ? mine : 1u; nx = cnt > 0u ? cnt : 1u;
}

__device__ __forceinline__ void xcd_barrier(const XcdBarrier& b) {
    asm volatile("s_waitcnt vmcnt(0)" ::: "memory");
    __syncthreads();
    if (threadIdx.x == 0) {
        unsigned* bar = b.bar;
        __builtin_amdgcn_s_waitcnt(0);
        unsigned nloc = b.st[0], nx = b.st[1];
        if (nloc == 0u) { xcd_barrier_complete(bar, b.x, nloc, nx); b.st[0] = nloc; b.st[1] = nx; }
        const unsigned old = xb_add(&bar[XB_XSUB(b.x)], 1u);
        const unsigned gen = old / nloc;
        if (old + 1u == (gen + 1u) * nloc) {
            __builtin_amdgcn_fence(__ATOMIC_RELEASE, "agent");
            asm volatile("s_waitcnt vmcnt(0)" ::: "memory");
            const unsigned og = xb_add(&bar[XB_TOP], 1u);
            const unsigned tg = og / nx;
            if (og + 1u == (tg + 1u) * nx) xb_add(&bar[XB_TOPGEN], 1u);
            else XB_SPIN(xb_ld(&bar[XB_TOPGEN]) == tg, bar);
            __builtin_amdgcn_fence(__ATOMIC_ACQUIRE, "agent");
            xb_add(&bar[XB_XGEN(b.x)], 1u);
            asm volatile("s_waitcnt vmcnt(0)" ::: "memory");
        } else {
            XB_SPIN(xb_ld(&bar[XB_XGEN(b.x)]) == gen, bar);
            __builtin_amdgcn_fence(__ATOMIC_ACQUIRE, "agent");
            asm volatile("s_waitcnt vmcnt(0)" ::: "memory");
        }
    }
    __syncthreads();
}

__global__ void __launch_bounds__(NTHREADS, 2) fwd_mega(Args a) {
    extern __shared__ __attribute__((aligned(16))) unsigned char lds_raw[];
    LAS unsigned char* lds = (LAS unsigned char*)lds_raw;
    cg::grid_group grid = cg::this_grid();
    const int wave_s = __builtin_amdgcn_readfirstlane(threadIdx.x >> 6);
#define TID_NOW (wave_s * 64 + pg8::lane_id_asm())
    if (threadIdx.x < 4) ((volatile LAS unsigned*)(lds + MISC_OFF))[threadIdx.x] = 0u;
    __syncthreads();
    (void)xcd_barrier_post((unsigned*)(a.ws + WS_CTL), (volatile LAS unsigned*)(lds + MISC_OFF));
#define PH_ON (true)
#define SEAM() do { { unsigned long long wsb_ = (unsigned long long)a.ws; asm volatile("" : "+s"(wsb_)); XcdBarrier b_; b_.bar = (unsigned*)((unsigned char*)wsb_ + WS_CTL); b_.x = xb_xcc_id(); b_.st = (volatile LAS unsigned*)(lds + MISC_OFF); xcd_barrier(b_); } } while (0)
#ifdef PROBE_SYNC2
#define PH_NEXT do { SEAM(); SEAM(); } while (0)
#else
#define PH_NEXT do { SEAM(); } while (0)
#endif
#define WS_LOCAL int G = gridDim.x; asm volatile("" : "+s"(G)); const int bx = blockIdx.x, vcu = (G % 8 == 0) ? (bx % 8) * (G / 8) + bx / 8 : bx; (void)vcu; unsigned long long wsi_ = (unsigned long long)a.ws; asm volatile("" : "+s"(wsi_)); unsigned char* ws = (unsigned char*)(GAS unsigned char*)wsi_; float* ss = (float*)(ws + WS_SS); bf16_t* xb = (bf16_t*)(ws + WS_XB); (void)ss; (void)xb

#ifndef DIS_P0
    if (PH_ON) { WS_LOCAL; const int tid = TID_NOW;
#ifdef PROBE_P02
#pragma unroll 1
        for (int rep_ = 0; rep_ < 2; ++rep_)
#endif
        prologue(a, lds, vcu, G, wave_s, tid & 63, tid); }
#endif
    if (a.ph_lo != 0) grid.sync();
    PH_NEXT;

#pragma unroll 1
    for (int li = 0; li < 4; ++li) {
#pragma unroll 1
        for (int j = 0; j < 2; ++j) {
            const int f = li * 2 + j;
            if (PH_ON) {
                WS_LOCAL; const bf16_t* wgu = (const bf16_t*)(ws + ffn_w_off(f));
                pg8::Gemm g{xb, wgu, M_TOK, 5632, 1024}; pg8::StaticOrder S; S.init(M_TOK, 5632, G, bx);
                EpiSwiglu E{ws, lds + EPI_OFF};
#ifndef DIS_F1
#ifdef PROBE_F12
#pragma unroll 1
                for (int rep_ = 0; rep_ < 2; ++rep_)
#endif
                pg8::gemm_phase<EpiSwiglu, pg8::StaticOrder, true, true>(lds, g, S, E, wave_s);
#endif
            }
            PH_NEXT;
            if (PH_ON) {
                WS_LOCAL; const bf16_t* wd = (const bf16_t*)(ws + ffn_w_off(f)) + (size_t)5632 * 1024;
                pg8::Gemm g{(const bf16_t*)(ws + T_H), wd, M_TOK, 1024, FF, 1}; pg8::StaticOrder S; S.init(M_TOK, 1024, G, bx);
                EpiResid E{a.in[0], a.out, ws, 0.5f, f == 0 ? 1 : (f == 7 ? (2 | 4) : 0)};
#ifndef DIS_RES
                pg8::gemm_phase<EpiResid, pg8::StaticOrder, true, true>(lds, g, S, E, wave_s);
#endif
            }
            if (f != 7) PH_NEXT;
            if (j == 0) {
                const int kind = li % 3;
                if (kind == 0) {
                    const int ia = li == 0 ? 0 : 1;
                    if (PH_ON) {
                        WS_LOCAL; const bf16_t* win = (const bf16_t*)(ws + conv_w_off(ia));
                        pg8::Gemm g{xb, win, M_TOK, 3072, 1024}; pg8::StaticOrder S; S.init(M_TOK, 3072, G, bx);
                        EpiConvIn E{ws, lds + EPI_OFF};
#ifndef DIS_C1
                        pg8::gemm_phase<EpiConvIn, pg8::StaticOrder, true, true>(lds, g, S, E, wave_s);
#endif
                    }
                    PH_NEXT;
#ifndef DIS_E
                    if (PH_ON) { WS_LOCAL; const int tid = TID_NOW; conv_phase((const bf16_t*)(ws + T_Z), (const bf16_t*)(ws + T_BG), a.in[7] + (size_t)ia * 3 * 1024, (bf16_t*)(ws + T_G), vcu * NTHREADS + tid, G * NTHREADS); }
#endif
                    PH_NEXT;
                } else if (kind == 1) {
                    if (PH_ON) {
                        WS_LOCAL;
                        pg8::Gemm g{xb, (const bf16_t*)(ws + W_MLA_A), M_TOK, 512, 1024}; pg8::StaticOrder S; S.init(M_TOK, 512, G, bx);
                        EpiMlaA E{ws, lds + EPI_OFF};
#ifndef DIS_M1
                        pg8::gemm_phase<EpiMlaA, pg8::StaticOrder, true, true>(lds, g, S, E, wave_s);
#endif
                    }
                    PH_NEXT;
                    if (PH_ON) {
                        { WS_LOCAL; pg8::Gemm g{(const bf16_t*)(ws + T_AQ), (const bf16_t*)(ws + W_MLA_UQ), M_TOK, 2048, 256}; pg8::StaticOrder S; S.init(M_TOK, 2048, G, bx);
                          EpiQ E{ws};
#ifndef DIS_M2
                          pg8::gemm_phase<EpiQ, pg8::StaticOrder, true, true>(lds, g, S, E, wave_s);
#endif
                        }
                        { WS_LOCAL; pg8::Gemm g{(const bf16_t*)(ws + T_AKV), (const bf16_t*)(ws + W_MLA_UKV), M_TOK, 2048, 256}; pg8::StaticOrder S; S.init(M_TOK, 2048, G, bx);
                          EpiKV E{ws, a.out};
#ifndef DIS_M3
                          pg8::gemm_phase<EpiKV, pg8::StaticOrder, true, true>(lds, g, S, E, wave_s);
#endif
                        }
                    }
                    PH_NEXT;
#ifndef DIS_FIN
                    if (PH_ON) { WS_LOCAL; const int tid = TID_NOW; qk_finalize((bf16_t*)(ws + T_Q), (bf16_t*)(ws + T_K), (const float*)(ws + WS_KR), a.in[14], a.in[15], (const float*)(ws + WS_COS), (const float*)(ws + WS_SIN), vcu * NTHREADS + tid, G * NTHREADS); }
#endif
                    PH_NEXT;
#ifndef DIS_ATT
                    if (PH_ON) { WS_LOCAL;
#ifdef PROBE_ATT2
#pragma unroll 1
                        for (int rep_ = 0; rep_ < 2; ++rep_)
#endif
                        attn_phase(lds, (const bf16_t*)(ws + T_Q), (const bf16_t*)(ws + T_K), (const bf16_t*)((const unsigned char*)a.out + 64 * MiB), (bf16_t*)(ws + T_O), a.in[14], a.in[15], (const float*)(ws + WS_COS), (const float*)(ws + WS_SIN), vcu, G, wave_s); }
#endif
                    PH_NEXT;
                } else {
                    if (PH_ON) {
                        WS_LOCAL;
                        pg8::Gemm g{xb, (const bf16_t*)(ws + W_SG_IN), M_TOK, 2048, 1024}; pg8::StaticOrder S; S.init(M_TOK, 2048, G, bx);
                        EpiSgIn E{ws, lds + EPI_OFF};
#ifndef DIS_S1
                        pg8::gemm_phase<EpiSgIn, pg8::StaticOrder, true, true>(lds, g, S, E, wave_s);
#endif
                    }
                    PH_NEXT;
#ifndef DIS_S2
                    if (PH_ON) { WS_LOCAL; sg_phase(lds, (const bf16_t*)(ws + T_Z), (const bf16_t*)(ws + T_BG), (const float*)(ws + WS_SSV), a.in[18], (const bf16_t*)(ws + W_SG_S), a.in[20], (bf16_t*)(ws + T_G), vcu, G, wave_s); }
#endif
                    PH_NEXT;
                }
                if (PH_ON) {
                    WS_LOCAL;
                    const bf16_t* Amix = (const bf16_t*)(ws + (kind == 1 ? T_O : T_G));
                    const bf16_t* Wmix = kind == 0 ? (const bf16_t*)(ws + conv_w_off(li == 0 ? 0 : 1)) + (size_t)3072 * 1024 : kind == 1 ? (const bf16_t*)(ws + W_MLA_O) : (const bf16_t*)(ws + W_SG_OUT);
                    pg8::Gemm g{Amix, Wmix, M_TOK, 1024, 1024}; pg8::StaticOrder S; S.init(M_TOK, 1024, G, bx);
                    EpiResid E{a.in[0], a.out, ws, 1.0f, li == 3 ? 8 : 0};
#ifndef DIS_RES
                    pg8::gemm_phase<EpiResid, pg8::StaticOrder, true, true>(lds, g, S, E, wave_s);
#endif
                }
                PH_NEXT;
            }
        }
    }
}

#ifndef MK_PER_PHASE
#define MK_PER_PHASE 0
#endif
extern "C" void kernel_launch(void* const* d_in, const int* in_sizes, int n_in, void* d_out, int out_size, void* d_ws, size_t ws_size, hipStream_t stream) {
    static int grid = 0;
    if (grid == 0) {
        if (n_in != 22 || out_size != M_TOK * DM || ws_size < WS_END) { fprintf(stderr, "kernel_launch: unexpected shapes (n_in %d out %d ws %zu)\n", n_in, out_size, ws_size); grid = -1; return; }
        int dev = 0, cus = 0, per_cu = 0;
        hipGetDevice(&dev); hipDeviceGetAttribute(&cus, hipDeviceAttributeMultiprocessorCount, dev);
        if (hipFuncSetAttribute((const void*)fwd_mega, hipFuncAttributeMaxDynamicSharedMemorySize, LDS_BYTES) != hipSuccess) fprintf(stderr, "kernel_launch: hipFuncSetAttribute failed\n");
        if (hipOccupancyMaxActiveBlocksPerMultiprocessor(&per_cu, (const void*)fwd_mega, NTHREADS, LDS_BYTES) != hipSuccess || per_cu < 1) { fprintf(stderr, "kernel_launch: occupancy query says %d\n", per_cu); per_cu = 1; }
        (void)hipGetLastError();
        grid = cus * 1;
        fprintf(stderr, "kernel_launch: grid %d (per_cu %d)\n", grid, per_cu);
    }
    if (grid < 0) return;
    if (hipMemsetAsync((char*)d_ws + WS_CTL, 0, CTL_ZERO_BYTES, stream) != hipSuccess) { fprintf(stderr, "kernel_launch: memset failed\n"); return; }
    Args a{};
    for (int i = 0; i < 22; ++i) a.in[i] = (const float*)d_in[i];
    a.out = (float*)d_out; a.ws = (unsigned char*)d_ws;
    for (int i = 0; i < 16; ++i) { const float e = (float)(2 * i) / 32.0f; a.inv_freq[i] = 1.0f / powf(10000.0f, e); }
#if MK_PER_PHASE
    for (int p = 0; p < 31; ++p) { a.ph_lo = p; a.ph_hi = p + 1; hipLaunchKernelGGL(fwd_mega, dim3(grid), dim3(NTHREADS), LDS_BYTES, stream, a); }
#else
    a.ph_lo = 0; a.ph_hi = 1000;
    void* args[] = {&a};
    const hipError_t e = hipLaunchCooperativeKernel((const void*)fwd_mega, dim3(grid), dim3(NTHREADS), args, LDS_BYTES, stream);
    if (e != hipSuccess) fprintf(stderr, "kernel_launch: cooperative launch failed: %s (grid %d)\n", hipGetErrorString(e), grid);
#endif
}
```
